# Optimizing an MI355X kernel written in HIP

```python
import math
import jax, jax.numpy as jnp
from jax import lax
import numpy as np

D_MODEL = 2048
BATCH = 8
SEQ = 2048
DEPTH = 2
DEC_BATCH = 4
DEC_SEQ = 8192
PAST_LEN = 128

D_MIX = D_MODEL
LRU_WIDTH = D_MIX // 4
LRU_BLOCKS = 8
LRU_BLOCK = LRU_WIDTH // LRU_BLOCKS
CONV_WIDTH = 4
CONV_PAD_LEFT = 2
CONV_PAD_RIGHT = 1
LRU_C = 8.0
RWKV_WIDTH = D_MIX // 4
RWKV_HEAD = 64
RWKV_HEADS = RWKV_WIDTH // RWKV_HEAD
DECAY_RANK = 64
ICLR_RANK = 64
GATE_RANK = 128
DECAY_SCALE = 0.606531
GN_EPS = 64e-5
ATTN_WIDTH = D_MIX - LRU_WIDTH - RWKV_WIDTH
HEAD_DIM = 128
N_Q_HEADS = ATTN_WIDTH // HEAD_DIM
N_KV_HEADS = 2
GQA_GROUP = N_Q_HEADS // N_KV_HEADS
KV_WIDTH = N_KV_HEADS * HEAD_DIM
WINDOW = 128
BLOCK = 128
N_BUCKETS = 32
MAX_DISTANCE = 128
D_FF = 4 * D_MODEL
EPS = 1e-6
OFF_LRU_X = 0
OFF_LRU_G = LRU_WIDTH
OFF_RWKV = 2 * LRU_WIDTH
RWKV_COLS = 3 * RWKV_WIDTH + 2 * DECAY_RANK + 2 * ICLR_RANK + GATE_RANK
OFF_ATTN = OFF_RWKV + RWKV_COLS
ATTN_COLS = ATTN_WIDTH + 2 * KV_WIDTH
D_IN = OFF_ATTN + ATTN_COLS

kernel_name = 'hymba_lru_rwkv7_swa_encoder'


def _rms_norm(x, g):
    xf = x.astype(jnp.float32)
    y = xf * lax.rsqrt(jnp.mean(xf * xf, axis=-1, keepdims=True) + EPS)
    return (y * g.astype(jnp.float32)).astype(x.dtype)


def _lin_combine(left, right):
    a_l, b_l = left
    a_r, b_r = right
    return a_l * a_r, a_r * b_l + b_r


def _rg_lru(xb, gb, conv_w, conv_b, wa, ba, wx, bx, lam):
    f32 = jnp.float32
    bsz, slen, _ = xb.shape
    xf = xb.astype(f32)
    xc = lax.conv_general_dilated(xf, conv_w.astype(f32)[:, None, :], (1,), [(CONV_PAD_LEFT, CONV_PAD_RIGHT)],
                                  dimension_numbers=('NWC', 'WIO', 'NWC'),
                                  feature_group_count=LRU_WIDTH) + conv_b.astype(f32)
    xh = xc.reshape(bsz, slen, LRU_BLOCKS, LRU_BLOCK)
    r = jax.nn.sigmoid(jnp.einsum('bsni,dnij->dbsnj', xh, wa.astype(f32)).reshape(2, bsz, slen, LRU_WIDTH)
                       + ba.astype(f32)[:, None, None, :])
    i = jax.nn.sigmoid(jnp.einsum('bsni,dnij->dbsnj', xh, wx.astype(f32)).reshape(2, bsz, slen, LRU_WIDTH)
                       + bx.astype(f32)[:, None, None, :])
    log_a = -LRU_C * r * jax.nn.softplus(-lam.astype(f32))[:, None, None, :]
    a = jnp.exp(log_a)
    mult = jnp.sqrt(-jnp.expm1(2.0 * log_a))
    pos = jnp.arange(slen)
    first = jnp.stack([pos == 0, pos == slen - 1])[:, None, :, None]
    mult = jnp.where(first, 1.0, mult)
    u = mult * i * xc[None]
    h_f = lax.associative_scan(_lin_combine, (a[0], u[0]), axis=1)[1]
    h_b = lax.associative_scan(_lin_combine, (a[1], u[1]), axis=1, reverse=True)[1]
    return (h_f + h_b) * jax.nn.gelu(gb.astype(f32), approximate=True)


def _centred_shift(z):
    zp = jnp.pad(z, ((0, 0), (1, 1), (0, 0)))
    return 0.5 * (zp[:, :-2] + zp[:, 2:])


def _heads(t):
    return t.reshape(t.shape[:-1] + (RWKV_HEADS, RWKV_HEAD))


def _rwkv_scan(r, w, kk, a, k, v, reverse):
    bsz, _, nh, n = r.shape
    xs = tuple(jnp.moveaxis(t, 1, 0) for t in (r, w, kk, a, k, v))

    def step(st, inp):
        r_t, w_t, kk_t, a_t, k_t, v_t = inp
        sa = jnp.einsum('bhvk,bhk->bhv', st, kk_t)
        st = (st * w_t[:, :, None, :] - sa[..., None] * (kk_t * a_t)[:, :, None, :]
              + v_t[..., None] * k_t[:, :, None, :])
        y = jnp.einsum('bhvk,bhk->bhv', st, r_t)
        return st, y

    s0 = jnp.zeros((bsz, nh, n, n), jnp.float32)
    _, ys = lax.scan(step, s0, xs, reverse=reverse)
    return jnp.moveaxis(ys, 0, 1)


def _rwkv7(z, mu, w0, w2, a0, a2, g2, k_k, k_a, r_k, gn_w, gn_b):
    f32 = jnp.float32
    bsz, slen, _ = z.shape
    W = RWKV_WIDTH
    z = z.astype(f32)
    z = z + (_centred_shift(z) - z) * mu.astype(f32)
    r = z[..., 0:W]
    k = z[..., W:2 * W]
    v = z[..., 2 * W:3 * W]
    o = 3 * W
    dw = z[..., o:o + 2 * DECAY_RANK].reshape(bsz, slen, 2, DECAY_RANK)
    o += 2 * DECAY_RANK
    da = z[..., o:o + 2 * ICLR_RANK].reshape(bsz, slen, 2, ICLR_RANK)
    o += 2 * ICLR_RANK
    dg = z[..., o:o + GATE_RANK]
    decay = jnp.exp(-DECAY_SCALE * jax.nn.sigmoid(
        jnp.einsum('bsdr,drc->dbsc', jnp.tanh(dw), w2.astype(f32)) + w0.astype(f32)[:, None, None, :]))
    a = jax.nn.sigmoid(jnp.einsum('bsdr,drc->dbsc', da, a2.astype(f32)) + a0.astype(f32)[:, None, None, :])
    g = jax.nn.sigmoid(dg) @ g2.astype(f32)
    kdir = k[None] * (1.0 + (a - 1.0) * k_a.astype(f32)[:, None, None, :])
    kk = _heads(k * k_k.astype(f32))
    kk = kk * lax.rsqrt(jnp.maximum(jnp.sum(kk * kk, axis=-1, keepdims=True), 1e-24))
    rh, vh = _heads(r), _heads(v)
    decay_h, a_h, kdir_h = _heads(decay), _heads(a), _heads(kdir)
    y = (_rwkv_scan(rh, decay_h[0], kk, a_h[0], kdir_h[0], vh, False)
         + _rwkv_scan(rh, decay_h[1], kk, a_h[1], kdir_h[1], vh, True))
    mean = jnp.mean(y, axis=-1, keepdims=True)
    var = jnp.mean(jnp.square(y - mean), axis=-1, keepdims=True)
    yn = ((y - mean) * lax.rsqrt(var + GN_EPS)).reshape(bsz, slen, W) * gn_w.astype(f32) + gn_b.astype(f32)
    bonus = jnp.sum(rh * (kdir_h[0] + kdir_h[1]) * r_k.astype(f32), axis=-1, keepdims=True) * vh
    return (yn + bonus.reshape(bsz, slen, W)) * g


def _t5_bucket(rel):
    half = N_BUCKETS // 2
    max_exact = half // 2
    ret = jnp.where(rel > 0, half, 0)
    n = jnp.abs(rel)
    nf = jnp.maximum(n, 1).astype(jnp.float32)
    large = max_exact + (jnp.log(nf / max_exact) / math.log(MAX_DISTANCE / max_exact)
                         * (half - max_exact)).astype(jnp.int32)
    large = jnp.minimum(large, half - 1)
    return ret + jnp.where(n < max_exact, n, large)


def _window_attention(q, k, v, sink, rel_bias):
    f32 = jnp.float32
    bsz, slen = q.shape[:2]
    nb = slen // BLOCK
    qb = q.reshape(bsz, nb, BLOCK, N_KV_HEADS, GQA_GROUP, HEAD_DIM)

    def band(t):
        tp = jnp.pad(t, ((0, 0), (BLOCK, BLOCK), (0, 0), (0, 0))).reshape(bsz, nb + 2, BLOCK, N_KV_HEADS, HEAD_DIM)
        return jnp.concatenate([tp[:, :-2], tp[:, 1:-1], tp[:, 2:]], axis=2)

    kb, vb = band(k), band(v)
    s = jnp.einsum('bnqhgd,bnkhd->bnhgqk', qb, kb).astype(f32) * (HEAD_DIM ** -0.5)
    qi = jnp.arange(BLOCK)[:, None]
    kj = jnp.arange(3 * BLOCK)[None, :]
    rel = kj - BLOCK - qi
    bias = rel_bias.astype(f32)[_t5_bucket(rel)]
    bias = jnp.transpose(bias, (2, 0, 1)).reshape(N_KV_HEADS, GQA_GROUP, BLOCK, 3 * BLOCK)
    kpos = jnp.arange(nb)[:, None] * BLOCK + kj - BLOCK
    valid = ((jnp.abs(rel) <= WINDOW)[None] & (kpos >= 0)[:, None, :] & (kpos < slen)[:, None, :])
    s = jnp.where(valid[None, :, None, None], s + bias, -jnp.inf)
    sk = sink.astype(f32).reshape(N_KV_HEADS, GQA_GROUP)[None, None, :, :, None, None]
    m = jnp.maximum(jnp.max(s, axis=-1, keepdims=True), sk)
    p = jnp.exp(s - m)
    den = jnp.sum(p, axis=-1, keepdims=True) + jnp.exp(sk - m)
    o = jnp.einsum('bnhgqk,bnkhd->bnqhgd', (p / den).astype(v.dtype), vb)
    return o.reshape(bsz, slen, ATTN_WIDTH)


def _trunk(x, norm_mix_pre, norm_mix_post, norm_ffn_pre, norm_ffn_post, w_in, w_out,
           conv_w, conv_b, lru_wa, lru_ba, lru_wx, lru_bx, lru_lambda,
           rwkv_mu, rwkv_w0, rwkv_w2, rwkv_a0, rwkv_a2, rwkv_g2, rwkv_k_k, rwkv_k_a, rwkv_r_k,
           rwkv_gn_w, rwkv_gn_b, attn_sink, rel_bias, w_up, w_down):
    bsz, slen, _ = x.shape
    for l in range(DEPTH):
        h = _rms_norm(x, norm_mix_pre[l])
        p = h @ w_in[l]
        lru_out = _rg_lru(p[..., OFF_LRU_X:OFF_LRU_G], p[..., OFF_LRU_G:OFF_RWKV], conv_w[l], conv_b[l],
                          lru_wa[l], lru_ba[l], lru_wx[l], lru_bx[l], lru_lambda[l])
        rwkv_out = _rwkv7(p[..., OFF_RWKV:OFF_ATTN], rwkv_mu[l], rwkv_w0[l], rwkv_w2[l], rwkv_a0[l], rwkv_a2[l],
                          rwkv_g2[l], rwkv_k_k[l], rwkv_k_a[l], rwkv_r_k[l], rwkv_gn_w[l], rwkv_gn_b[l])
        q = p[..., OFF_ATTN:OFF_ATTN + ATTN_WIDTH].reshape(bsz, slen, N_Q_HEADS, HEAD_DIM)
        k = p[..., OFF_ATTN + ATTN_WIDTH:OFF_ATTN + ATTN_WIDTH + KV_WIDTH].reshape(bsz, slen, N_KV_HEADS, HEAD_DIM)
        v = p[..., OFF_ATTN + ATTN_WIDTH + KV_WIDTH:D_IN].reshape(bsz, slen, N_KV_HEADS, HEAD_DIM)
        attn_out = _window_attention(q, k, v, attn_sink[l], rel_bias)
        mix = jnp.concatenate([lru_out, rwkv_out, attn_out.astype(jnp.float32)], axis=-1).astype(x.dtype) @ w_out[l]
        x = x + _rms_norm(mix, norm_mix_post[l])
        h = _rms_norm(x, norm_ffn_pre[l])
        f = jnp.square(jax.nn.relu(h @ w_up[l])) @ w_down[l]
        x = x + _rms_norm(f, norm_ffn_post[l])
    return x


def setup_inputs(seed: int = 0) -> dict:
    key = jax.random.key(seed)
    ks = jax.random.split(key, 32)
    f32 = jnp.float32
    L = DEPTH

    def nrm(k, shape, scale):
        return jax.random.normal(k, shape, f32) * scale

    def gain(k, shape):
        return 1.0 + 0.05 * jax.random.normal(k, shape, f32)

    u = jax.random.uniform(ks[14], (L, 2, LRU_WIDTH), f32, 0.9, 0.999)
    a_base = u ** (1.0 / LRU_C)
    lam = jnp.log(a_base) - jnp.log1p(-a_base)
    return {
        'x_prompt': nrm(ks[0], (BATCH, SEQ, D_MODEL), 1.0),
        'x_sample': nrm(ks[1], (DEC_BATCH, DEC_SEQ, D_MODEL), 1.0),
        'norm_mix_pre': gain(ks[2], (L, D_MODEL)),
        'norm_mix_post': gain(ks[3], (L, D_MODEL)),
        'norm_ffn_pre': gain(ks[4], (L, D_MODEL)),
        'norm_ffn_post': gain(ks[5], (L, D_MODEL)),
        'w_in': nrm(ks[6], (L, D_MODEL, D_IN), D_MODEL ** -0.5),
        'w_out': nrm(ks[7], (L, D_MIX, D_MODEL), D_MIX ** -0.5),
        'conv_w': nrm(ks[8], (L, CONV_WIDTH, LRU_WIDTH), CONV_WIDTH ** -0.5),
        'conv_b': nrm(ks[9], (L, LRU_WIDTH), 0.01),
        'lru_wa': nrm(ks[10], (L, 2, LRU_BLOCKS, LRU_BLOCK, LRU_BLOCK), LRU_BLOCK ** -0.5),
        'lru_ba': nrm(ks[11], (L, 2, LRU_WIDTH), 0.01),
        'lru_wx': nrm(ks[12], (L, 2, LRU_BLOCKS, LRU_BLOCK, LRU_BLOCK), LRU_BLOCK ** -0.5),
        'lru_bx': nrm(ks[13], (L, 2, LRU_WIDTH), 0.01),
        'lru_lambda': lam,
        'rwkv_mu': jax.random.uniform(ks[15], (L, RWKV_COLS), f32, 0.0, 1.0),
        'rwkv_w0': jax.random.uniform(ks[16], (L, 2, RWKV_WIDTH), f32, -2.0, 2.0),
        'rwkv_w2': nrm(ks[17], (L, 2, DECAY_RANK, RWKV_WIDTH), 0.5 * DECAY_RANK ** -0.5),
        'rwkv_a0': nrm(ks[18], (L, 2, RWKV_WIDTH), 0.5),
        'rwkv_a2': nrm(ks[19], (L, 2, ICLR_RANK, RWKV_WIDTH), 0.5 * ICLR_RANK ** -0.5),
        'rwkv_g2': nrm(ks[20], (L, GATE_RANK, RWKV_WIDTH), GATE_RANK ** -0.5),
        'rwkv_k_k': 0.85 + 0.05 * jax.random.normal(ks[21], (L, RWKV_WIDTH), f32),
        'rwkv_k_a': gain(ks[22], (L, 2, RWKV_WIDTH)),
        'rwkv_r_k': nrm(ks[23], (L, RWKV_HEADS, RWKV_HEAD), 0.1),
        'rwkv_gn_w': gain(ks[24], (L, RWKV_WIDTH)),
        'rwkv_gn_b': nrm(ks[25], (L, RWKV_WIDTH), 0.01),
        'attn_sink': nrm(ks[26], (L, N_Q_HEADS), 0.5),
        'rel_bias': nrm(ks[27], (N_BUCKETS, N_Q_HEADS), 0.5),
        'w_up': nrm(ks[28], (L, D_MODEL, D_FF), D_MODEL ** -0.5),
        'w_down': nrm(ks[29], (L, D_FF, D_MODEL), D_FF ** -0.5),
    }


def reference(x_prompt, x_sample, norm_mix_pre, norm_mix_post, norm_ffn_pre, norm_ffn_post, w_in, w_out,
              conv_w, conv_b, lru_wa, lru_ba, lru_wx, lru_bx, lru_lambda,
              rwkv_mu, rwkv_w0, rwkv_w2, rwkv_a0, rwkv_a2, rwkv_g2, rwkv_k_k, rwkv_k_a, rwkv_r_k,
              rwkv_gn_w, rwkv_gn_b, attn_sink, rel_bias, w_up, w_down):
    weights = (norm_mix_pre, norm_mix_post, norm_ffn_pre, norm_ffn_post, w_in, w_out,
               conv_w, conv_b, lru_wa, lru_ba, lru_wx, lru_bx, lru_lambda,
               rwkv_mu, rwkv_w0, rwkv_w2, rwkv_a0, rwkv_a2, rwkv_g2, rwkv_k_k, rwkv_k_a, rwkv_r_k,
               rwkv_gn_w, rwkv_gn_b, attn_sink, rel_bias, w_up, w_down)
    y_prompt = _trunk(x_prompt, *weights)
    y_sample = _trunk(x_sample, *weights)
    return (y_prompt, y_sample)
```

```cpp
#include <hip/hip_runtime.h>
#include <hip/hip_cooperative_groups.h>
#include <cstdio>
namespace cg = cooperative_groups;

#define LAS __attribute__((address_space(3)))
typedef float f32x2 __attribute__((ext_vector_type(2)));
typedef unsigned u32x2 __attribute__((ext_vector_type(2)));
typedef _Float16 f16x4 __attribute__((ext_vector_type(4)));
typedef _Float16 f16x8 __attribute__((ext_vector_type(8)));
#define N_LAUNCH_PER_PHASE 0
namespace pg8 {
#define PG8_LAS __attribute__((address_space(3)))
typedef unsigned short bf16_t;
typedef short bf16x8 __attribute__((ext_vector_type(8)));
typedef float f32x4 __attribute__((ext_vector_type(4)));
typedef unsigned u32x4 __attribute__((ext_vector_type(4)));
constexpr int BM = 256, BK = 64, HALF = 128, HTB = HALF * BK * 2  , STAGE_BYTES = 8 * HTB, NXCD = 8, WGM = 8;

__host__ __device__ __forceinline__ int lds_byte(int r, int c) { const int st = (r >> 4) * 2 + (c >> 5), rr = r & 15, cc = c & 31, ob = rr * 64 + cc * 2; return st * 1024 + (ob ^ (((ob >> 9) & 1) << 5)); }
__host__ __device__ __forceinline__ void stage_rc(int b, int& R, int& C) { const int st = b / 1024, sb = b % 1024, swz = sb ^ (((sb >> 9) & 1) << 5); R = (st >> 1) * 16 + swz / 64; C = (st & 1) * 32 + (swz % 64) / 2; }
__host__ __device__ __forceinline__ int perm32(int rho) { const int n = rho >> 4, i = rho & 15; return 8 * (i >> 2) + 4 * n + (i & 3); }

struct Unit { int pm, pn; };
struct Gemm { const bf16_t* A; const bf16_t* Bt; int M, N, K; };

struct StaticOrder {
    int nM, nN, nwg, G, c;
    __host__ __device__ void init(int M, int N, int G_, int c_) { nM = M / BM; nN = N / BM; nwg = nM * nN; G = G_; c = c_; }
    __host__ __device__ bool next(int i, Unit& u) const {
        const long L = (long)i * G + c; if (L >= nwg) return false;
        int wgid = (int)L; { const int q = nwg / NXCD, r = nwg % NXCD, xcd = wgid % NXCD, off = wgid / NXCD; wgid = (xcd < r ? xcd * (q + 1) : r * (q + 1) + (xcd - r) * q) + off; }
        const int nig = WGM * nN, gid = wgid / nig, fm = gid * WGM, gsz = (nM - fm) < WGM ? (nM - fm) : WGM;
        u.pm = fm + ((wgid % nig) % gsz); u.pn = (wgid % nig) / gsz; return true;
    }
    __device__ __forceinline__ void a_ready(const Unit&) const {}
    __device__ __forceinline__ void done(const Unit&) const {}
};
__device__ __forceinline__ unsigned cvt_pk_bf16(float lo, float hi) { unsigned r; asm volatile("v_cvt_pk_bf16_f32 %0, %1, %2" : "=v"(r) : "v"(lo), "v"(hi)); return r; }
template <class Epi, class Sched, bool STAMP = false>
__device__ __forceinline__ void gemm_phase(PG8_LAS unsigned char* lds, const Gemm g, const Sched& S, const Epi& E, unsigned long long* stamps, const int tid_) {
    const int tid = tid_, wid = __builtin_amdgcn_readfirstlane(tid >> 6), lane = tid & 63, wr = wid >> 2, wc = wid & 3, fr = lane & 15, fq = lane >> 4;
    const int K = g.K, nt = K / BK;
    int ts_lo = 0, ts_hi = 0, nts = 0; const unsigned long long rt_entry = STAMP ? (unsigned long long)wall_clock64() : 0ull;
#define PG8_STAMP() do { if (STAMP && wid == 0 && nts < 64) { const unsigned long long _c = (unsigned long long)clock64(); \
        ts_lo = (lane == nts) ? (int)(unsigned)_c : ts_lo; ts_hi = (lane == nts) ? (int)(unsigned)(_c >> 32) : ts_hi; ++nts; } } while (0)
    PG8_STAMP();
    unsigned voffA[2], voffB[2];
#pragma unroll
    for (int i = 0; i < 2; ++i) { int R, C; stage_rc(tid * 16 + i * 8192, R, C); const int Rb = Epi::PERM ? ((R & ~31) + perm32(R & 31)) : R;
        voffA[i] = (unsigned)(R * K + C) * 2u; voffB[i] = (unsigned)(Rb * K + C) * 2u; }
    const size_t kstep = (size_t)(BK * 2);
    const size_t hstep = (size_t)HALF * K * 2;
    const size_t tstep = 2 * hstep;
    const unsigned ldsw = (unsigned)wid * 1024u;
    const int aoff = lds_byte(wr * 64 + fr, fq * 8), boff = lds_byte(wc * 32 + fr, fq * 8);
#define PG8_SA(b, h) (((b) * 2 + (h)) * HTB)
#define PG8_SB(b, h) ((4 + (b) * 2 + (h)) * HTB)
#define PG8_STAGE(bufoff, gbase, voff) do { _Pragma("unroll") for (int _i = 0; _i < 2; ++_i) \
        __builtin_amdgcn_global_load_lds((const unsigned*)((const char*)(gbase) + (voff)[_i]), (PG8_LAS unsigned*)(lds + (bufoff) + ldsw + _i * 8192), 16, 0, 0); } while (0)
#define PG8_LDA(dst, b, h) do { _Pragma("unroll") for (int m = 0; m < 4; ++m) _Pragma("unroll") for (int k = 0; k < 2; ++k) dst[m][k] = *(const PG8_LAS bf16x8*)(lds + PG8_SA(b, h) + aoff + m * 2048 + k * 1024); } while (0)
#define PG8_LDB(dst, b, h) do { _Pragma("unroll") for (int n = 0; n < 2; ++n) _Pragma("unroll") for (int k = 0; k < 2; ++k) dst[n][k] = *(const PG8_LAS bf16x8*)(lds + PG8_SB(b, h) + boff + n * 2048 + k * 1024); } while (0)
#define PG8_MMA(ai, bj, At, Bt) do { __builtin_amdgcn_s_setprio(1); _Pragma("unroll") for (int m = 0; m < 4; ++m) _Pragma("unroll") for (int n = 0; n < 2; ++n) _Pragma("unroll") for (int k = 0; k < 2; ++k) \
        acc[ai][bj][m][n] = __builtin_amdgcn_mfma_f32_16x16x32_bf16(Bt[n][k], At[m][k], acc[ai][bj][m][n], 0, 0, 0); __builtin_amdgcn_s_setprio(0); } while (0)
#define PG8_WAIT_V(n) asm volatile("s_waitcnt vmcnt(" #n ")" ::: "memory")
#define PG8_WAIT_L(n) asm volatile("s_waitcnt lgkmcnt(" #n ")" ::: "memory")
#define PG8_BAR __builtin_amdgcn_s_barrier()
#define PG8_SCHED __builtin_amdgcn_sched_barrier(0)
    Unit cur, nxt; int ui = 0;
    if (!S.next(0, cur)) return;
    f32x4 acc[2][2][4][2];
#pragma unroll
    for (int a = 0; a < 2; ++a)
#pragma unroll
        for (int b = 0; b < 2; ++b)
#pragma unroll
            for (int m = 0; m < 4; ++m)
#pragma unroll
                for (int n = 0; n < 2; ++n) acc[a][b][m][n] = (f32x4){0.f, 0.f, 0.f, 0.f};
    bf16x8 At[4][2], B0[2][2], B1[2][2];
    const char* cA = (const char*)g.A + (size_t)cur.pm * tstep; const char* cB = (const char*)g.Bt + (size_t)cur.pn * tstep;
    S.a_ready(cur);
    PG8_STAGE(PG8_SB(0, 0), cB, voffB); PG8_STAGE(PG8_SA(0, 0), cA, voffA); PG8_STAGE(PG8_SB(0, 1), cB + hstep, voffB); PG8_STAGE(PG8_SA(0, 1), cA + hstep, voffA);
    if (wr == 1) PG8_BAR;
    PG8_WAIT_V(4); PG8_BAR;
    PG8_STAGE(PG8_SB(1, 0), cB + kstep, voffB); PG8_STAGE(PG8_SA(1, 0), cA + kstep, voffA); PG8_STAGE(PG8_SB(1, 1), cB + hstep + kstep, voffB);
    PG8_WAIT_V(6); PG8_BAR;
    PG8_STAMP();
    for (;;) {
        const bool has_next = S.next(ui + 1, nxt);
        const char* nA = has_next ? (const char*)g.A + (size_t)nxt.pm * tstep : cA; const char* nB = has_next ? (const char*)g.Bt + (size_t)nxt.pn * tstep : cB;
        for (int t = 0; t < nt; t += 2) {
            const bool last = (t == nt - 2);
            const char* a1 = cA + (size_t)(t + 1) * kstep;
            const char* a2 = last ? nA : cA + (size_t)(t + 2) * kstep; const char* b2 = last ? nB : cB + (size_t)(t + 2) * kstep;
            const char* a3 = a2 + kstep; const char* b3 = b2 + kstep;
            if (last && has_next) S.a_ready(nxt);
            PG8_LDB(B0, 0, 0); PG8_SCHED; PG8_LDA(At, 0, 0); PG8_STAGE(PG8_SA(1, 1), a1 + hstep, voffA);
            PG8_WAIT_L(8); PG8_BAR; PG8_WAIT_L(0); PG8_MMA(0, 0, At, B0); PG8_BAR; PG8_SCHED;
            PG8_LDB(B1, 0, 1); PG8_STAGE(PG8_SB(0, 0), b2, voffB);
            PG8_BAR; PG8_WAIT_L(0); PG8_MMA(0, 1, At, B1); PG8_BAR;
            PG8_LDA(At, 0, 1); PG8_STAGE(PG8_SA(0, 0), a2, voffA);
            PG8_BAR; PG8_WAIT_L(0); PG8_MMA(1, 0, At, B0); PG8_BAR; PG8_SCHED;
            PG8_STAGE(PG8_SB(0, 1), b2 + hstep, voffB);
            PG8_WAIT_V(6); PG8_BAR; PG8_MMA(1, 1, At, B1); PG8_BAR;
            PG8_LDB(B0, 1, 0); PG8_SCHED; PG8_LDA(At, 1, 0); PG8_STAGE(PG8_SA(0, 1), a2 + hstep, voffA);
            PG8_WAIT_L(8); PG8_BAR; PG8_WAIT_L(0); PG8_MMA(0, 0, At, B0); PG8_BAR; PG8_SCHED;
            PG8_LDB(B1, 1, 1); PG8_STAGE(PG8_SB(1, 0), b3, voffB);
            PG8_BAR; PG8_WAIT_L(0); PG8_MMA(0, 1, At, B1); PG8_BAR;
            PG8_LDA(At, 1, 1); PG8_STAGE(PG8_SA(1, 0), a3, voffA);
            PG8_BAR; PG8_WAIT_L(0); PG8_MMA(1, 0, At, B0); PG8_BAR; PG8_SCHED;
            PG8_STAGE(PG8_SB(1, 1), b3 + hstep, voffB);
            PG8_WAIT_V(6); PG8_BAR; PG8_MMA(1, 1, At, B1); PG8_BAR;
        }
        PG8_STAMP();
        if constexpr (!Epi::AFTER_DRAIN) { E(acc, cur, wr, wc, fr, fq); S.done(cur); }
        PG8_STAMP();
        if (!has_next) break;
#pragma unroll
        for (int a = 0; a < 2; ++a)
#pragma unroll
            for (int b = 0; b < 2; ++b)
#pragma unroll
                for (int m = 0; m < 4; ++m)
#pragma unroll
                    for (int n = 0; n < 2; ++n) acc[a][b][m][n] = (f32x4){0.f, 0.f, 0.f, 0.f};
        cur = nxt; cA = nA; cB = nB; ++ui;
    }
    PG8_WAIT_V(0);
    if (wr == 0) PG8_BAR;
    PG8_BAR;
    if constexpr (Epi::AFTER_DRAIN) { E.fused(acc, cur, wr, wc, fr, fq, lds, wid, lane); S.done(cur); }
    PG8_STAMP();
    if (STAMP && wid == 0) { stamps[lane] = lane < nts ? (((unsigned long long)(unsigned)ts_hi << 32) | (unsigned)ts_lo) : 0ull;
        if (lane == 62) stamps[62] = rt_entry; if (lane == 63) stamps[63] = (unsigned long long)wall_clock64(); }
#undef PG8_STAMP
#undef PG8_SA
#undef PG8_SB
#undef PG8_STAGE
#undef PG8_LDA
#undef PG8_LDB
#undef PG8_MMA
#undef PG8_WAIT_V
#undef PG8_WAIT_L
#undef PG8_BAR
#undef PG8_SCHED
}
}

using pg8::bf16_t; using pg8::bf16x8; using pg8::f32x4; using pg8::u32x4;

constexpr int T = 49152, D = 2048, NP = 4608, DFF = 8192;
constexpr int P_K = 1024, P_V = 1280, P_LX = 1536, P_LG = 2048, P_RW = 2560;
constexpr size_t MiB = (size_t)1 << 20;
constexpr size_t WS_WIN = 0, WS_WOUT = WS_WIN + (size_t)NP * D * 2, WS_WUP = WS_WOUT + (size_t)D * D * 2, WS_WDN = WS_WUP + (size_t)DFF * D * 2;
constexpr size_t WS_SMALL = 90 * MiB, WS_LB = WS_SMALL, WS_W2T = WS_SMALL + 262144, WS_A2T = WS_SMALL + 393216, WS_G2T = WS_SMALL + 524288,
                 WS_RS1 = WS_SMALL + 1048576, WS_RS2 = WS_SMALL + 1310720;
constexpr size_t WS_XB = 92 * MiB, WS_P = 284 * MiB, WS_PREP = 716 * MiB, WS_YFB = 908 * MiB, WS_END = 1004 * MiB;
constexpr size_t WS_F = WS_P, WS_U = 668 * MiB;
constexpr int LDS_BYTES = 131072;

struct Params { const float* in[30]; float* out; unsigned char* ws; int ph_lo, ph_hi; };

#define DI __device__ __forceinline__
DI unsigned pk_bf16(float lo, float hi) { unsigned r; asm("v_cvt_pk_bf16_f32 %0, %1, %2" : "=v"(r) : "v"(lo), "v"(hi)); return r; }
DI float bf_lo(unsigned w) { return __uint_as_float(w << 16); }
DI float bf_hi(unsigned w) { return __uint_as_float(w & 0xffff0000u); }
DI float bf_at(const u32x4& v, int j) { const unsigned w = v[j >> 1]; return (j & 1) ? bf_hi(w) : bf_lo(w); }
DI float sigm(float x) { return __builtin_amdgcn_rcpf(1.0f + __builtin_amdgcn_exp2f(-1.4426950408889634f * x)); }
DI float tanh_fast(float x) { return 1.0f - 2.0f * __builtin_amdgcn_rcpf(1.0f + __builtin_amdgcn_exp2f(2.8853900817779268f * x)); }
DI float exp_fast(float x) { return __builtin_amdgcn_exp2f(1.4426950408889634f * x); }
DI void seq_of(int row, int& s0, int& len) { if (row < 16384) { s0 = row & ~2047; len = 2048; } else { s0 = 16384 + ((row - 16384) & ~8191); len = 8192; } }
DI f32x4 mfma16(bf16x8 a, bf16x8 b, f32x4 c) { return __builtin_amdgcn_mfma_f32_16x16x32_bf16(a, b, c, 0, 0, 0); }

struct EpiBf16S {
    static constexpr bool PERM = true, AFTER_DRAIN = false;
    bf16_t* O; int ldc; const float* rs; int act;
    __device__ __forceinline__ void operator()(const f32x4 (&acc)[2][2][4][2], const pg8::Unit& u, int wr, int wc, int fr, int fq) const {
        const int row0 = u.pm * 256 + wr * 64 + fr, col0 = u.pn * 256 + wc * 32 + 8 * fq;
#pragma unroll
        for (int ai = 0; ai < 2; ++ai)
#pragma unroll
            for (int m = 0; m < 4; ++m) { const int row = row0 + ai * 128 + m * 16; const float s = rs[row]; bf16_t* rowp = O + (size_t)row * ldc + col0;
#pragma unroll
                for (int bj = 0; bj < 2; ++bj) { f32x4 v0 = acc[ai][bj][m][0] * s, v1 = acc[ai][bj][m][1] * s;
                    if (act) {
#pragma unroll
                        for (int j = 0; j < 4; ++j) { const float a = fmaxf(v0[j], 0.f), b = fmaxf(v1[j], 0.f); v0[j] = a * a; v1[j] = b * b; } }
                    u32x4 w; w.x = pk_bf16(v0[0], v0[1]); w.y = pk_bf16(v0[2], v0[3]); w.z = pk_bf16(v1[0], v1[1]); w.w = pk_bf16(v1[2], v1[3]);
                    *(u32x4*)(rowp + bj * 128) = w; } }
    }
};
struct EpiF32S {
    static constexpr bool PERM = false, AFTER_DRAIN = false;
    float* C; int ldc;
    __device__ __forceinline__ void operator()(const f32x4 (&acc)[2][2][4][2], const pg8::Unit& u, int wr, int wc, int fr, int fq) const {
        const int row0 = u.pm * 256 + wr * 64 + fr, col0 = u.pn * 256 + wc * 32 + 4 * fq;
#pragma unroll
        for (int ai = 0; ai < 2; ++ai)
#pragma unroll
            for (int m = 0; m < 4; ++m) { float* rowp = C + (size_t)(row0 + ai * 128 + m * 16) * ldc + col0;
#pragma unroll
                for (int bj = 0; bj < 2; ++bj)
#pragma unroll
                    for (int n = 0; n < 2; ++n) *(f32x4*)(rowp + bj * 128 + n * 16) = acc[ai][bj][m][n]; }
    }
};

DI void transpose_tile(const float* __restrict__ W, int ldw, int k0, int srcn0, bf16_t* __restrict__ Wt, int ldt, int dstn0, const float* __restrict__ gain, LAS float* tile, const int tid_) {
    const int tid = tid_;
#pragma unroll
    for (int it = 0; it < 2; ++it) {
        const int kk = (tid >> 4) + 32 * it, n4 = (tid & 15) * 4;
        float4 v = make_float4(0.f, 0.f, 0.f, 0.f);
        if (srcn0 >= 0) { v = *(const float4*)(W + (size_t)(k0 + kk) * ldw + srcn0 + n4); if (gain) { const float g = gain[k0 + kk]; v.x *= g; v.y *= g; v.z *= g; v.w *= g; } }
        tile[kk * 65 + n4 + 0] = v.x; tile[kk * 65 + n4 + 1] = v.y; tile[kk * 65 + n4 + 2] = v.z; tile[kk * 65 + n4 + 3] = v.w;
    }
    __syncthreads();
    { const int nn = tid >> 3, kc = tid & 7; float e[8];
#pragma unroll
      for (int j = 0; j < 8; ++j) e[j] = tile[(8 * kc + j) * 65 + nn];
      u32x4 w; w.x = pk_bf16(e[0], e[1]); w.y = pk_bf16(e[2], e[3]); w.z = pk_bf16(e[4], e[5]); w.w = pk_bf16(e[6], e[7]);
      *(u32x4*)(Wt + (size_t)(dstn0 + nn) * ldt + k0 + 8 * kc) = w; }
    __syncthreads();
}
__device__ void wprep_phase(const Params& p, int l, LAS unsigned char* lds, const int tid_) {
    LAS float* tile = (LAS float*)lds;
    const float* w_in = p.in[6] + (size_t)l * D * 4480; const float* w_out = p.in[7] + (size_t)l * D * D;
    const float* w_up = p.in[28] + (size_t)l * D * DFF; const float* w_dn = p.in[29] + (size_t)l * DFF * D;
    const float* g_mix = p.in[2] + l * D; const float* g_ffn = p.in[4] + l * D;
    bf16_t* Wt_in = (bf16_t*)(p.ws + WS_WIN); bf16_t* Wt_out = (bf16_t*)(p.ws + WS_WOUT); bf16_t* Wt_up = (bf16_t*)(p.ws + WS_WUP); bf16_t* Wt_dn = (bf16_t*)(p.ws + WS_WDN);
    for (int id = blockIdx.x; id < 11520; id += gridDim.x) {
        if (id < 2304) { const int kt = id & 31, nt = id >> 5, dn = nt * 64; const int sn = dn < 1536 ? dn + 2944 : (dn < 4480 ? dn - 1536 : -1);
            transpose_tile(w_in, 4480, kt * 64, sn, Wt_in, D, dn, g_mix, tile, tid_); }
        else if (id < 3328) { const int j = id - 2304, kt = j & 31, nt = j >> 5; transpose_tile(w_out, D, kt * 64, nt * 64, Wt_out, D, nt * 64, nullptr, tile, tid_); }
        else if (id < 7424) { const int j = id - 3328, kt = j & 31, nt = j >> 5; transpose_tile(w_up, DFF, kt * 64, nt * 64, Wt_up, D, nt * 64, g_ffn, tile, tid_); }
        else { const int j = id - 7424, kt = j & 127, nt = j >> 7; transpose_tile(w_dn, D, kt * 64, nt * 64, Wt_dn, DFF, nt * 64, nullptr, tile, tid_); }
    }
    const int gt = blockIdx.x * 512 + tid_, gs = gridDim.x * 512;
    bf16_t* LB = (bf16_t*)(p.ws + WS_LB); bf16_t* W2T = (bf16_t*)(p.ws + WS_W2T); bf16_t* A2T = (bf16_t*)(p.ws + WS_A2T); bf16_t* G2T = (bf16_t*)(p.ws + WS_G2T);
    const float* wa = p.in[10] + (size_t)l * 65536; const float* wx = p.in[12] + (size_t)l * 65536;
    for (int e = gt; e < 131072; e += gs) { const int i = e & 63, c = (e >> 6) & 63, gate = (e >> 12) & 1, d = (e >> 13) & 1, n = e >> 14;
        const float v = (gate ? wx : wa)[((d * 8 + n) * 64 + i) * 64 + c]; LB[e] = (bf16_t)(pk_bf16(v, 0.f) & 0xffffu); }
    const float* w2 = p.in[17] + (size_t)l * 65536; const float* a2 = p.in[19] + (size_t)l * 65536; const float* g2 = p.in[20] + (size_t)l * 65536;
    for (int e = gt; e < 65536; e += gs) { const int rk = e & 63, c = (e >> 6) & 511, d = e >> 15;
        W2T[e] = (bf16_t)(pk_bf16(w2[(d * 64 + rk) * 512 + c], 0.f) & 0xffffu); A2T[e] = (bf16_t)(pk_bf16(a2[(d * 64 + rk) * 512 + c], 0.f) & 0xffffu); }
    for (int e = gt; e < 65536; e += gs) { const int rk = e & 127, c = e >> 7; G2T[e] = (bf16_t)(pk_bf16(g2[rk * 512 + c], 0.f) & 0xffffu); }
}

DI float wave_sum(float v) {
#pragma unroll
    for (int o = 32; o >= 1; o >>= 1) v += __shfl_xor(v, o);
    return v; }
__device__ void rowpass0(const Params& p, const int tid_) {
    const int lane = tid_ & 63, gw = blockIdx.x * 8 + (tid_ >> 6), nw = gridDim.x * 8;
    bf16_t* XB = (bf16_t*)(p.ws + WS_XB); float* RS1 = (float*)(p.ws + WS_RS1);
    for (int row = gw; row < T; row += nw) {
        const float* src = row < 16384 ? p.in[0] + (size_t)row * D : p.in[1] + (size_t)(row - 16384) * D;
        float ss = 0.f; float4 v[8];
#pragma unroll
        for (int i = 0; i < 8; ++i) { v[i] = ((const float4*)src)[lane + 64 * i]; ss += v[i].x * v[i].x + v[i].y * v[i].y + v[i].z * v[i].z + v[i].w * v[i].w; }
        ss = wave_sum(ss);
#pragma unroll
        for (int i = 0; i < 8; ++i) { u32x2 w; w.x = pk_bf16(v[i].x, v[i].y); w.y = pk_bf16(v[i].z, v[i].w); *(u32x2*)(XB + (size_t)row * D + 4 * (lane + 64 * i)) = w; }
        if (lane == 0) RS1[row] = rsqrtf(ss * (1.0f / 2048.0f) + 1e-6f);
    }
}
__device__ void rowpass_post(const Params& p, const float* Y, const float* gpost, bool x_from_input, float* RS, const int tid_) {
    const int lane = tid_ & 63, gw = blockIdx.x * 8 + (tid_ >> 6), nw = gridDim.x * 8;
    bf16_t* XB = (bf16_t*)(p.ws + WS_XB);
    float4 g[8];
#pragma unroll
    for (int i = 0; i < 8; ++i) g[i] = ((const float4*)gpost)[lane + 64 * i];
    for (int row = gw; row < T; row += nw) {
        const float* xs = x_from_input ? (row < 16384 ? p.in[0] + (size_t)row * D : p.in[1] + (size_t)(row - 16384) * D) : p.out + (size_t)row * D;
        const float* ys = Y + (size_t)row * D;
        float ss = 0.f; float4 y[8], x[8];
#pragma unroll
        for (int i = 0; i < 8; ++i) { y[i] = ((const float4*)ys)[lane + 64 * i]; x[i] = ((const float4*)xs)[lane + 64 * i]; ss += y[i].x * y[i].x + y[i].y * y[i].y + y[i].z * y[i].z + y[i].w * y[i].w; }
        ss = wave_sum(ss);
        const float ry = rsqrtf(ss * (1.0f / 2048.0f) + 1e-6f);
        float s2 = 0.f;
#pragma unroll
        for (int i = 0; i < 8; ++i) { x[i].x += y[i].x * ry * g[i].x; x[i].y += y[i].y * ry * g[i].y; x[i].z += y[i].z * ry * g[i].z; x[i].w += y[i].w * ry * g[i].w;
            s2 += x[i].x * x[i].x + x[i].y * x[i].y + x[i].z * x[i].z + x[i].w * x[i].w; }
        s2 = wave_sum(s2);
#pragma unroll
        for (int i = 0; i < 8; ++i) { ((float4*)(p.out + (size_t)row * D))[lane + 64 * i] = x[i];
            u32x2 w; w.x = pk_bf16(x[i].x, x[i].y); w.y = pk_bf16(x[i].z, x[i].w); *(u32x2*)(XB + (size_t)row * D + 4 * (lane + 64 * i)) = w; }
        if (lane == 0) RS[row] = rsqrtf(s2 * (1.0f / 2048.0f) + 1e-6f);
    }
}

__device__ void attn_unit(const Params& p, int l, int unit, LAS unsigned char* lds, const int tid_) {
    const int tid = tid_, lane = tid & 63, w = tid >> 6, r = lane & 15, q = lane >> 4;
    const int qb = unit >> 3, hq = unit & 7, kvh = hq >> 2;
    const int g0 = qb * 128; int s0, len; seq_of(g0, s0, len);
    const bf16_t* P = (const bf16_t*)(p.ws + WS_P); bf16_t* MB = (bf16_t*)(p.ws + WS_XB);
    LAS bf16_t* Ks = (LAS bf16_t*)lds;
    LAS bf16_t* Vt = (LAS bf16_t*)(lds + 34816);
    LAS float* btab = (LAS float*)(lds + 69632);
    const int ql = 16 * w + r;
    __syncthreads();
    if (tid < 257) { const int rel = tid - 128, n = rel < 0 ? -rel : rel;
        const int bkt = (rel > 0 ? 16 : 0) + (n < 8 ? n : n < 12 ? 8 : n < 16 ? 9 : n < 23 ? 10 : n < 32 ? 11 : n < 46 ? 12 : n < 64 ? 13 : n < 91 ? 14 : 15);
        btab[tid] = p.in[27][bkt * 8 + hq]; }
    bf16x8 qf[4];
#pragma unroll
    for (int ks = 0; ks < 4; ++ks) qf[ks] = *(const bf16x8*)(P + (size_t)(g0 + ql) * NP + hq * 128 + 32 * ks + 8 * q);
    float m = p.in[26][l * 8 + hq], lsum = q == 0 ? 1.0f : 0.0f; f32x4 o[8];
#pragma unroll
    for (int dt = 0; dt < 8; ++dt) o[dt] = (f32x4){0.f, 0.f, 0.f, 0.f};
    const float scale = 0.08838834764831845f;
#pragma unroll 1
    for (int kbi = 0; kbi < 3; ++kbi) {
        const int gk0 = g0 + (kbi - 1) * 128;
        if (gk0 < s0 || gk0 >= s0 + len) continue;
        __syncthreads();
#pragma unroll
        for (int i = 0; i < 4; ++i) { const int id = tid + 512 * i, row = id >> 4, ch = id & 15;
            const u32x4 v = *(const u32x4*)(P + (size_t)(gk0 + row) * NP + P_K + kvh * 128 + 8 * ch); *(LAS u32x4*)(Ks + row * 136 + 8 * ch) = v; }
#pragma unroll
        for (int i = 0; i < 4; ++i) { const int id = tid + 512 * i, key = id & 127, dc = id >> 7;
            const u32x4 v = *(const u32x4*)(P + (size_t)(gk0 + key) * NP + P_V + kvh * 128 + 8 * dc);
#pragma unroll
            for (int j = 0; j < 4; ++j) { Vt[(8 * dc + 2 * j) * 136 + key] = (bf16_t)(v[j] & 0xffffu); Vt[(8 * dc + 2 * j + 1) * 136 + key] = (bf16_t)(v[j] >> 16); } }
        __syncthreads();
        f32x4 s[8];
#pragma unroll
        for (int kt = 0; kt < 8; ++kt) { f32x4 acc = (f32x4){0.f, 0.f, 0.f, 0.f};
#pragma unroll
            for (int ks = 0; ks < 4; ++ks) { const bf16x8 a = *(const LAS bf16x8*)(Ks + (16 * kt + r) * 136 + 32 * ks + 8 * q); acc = mfma16(a, qf[ks], acc); }
            s[kt] = acc; }
        float mx = -1e30f;
        const int relb = (kbi - 1) * 128 + 4 * q - ql;
#pragma unroll
        for (int kt = 0; kt < 8; ++kt)
#pragma unroll
            for (int i = 0; i < 4; ++i) { const int rel = relb + 16 * kt + i; const bool ok = rel >= -128 && rel <= 128;
                const int ri = rel < -128 ? 0 : (rel > 128 ? 256 : rel + 128);
                const float v = ok ? s[kt][i] * scale + btab[ri] : -1e30f; s[kt][i] = v; mx = fmaxf(mx, v); }
        mx = fmaxf(mx, __shfl_xor(mx, 16)); mx = fmaxf(mx, __shfl_xor(mx, 32));
        const float mn = fmaxf(m, mx), alpha = exp_fast(m - mn); m = mn;
        float ps = 0.f;
#pragma unroll
        for (int kt = 0; kt < 8; ++kt)
#pragma unroll
            for (int i = 0; i < 4; ++i) { const float pv = s[kt][i] > -1e29f ? exp_fast(s[kt][i] - mn) : 0.f; s[kt][i] = pv; ps += pv; }
        lsum = lsum * alpha + ps;
#pragma unroll
        for (int dt = 0; dt < 8; ++dt) o[dt] *= alpha;
#pragma unroll
        for (int kk = 0; kk < 4; ++kk) {
            u32x4 pw; pw.x = pk_bf16(s[2 * kk][0], s[2 * kk][1]); pw.y = pk_bf16(s[2 * kk][2], s[2 * kk][3]); pw.z = pk_bf16(s[2 * kk + 1][0], s[2 * kk + 1][1]); pw.w = pk_bf16(s[2 * kk + 1][2], s[2 * kk + 1][3]);
            const bf16x8 pf = __builtin_bit_cast(bf16x8, pw);
#pragma unroll
            for (int dt = 0; dt < 8; ++dt) {
                const u32x2 lo = *(const LAS u32x2*)(Vt + (16 * dt + r) * 136 + 32 * kk + 4 * q), hi = *(const LAS u32x2*)(Vt + (16 * dt + r) * 136 + 32 * kk + 16 + 4 * q);
                u32x4 vw; vw.x = lo.x; vw.y = lo.y; vw.z = hi.x; vw.w = hi.y;
                o[dt] = mfma16(__builtin_bit_cast(bf16x8, vw), pf, o[dt]); }
        }
    }
    float lt = lsum; lt += __shfl_xor(lt, 16); lt += __shfl_xor(lt, 32);
    const float inv = 1.0f / lt;
    bf16_t* dst = MB + (size_t)(g0 + ql) * D + 1024 + hq * 128 + 4 * q;
#pragma unroll
    for (int dt = 0; dt < 8; ++dt) { u32x2 wv; wv.x = pk_bf16(o[dt][0] * inv, o[dt][1] * inv); wv.y = pk_bf16(o[dt][2] * inv, o[dt][3] * inv); *(u32x2*)(dst + 16 * dt) = wv; }
}

__device__ void rwkv_prep_tile(const Params& p, int l, int tile, LAS unsigned char* lds, const int tid_) {
    const int tid = tid_, lane = tid & 63, w = tid >> 6, r = lane & 15, q = lane >> 4;
    const int t0 = tile * 64; int s0, len; seq_of(t0, s0, len);
    LAS bf16_t* raw = (LAS bf16_t*)lds;
    LAS bf16_t* A = (LAS bf16_t*)(lds + 50688);
    const bf16_t* P = (const bf16_t*)(p.ws + WS_P); bf16_t* MB = (bf16_t*)(p.ws + WS_XB); _Float16* PREP = (_Float16*)(p.ws + WS_PREP);
    const bf16_t* W2T = (const bf16_t*)(p.ws + WS_W2T); const bf16_t* A2T = (const bf16_t*)(p.ws + WS_A2T); const bf16_t* G2T = (const bf16_t*)(p.ws + WS_G2T);
    const float* mu = p.in[15] + l * 1920 + 1536; const float* w0 = p.in[16] + l * 1024; const float* a0 = p.in[18] + l * 1024;
    __syncthreads();
    for (int id = tid; id < 66 * 48; id += 512) { const int row = id / 48, ch = id % 48, gr = t0 - 1 + row; u32x4 v = (u32x4){0u, 0u, 0u, 0u};
        if (gr >= s0 && gr < s0 + len) v = *(const u32x4*)(P + (size_t)gr * NP + P_RW + 1536 + 8 * ch);
        *(LAS u32x4*)(raw + row * 384 + 8 * ch) = v; }
    __syncthreads();
    for (int id = tid; id < 64 * 48; id += 512) { const int tok = id / 48, ch = id % 48, col = 8 * ch;
        const u32x4 a = *(const LAS u32x4*)(raw + tok * 384 + col), b = *(const LAS u32x4*)(raw + (tok + 1) * 384 + col), c = *(const LAS u32x4*)(raw + (tok + 2) * 384 + col);
        float o[8];
#pragma unroll
        for (int j = 0; j < 8; ++j) { const float zm = bf_at(a, j), z = bf_at(b, j), zp = bf_at(c, j); float zz = z + (0.5f * (zm + zp) - z) * mu[col + j];
            if (col < 128) zz = tanh_fast(zz); else if (col >= 256) zz = sigm(zz); o[j] = zz; }
        u32x4 wv; wv.x = pk_bf16(o[0], o[1]); wv.y = pk_bf16(o[2], o[3]); wv.z = pk_bf16(o[4], o[5]); wv.w = pk_bf16(o[6], o[7]);
        *(LAS u32x4*)(A + tok * 392 + col) = wv; }
    __syncthreads();
#pragma unroll 1
    for (int og = 0; og < 5; ++og) {
        const int nks = og < 4 ? 2 : 4, acol0 = og < 4 ? 64 * og : 256, ldb = og < 4 ? 64 : 128;
        const bf16_t* Bt = og < 2 ? W2T + og * 32768 : (og < 4 ? A2T + (og - 2) * 32768 : G2T);
        f32x4 acc[4][4];
#pragma unroll
        for (int mt = 0; mt < 4; ++mt)
#pragma unroll
            for (int nt = 0; nt < 4; ++nt) acc[mt][nt] = (f32x4){0.f, 0.f, 0.f, 0.f};
#pragma unroll 1
        for (int ks = 0; ks < nks; ++ks) {
            bf16x8 bfr[4];
#pragma unroll
            for (int nt = 0; nt < 4; ++nt) bfr[nt] = *(const bf16x8*)(Bt + (size_t)(64 * w + 16 * nt + r) * ldb + 32 * ks + 8 * q);
#pragma unroll
            for (int mt = 0; mt < 4; ++mt) { const bf16x8 a = *(const LAS bf16x8*)(A + (16 * mt + r) * 392 + acol0 + 32 * ks + 8 * q);
#pragma unroll
                for (int nt = 0; nt < 4; ++nt) acc[mt][nt] = mfma16(a, bfr[nt], acc[mt][nt]); }
        }
        {
            _Float16* pb = PREP + (size_t)t0 * 2048 + og * 512 + 64 * w + r; bf16_t* mb = MB + (size_t)t0 * D + 512 + 64 * w + r;
            const float* bsrc = og < 2 ? w0 + og * 512 : a0 + (og - 2) * 512;
#pragma unroll
            for (int nt = 0; nt < 4; ++nt) { const float bias = og < 4 ? bsrc[64 * w + 16 * nt + r] : 0.f;
#pragma unroll
                for (int mt = 0; mt < 4; ++mt) {
#pragma unroll
                    for (int i = 0; i < 4; ++i) { const int tk = 16 * mt + 4 * q + i; const float x = acc[mt][nt][i] + bias;
                        if (og < 4) { const float sg = sigm(x); pb[tk * 2048 + 16 * nt] = (_Float16)(og < 2 ? exp_fast(-0.606531f * sg) : sg); }
                        else mb[tk * D + 16 * nt] = (bf16_t)(pk_bf16(x, 0.f) & 0xffffu); }
                    asm volatile("" ::: "memory"); } }
        }
    }
}

__device__ void rwkv_scan_task(const Params& p, int l, int task, LAS unsigned char* lds, const int tid_) {
    const int tid = tid_;
    int seq, hd; if (task < 64) { seq = 8 + (task >> 4); hd = task & 15; } else { const int j = task - 64; seq = j >> 4; hd = j & 15; }
    const int h = hd >> 1, d = hd & 1;
    const int s0 = seq < 8 ? seq * 2048 : 16384 + (seq - 8) * 8192, len = seq < 8 ? 2048 : 8192, ntiles = len / 32;
    LAS float* opK = (LAS float*)lds; LAS float* opW = opK + 2048; LAS float* opB = opK + 4096; LAS float* opKh = opK + 6144; LAS float* opR = opK + 8192; LAS float* opV = opK + 10240; LAS float* ybuf = opK + 12288;
    const bf16_t* P = (const bf16_t*)(p.ws + WS_P); const _Float16* PREP = (const _Float16*)(p.ws + WS_PREP); bf16_t* YFB = (bf16_t*)(p.ws + WS_YFB);
    const int ptok = tid >> 4, cq = tid & 15, c0 = 64 * h + 4 * cq;
    const float* mu = p.in[15] + l * 1920;
    float mu_c[3][4], kk_c[4], ka_c[4];
#pragma unroll
    for (int j = 0; j < 4; ++j) { mu_c[0][j] = mu[c0 + j]; mu_c[1][j] = mu[512 + c0 + j]; mu_c[2][j] = mu[1024 + c0 + j]; kk_c[j] = p.in[21][l * 512 + c0 + j]; ka_c[j] = p.in[22][(l * 2 + d) * 512 + c0 + j]; }
    const int rv = tid >> 3, rg = tid & 7;
    float st[8];
#pragma unroll
    for (int i = 0; i < 8; ++i) st[i] = 0.f;
    u32x2 raw[3][3], rw_w, rw_a;
    const u32x2 zero2 = (u32x2){0u, 0u};
#define RW_TT(ti) (d ? len - 32 * ((ti) + 1) + (31 - ptok) : 32 * (ti) + ptok)
#define RW_LOAD(ti) do { const int tt_ = RW_TT(ti); const size_t gr_ = (size_t)(s0 + tt_); \
        _Pragma("unroll") for (int X = 0; X < 3; ++X) { const bf16_t* b_ = P + gr_ * NP + P_RW + 512 * X + c0; raw[X][1] = *(const u32x2*)b_; \
            raw[X][0] = tt_ > 0 ? *(const u32x2*)(b_ - NP) : zero2; raw[X][2] = tt_ < len - 1 ? *(const u32x2*)(b_ + NP) : zero2; } \
        rw_w = *(const u32x2*)(PREP + gr_ * 2048 + d * 512 + c0); rw_a = *(const u32x2*)(PREP + gr_ * 2048 + (2 + d) * 512 + c0); } while (0)
    __syncthreads();
    RW_LOAD(0);
    for (int ti = 0; ti < ntiles; ++ti) {
        {
            float z[3][4];
#pragma unroll
            for (int X = 0; X < 3; ++X)
#pragma unroll
                for (int j = 0; j < 4; ++j) { const unsigned wm = raw[X][0][j >> 1], wz = raw[X][1][j >> 1], wp = raw[X][2][j >> 1];
                    const float zm = (j & 1) ? bf_hi(wm) : bf_lo(wm), zc = (j & 1) ? bf_hi(wz) : bf_lo(wz), zp = (j & 1) ? bf_hi(wp) : bf_lo(wp);
                    z[X][j] = zc + (0.5f * (zm + zp) - zc) * mu_c[X][j]; }
            const f16x4 wh = __builtin_bit_cast(f16x4, rw_w), ah = __builtin_bit_cast(f16x4, rw_a);
            float kkn[4], ss = 0.f;
#pragma unroll
            for (int j = 0; j < 4; ++j) { kkn[j] = z[1][j] * kk_c[j]; ss += kkn[j] * kkn[j]; }
            ss += __shfl_xor(ss, 1); ss += __shfl_xor(ss, 2); ss += __shfl_xor(ss, 4); ss += __shfl_xor(ss, 8);
            const float inv = rsqrtf(fmaxf(ss, 1e-24f));
            f32x4 vK, vW, vB, vKh, vR, vV;
#pragma unroll
            for (int j = 0; j < 4; ++j) { const float av = (float)ah[j]; vK[j] = kkn[j] * inv; vW[j] = (float)wh[j]; vB[j] = vK[j] * av; vKh[j] = z[1][j] * (1.0f + (av - 1.0f) * ka_c[j]); vR[j] = z[0][j]; vV[j] = z[2][j]; }
            *(LAS f32x4*)(opK + ptok * 64 + 4 * cq) = vK; *(LAS f32x4*)(opW + ptok * 64 + 4 * cq) = vW; *(LAS f32x4*)(opB + ptok * 64 + 4 * cq) = vB;
            *(LAS f32x4*)(opKh + ptok * 64 + 4 * cq) = vKh; *(LAS f32x4*)(opR + ptok * 64 + 4 * cq) = vR; *(LAS f32x4*)(opV + ptok * 64 + 4 * cq) = vV;
        }
        __syncthreads();
        if (ti + 1 < ntiles) RW_LOAD(ti + 1);
#pragma unroll 2
        for (int s = 0; s < 32; ++s) {
            const f32x4 k0 = *(const LAS f32x4*)(opK + s * 64 + 8 * rg), k1 = *(const LAS f32x4*)(opK + s * 64 + 8 * rg + 4);
            const f32x4 w0 = *(const LAS f32x4*)(opW + s * 64 + 8 * rg), w1 = *(const LAS f32x4*)(opW + s * 64 + 8 * rg + 4);
            const f32x4 b0 = *(const LAS f32x4*)(opB + s * 64 + 8 * rg), b1 = *(const LAS f32x4*)(opB + s * 64 + 8 * rg + 4);
            const f32x4 h0 = *(const LAS f32x4*)(opKh + s * 64 + 8 * rg), h1 = *(const LAS f32x4*)(opKh + s * 64 + 8 * rg + 4);
            const f32x4 r0 = *(const LAS f32x4*)(opR + s * 64 + 8 * rg), r1 = *(const LAS f32x4*)(opR + s * 64 + 8 * rg + 4);
            const float vv = opV[s * 64 + rv];
            float sa = st[0] * k0[0] + st[1] * k0[1] + st[2] * k0[2] + st[3] * k0[3] + st[4] * k1[0] + st[5] * k1[1] + st[6] * k1[2] + st[7] * k1[3];
            sa += __shfl_xor(sa, 1); sa += __shfl_xor(sa, 2); sa += __shfl_xor(sa, 4);
            st[0] = st[0] * w0[0] - sa * b0[0] + vv * h0[0]; st[1] = st[1] * w0[1] - sa * b0[1] + vv * h0[1]; st[2] = st[2] * w0[2] - sa * b0[2] + vv * h0[2]; st[3] = st[3] * w0[3] - sa * b0[3] + vv * h0[3];
            st[4] = st[4] * w1[0] - sa * b1[0] + vv * h1[0]; st[5] = st[5] * w1[1] - sa * b1[1] + vv * h1[1]; st[6] = st[6] * w1[2] - sa * b1[2] + vv * h1[2]; st[7] = st[7] * w1[3] - sa * b1[3] + vv * h1[3];
            float y = st[0] * r0[0] + st[1] * r0[1] + st[2] * r0[2] + st[3] * r0[3] + st[4] * r1[0] + st[5] * r1[1] + st[6] * r1[2] + st[7] * r1[3];
            y += __shfl_xor(y, 1); y += __shfl_xor(y, 2); y += __shfl_xor(y, 4);
            if (rg == 0) ybuf[s * 64 + rv] = y;
        }
        __syncthreads();
        { const int tt = RW_TT(ti); const f32x4 yv = *(const LAS f32x4*)(ybuf + ptok * 64 + 4 * cq);
          u32x2 wv; wv.x = pk_bf16(yv[0], yv[1]); wv.y = pk_bf16(yv[2], yv[3]);
          *(u32x2*)(YFB + ((size_t)d * T + (size_t)(s0 + tt)) * 512 + c0) = wv; }
    }
#undef RW_LOAD
#undef RW_TT
}

__device__ void rwkv_final(const Params& p, int l, const int tid_) {
    const int lane = tid_ & 63, gw = blockIdx.x * 8 + (tid_ >> 6), nw = gridDim.x * 8, c0 = 8 * lane, h = lane >> 3;
    const bf16_t* P = (const bf16_t*)(p.ws + WS_P); const _Float16* PREP = (const _Float16*)(p.ws + WS_PREP); const bf16_t* YFB = (const bf16_t*)(p.ws + WS_YFB); bf16_t* MB = (bf16_t*)(p.ws + WS_XB);
    const float* mu = p.in[15] + l * 1920;
    float mu_c[3][8], ka0[8], ka1[8], rk[8], gnw[8], gnb[8];
#pragma unroll
    for (int j = 0; j < 8; ++j) { mu_c[0][j] = mu[c0 + j]; mu_c[1][j] = mu[512 + c0 + j]; mu_c[2][j] = mu[1024 + c0 + j];
        ka0[j] = p.in[22][(l * 2 + 0) * 512 + c0 + j]; ka1[j] = p.in[22][(l * 2 + 1) * 512 + c0 + j]; rk[j] = p.in[23][l * 512 + h * 64 + (c0 & 63) + j];
        gnw[j] = p.in[24][l * 512 + c0 + j]; gnb[j] = p.in[25][l * 512 + c0 + j]; }
    for (int row = gw; row < T; row += nw) {
        int s0, len; seq_of(row, s0, len); const bool hm = row > s0, hp = row < s0 + len - 1;
        const u32x4 yf = *(const u32x4*)(YFB + (size_t)row * 512 + c0), yb = *(const u32x4*)(YFB + ((size_t)T + row) * 512 + c0);
        float y[8], sum = 0.f;
#pragma unroll
        for (int j = 0; j < 8; ++j) { y[j] = bf_at(yf, j) + bf_at(yb, j); sum += y[j]; }
        sum += __shfl_xor(sum, 1); sum += __shfl_xor(sum, 2); sum += __shfl_xor(sum, 4);
        const float mean = sum * (1.0f / 64.0f); float var = 0.f;
#pragma unroll
        for (int j = 0; j < 8; ++j) { const float dd = y[j] - mean; var += dd * dd; }
        var += __shfl_xor(var, 1); var += __shfl_xor(var, 2); var += __shfl_xor(var, 4);
        const float rstd = rsqrtf(var * (1.0f / 64.0f) + 64e-5f);
        float z[3][8];
        const u32x4 zero4 = (u32x4){0u, 0u, 0u, 0u};
#pragma unroll
        for (int X = 0; X < 3; ++X) { const bf16_t* b = P + (size_t)row * NP + P_RW + 512 * X + c0;
            const u32x4 zc = *(const u32x4*)b, zm = hm ? *(const u32x4*)(b - NP) : zero4, zp = hp ? *(const u32x4*)(b + NP) : zero4;
#pragma unroll
            for (int j = 0; j < 8; ++j) { const float c = bf_at(zc, j); z[X][j] = c + (0.5f * (bf_at(zm, j) + bf_at(zp, j)) - c) * mu_c[X][j]; } }
        const f16x8 a0 = *(const f16x8*)(PREP + (size_t)row * 2048 + 1024 + c0), a1 = *(const f16x8*)(PREP + (size_t)row * 2048 + 1536 + c0);
        float bs = 0.f;
#pragma unroll
        for (int j = 0; j < 8; ++j) { const float k0 = z[1][j] * (1.0f + ((float)a0[j] - 1.0f) * ka0[j]), k1 = z[1][j] * (1.0f + ((float)a1[j] - 1.0f) * ka1[j]); bs += z[0][j] * (k0 + k1) * rk[j]; }
        bs += __shfl_xor(bs, 1); bs += __shfl_xor(bs, 2); bs += __shfl_xor(bs, 4);
        const u32x4 gv = *(const u32x4*)(MB + (size_t)row * D + 512 + c0);
        float o[8];
#pragma unroll
        for (int j = 0; j < 8; ++j) o[j] = ((y[j] - mean) * rstd * gnw[j] + gnb[j] + bs * z[2][j]) * bf_at(gv, j);
        u32x4 wv; wv.x = pk_bf16(o[0], o[1]); wv.y = pk_bf16(o[2], o[3]); wv.z = pk_bf16(o[4], o[5]); wv.w = pk_bf16(o[6], o[7]);
        *(u32x4*)(MB + (size_t)row * D + 512 + c0) = wv;
    }
}

DI float gelu_tanh(float x) { const float u = 0.7978845608028654f * (x + 0.044715f * x * x * x); return 0.5f * x * (1.0f + tanh_fast(u)); }
__device__ void lru_task(const Params& p, int l, int seq, int n, LAS unsigned char* lds, const int tid_) {
    const int tid = tid_, lane = tid & 63, w = tid >> 6, r = lane & 15, q = lane >> 4;
    const int s0 = seq < 8 ? seq * 2048 : 16384 + (seq - 8) * 8192, len = seq < 8 ? 2048 : 8192, N = len / 64;
    LAS float* xcf = (LAS float*)lds;
    LAS bf16_t* Ab = (LAS bf16_t*)(lds + 32768);
    LAS float* aL = (LAS float*)(lds + 51200);
    LAS float* uL = (LAS float*)(lds + 83968);
    LAS float* agg = (LAS float*)(lds + 116736);
    LAS float* carry = (LAS float*)(lds + 120832);
    const bf16_t* P = (const bf16_t*)(p.ws + WS_P); bf16_t* MB = (bf16_t*)(p.ws + WS_XB); const bf16_t* LB = (const bf16_t*)(p.ws + WS_LB);
    const int tok = tid >> 3, cg8 = tid & 7, ch0 = 64 * n + 8 * cg8;
    float cw[4][8], cb[8];
#pragma unroll
    for (int j = 0; j < 8; ++j) { cb[j] = p.in[9][l * 512 + ch0 + j];
#pragma unroll
        for (int k = 0; k < 4; ++k) cw[k][j] = p.in[8][(l * 4 + k) * 512 + ch0 + j]; }
    const int gd = w >> 2, ct = w & 3, chl = 16 * ct + r, gc = 64 * n + chl;
    bf16x8 br[2], bi[2];
#pragma unroll
    for (int ks = 0; ks < 2; ++ks) { br[ks] = *(const bf16x8*)(LB + (size_t)(n * 256 + (gd * 2 + 0) * 64 + chl) * 64 + 32 * ks + 8 * q);
                                     bi[ks] = *(const bf16x8*)(LB + (size_t)(n * 256 + (gd * 2 + 1) * 64 + chl) * 64 + 32 * ks + 8 * q); }
    const float ba_c = p.in[11][(l * 2 + gd) * 512 + gc], bx_c = p.in[13][(l * 2 + gd) * 512 + gc];
    float sp_c; { const float lam = p.in[14][(l * 2 + gd) * 512 + gc]; sp_c = (lam > 15.f) ? expf(-lam) : log1pf(expf(-lam)); }
    const int sd = tid >> 8, sc = (tid >> 6) & 3, scn = tid & 63;
    __syncthreads();
    if (tid < 128) carry[tid] = 0.f;
    for (int it = 0; it < N; ++it) {
#pragma unroll
        for (int dd = 0; dd < 2; ++dd) {
            const int t0 = 64 * (dd ? N - 1 - it : it);
            float acc[8];
#pragma unroll
            for (int j = 0; j < 8; ++j) acc[j] = cb[j];
#pragma unroll
            for (int k = 0; k < 4; ++k) { const int tt = t0 + tok - 2 + k;
                if (tt >= 0 && tt < len) { const u32x4 xv = *(const u32x4*)(P + (size_t)(s0 + tt) * NP + P_LX + ch0);
#pragma unroll
                    for (int j = 0; j < 8; ++j) acc[j] += cw[k][j] * bf_at(xv, j); } }
            *(LAS f32x4*)(xcf + (dd * 64 + tok) * 64 + 8 * cg8) = (f32x4){acc[0], acc[1], acc[2], acc[3]};
            *(LAS f32x4*)(xcf + (dd * 64 + tok) * 64 + 8 * cg8 + 4) = (f32x4){acc[4], acc[5], acc[6], acc[7]};
            u32x4 wv; wv.x = pk_bf16(acc[0], acc[1]); wv.y = pk_bf16(acc[2], acc[3]); wv.z = pk_bf16(acc[4], acc[5]); wv.w = pk_bf16(acc[6], acc[7]);
            *(LAS u32x4*)(Ab + (dd * 64 + tok) * 72 + 8 * cg8) = wv;
        }
        __syncthreads();
        {
            const int t0 = 64 * (gd ? N - 1 - it : it);
            f32x4 accr[4], acci[4];
#pragma unroll
            for (int mt = 0; mt < 4; ++mt) { accr[mt] = (f32x4){0.f, 0.f, 0.f, 0.f}; acci[mt] = (f32x4){0.f, 0.f, 0.f, 0.f};
#pragma unroll
                for (int ks = 0; ks < 2; ++ks) { const bf16x8 a = *(const LAS bf16x8*)(Ab + (gd * 64 + 16 * mt + r) * 72 + 32 * ks + 8 * q);
                    accr[mt] = mfma16(a, br[ks], accr[mt]); acci[mt] = mfma16(a, bi[ks], acci[mt]); } }
#pragma unroll
            for (int mt = 0; mt < 4; ++mt)
#pragma unroll
                for (int i = 0; i < 4; ++i) { const int tk = 16 * mt + 4 * q + i, tt = t0 + tk;
                    const float rg_ = sigm(accr[mt][i] + ba_c), ig_ = sigm(acci[mt][i] + bx_c);
                    const float la = -8.0f * rg_ * sp_c, a = exp_fast(la), e2 = 2.0f * la;
                    const float om = e2 > -0.05f ? -e2 * (1.0f + e2 * (0.5f + e2 * (0.16666667f + e2 * 0.041666668f))) : 1.0f - exp_fast(e2);
                    float mult = sqrtf(om); if (gd == 0 ? tt == 0 : tt == len - 1) mult = 1.0f;
                    const float u = mult * ig_ * xcf[(gd * 64 + tk) * 64 + chl];
                    aL[(gd * 64 + tk) * 64 + chl] = a; uL[(gd * 64 + tk) * 64 + chl] = u; }
        }
        __syncthreads();
        {
            float av[16], uv[16]; float A = 1.f, H = 0.f;
#pragma unroll
            for (int j = 0; j < 16; ++j) { const int tk = sd == 0 ? 16 * sc + j : 63 - 16 * sc - j; av[j] = aL[(sd * 64 + tk) * 64 + scn]; uv[j] = uL[(sd * 64 + tk) * 64 + scn]; H = av[j] * H + uv[j]; A *= av[j]; }
            agg[((sd * 64 + scn) * 4 + sc) * 2 + 0] = A; agg[((sd * 64 + scn) * 4 + sc) * 2 + 1] = H;
            float hh = carry[sd * 64 + scn];
            __syncthreads();
            for (int s2 = 0; s2 < sc; ++s2) hh = agg[((sd * 64 + scn) * 4 + s2) * 2 + 0] * hh + agg[((sd * 64 + scn) * 4 + s2) * 2 + 1];
#pragma unroll
            for (int j = 0; j < 16; ++j) { const int tk = sd == 0 ? 16 * sc + j : 63 - 16 * sc - j; hh = av[j] * hh + uv[j]; uL[(sd * 64 + tk) * 64 + scn] = hh; }
            if (sc == 3) carry[sd * 64 + scn] = hh;
        }
        __syncthreads();
#pragma unroll
        for (int dd = 0; dd < 2; ++dd) {
            const int t0 = 64 * (dd ? N - 1 - it : it); const size_t row = (size_t)(s0 + t0 + tok);
            const f32x4 h0 = *(const LAS f32x4*)(uL + (dd * 64 + tok) * 64 + 8 * cg8), h1 = *(const LAS f32x4*)(uL + (dd * 64 + tok) * 64 + 8 * cg8 + 4);
            float hv[8] = {h0[0], h0[1], h0[2], h0[3], h1[0], h1[1], h1[2], h1[3]};
            bf16_t* dst = MB + row * D + ch0;
            if (it >= N / 2) { const u32x4 pv = *(const u32x4*)dst, gv = *(const u32x4*)(P + row * NP + P_LG + ch0);
#pragma unroll
                for (int j = 0; j < 8; ++j) hv[j] = (hv[j] + bf_at(pv, j)) * gelu_tanh(bf_at(gv, j)); }
            u32x4 wv; wv.x = pk_bf16(hv[0], hv[1]); wv.y = pk_bf16(hv[2], hv[3]); wv.z = pk_bf16(hv[4], hv[5]); wv.w = pk_bf16(hv[6], hv[7]);
            *(u32x4*)dst = wv;
        }
    }
}

constexpr int N_PHASES = 27;
__device__ void run_phase(const Params& p, int ph, LAS unsigned char* lds, const int tid_) {
    bf16_t* XB = (bf16_t*)(p.ws + WS_XB); float* RS1 = (float*)(p.ws + WS_RS1); float* RS2 = (float*)(p.ws + WS_RS2);
    if (ph == 0) { wprep_phase(p, 0, lds, tid_); rowpass0(p, tid_); return; }
    const int l = (ph - 1) / 13, k = (ph - 1) % 13;
    if (k == 0) {
        pg8::Gemm g{XB, (const bf16_t*)(p.ws + WS_WIN), T, NP, D}; pg8::StaticOrder S; S.init(T, NP, (int)gridDim.x, (int)blockIdx.x);
        EpiBf16S E{(bf16_t*)(p.ws + WS_P), NP, RS1, 0};
        pg8::gemm_phase<EpiBf16S, pg8::StaticOrder>(lds, g, S, E, nullptr, tid_);
    } else if (k == 1) {
        for (int u = blockIdx.x; u < 3072; u += gridDim.x) attn_unit(p, l, u, lds, tid_);
        for (int t = blockIdx.x; t < 768; t += gridDim.x) rwkv_prep_tile(p, l, t, lds, tid_);
    } else if (k == 2) {
        for (int vb = blockIdx.x; vb < 256; vb += gridDim.x) {
            if (vb < 192) rwkv_scan_task(p, l, vb, lds, tid_);
            else if (vb < 224) { const int j = vb - 192; lru_task(p, l, 8 + (j >> 3), j & 7, lds, tid_); }
            else { const int j = vb - 224; lru_task(p, l, (2 * j) >> 3, (2 * j) & 7, lds, tid_); lru_task(p, l, (2 * j + 1) >> 3, (2 * j + 1) & 7, lds, tid_); }
        }
    } else if (k == 3) { rwkv_final(p, l, tid_);
    } else if (k == 4) {
        pg8::Gemm g{XB, (const bf16_t*)(p.ws + WS_WOUT), T, D, D}; pg8::StaticOrder S; S.init(T, D, (int)gridDim.x, (int)blockIdx.x);
        EpiF32S E{(float*)(p.ws + WS_F), D};
        pg8::gemm_phase<EpiF32S, pg8::StaticOrder>(lds, g, S, E, nullptr, tid_);
    } else if (k == 5) { rowpass_post(p, (const float*)(p.ws + WS_F), p.in[3] + l * D, l == 0, RS2, tid_);
    } else if (k < 12) {
        const int th = (k - 6) >> 1; const size_t rb = (size_t)th * 16384;
        if (((k - 6) & 1) == 0) {
            pg8::Gemm g{XB + rb * D, (const bf16_t*)(p.ws + WS_WUP), 16384, DFF, D}; pg8::StaticOrder S; S.init(16384, DFF, (int)gridDim.x, (int)blockIdx.x);
            EpiBf16S E{(bf16_t*)(p.ws + WS_U), DFF, RS2 + rb, 1};
            pg8::gemm_phase<EpiBf16S, pg8::StaticOrder>(lds, g, S, E, nullptr, tid_);
        } else {
            pg8::Gemm g{(const bf16_t*)(p.ws + WS_U), (const bf16_t*)(p.ws + WS_WDN), 16384, D, DFF}; pg8::StaticOrder S; S.init(16384, D, (int)gridDim.x, (int)blockIdx.x);
            EpiF32S E{(float*)(p.ws + WS_F) + rb * D, D};
            pg8::gemm_phase<EpiF32S, pg8::StaticOrder>(lds, g, S, E, nullptr, tid_);
        }
    } else {
        rowpass_post(p, (const float*)(p.ws + WS_F), p.in[5] + l * D, false, RS1, tid_);
        if (l == 0) wprep_phase(p, 1, lds, tid_);
    }
}

__global__ void __launch_bounds__(512, 2) hymba_mega(Params p) {
    extern __shared__ __attribute__((aligned(16))) unsigned char smem[];
    LAS unsigned char* lds = (LAS unsigned char*)smem;
    for (int ph = p.ph_lo; ph < p.ph_hi; ++ph) {
        int tid_ = (int)__builtin_amdgcn_workitem_id_x(); asm volatile("" : "+v"(tid_));
        run_phase(p, ph, lds, tid_);
        if (ph + 1 < p.ph_hi) cg::this_grid().sync();
    }
}

#ifndef N_LAUNCH_PER_PHASE
#define N_LAUNCH_PER_PHASE 1
#endif
extern "C" void kernel_launch(void* const* d_in, const int* in_sizes, int n_in, void* d_out, int out_size, void* d_ws, size_t ws_size, hipStream_t stream) {
    static int grid = 0;
    if (grid == 0) {
        if (n_in != 30 || ws_size < WS_END) { fprintf(stderr, "kernel_launch: unexpected n_in %d / ws_size %zu\n", n_in, ws_size); grid = -1; return; }
        int dev = 0, cus = 0, per_cu = 0;
        hipGetDevice(&dev); hipDeviceGetAttribute(&cus, hipDeviceAttributeMultiprocessorCount, dev);
        if (hipFuncSetAttribute((const void*)hymba_mega, hipFuncAttributeMaxDynamicSharedMemorySize, LDS_BYTES) != hipSuccess) { fprintf(stderr, "kernel_launch: hipFuncSetAttribute failed\n"); grid = -1; return; }
        if (hipOccupancyMaxActiveBlocksPerMultiprocessor(&per_cu, (const void*)hymba_mega, 512, LDS_BYTES) != hipSuccess || per_cu < 1) { fprintf(stderr, "kernel_launch: occupancy query says %d\n", per_cu); per_cu = 1; }
        (void)hipGetLastError();
        grid = cus * (per_cu > 1 ? 1 : per_cu);
    }
    if (grid < 0) return;
    Params p{};
    for (int i = 0; i < 30; ++i) p.in[i] = (const float*)d_in[i];
    p.out = (float*)d_out; p.ws = (unsigned char*)d_ws;
#if N_LAUNCH_PER_PHASE
    for (int ph = 0; ph < N_PHASES; ++ph) { p.ph_lo = ph; p.ph_hi = ph + 1; hipLaunchKernelGGL(hymba_mega, dim3(grid), dim3(512), LDS_BYTES, stream, p); }
#else
    p.ph_lo = 0; p.ph_hi = N_PHASES;
    void* args[] = {&p};
    hipError_t e = hipLaunchCooperativeKernel((const void*)hymba_mega, dim3(grid), dim3(512), args, LDS_BYTES, stream);
    if (e != hipSuccess) fprintf(stderr, "kernel_launch: cooperative launch failed: %s (grid %d)\n", hipGetErrorString(e), grid);
#endif
}
```

```cpp
#include <hip/hip_runtime.h>
#include <hip/hip_cooperative_groups.h>
#include <cstdio>
namespace cg = cooperative_groups;

#define LAS __attribute__((address_space(3)))
typedef float f32x2 __attribute__((ext_vector_type(2)));
typedef unsigned u32x2 __attribute__((ext_vector_type(2)));
typedef _Float16 f16x4 __attribute__((ext_vector_type(4)));
typedef _Float16 f16x8 __attribute__((ext_vector_type(8)));
#define N_LAUNCH_PER_PHASE 0
#define PROBE_MASK 0
#define PROBE2 0
#define NCH 6
namespace pg8 {
#define PG8_LAS __attribute__((address_space(3)))
typedef unsigned short bf16_t;
typedef short bf16x8 __attribute__((ext_vector_type(8)));
typedef float f32x4 __attribute__((ext_vector_type(4)));
typedef unsigned u32x4 __attribute__((ext_vector_type(4)));
constexpr int BM = 256, BK = 64, HALF = 128, HTB = HALF * BK * 2  , STAGE_BYTES = 8 * HTB, NXCD = 8, WGM = 8;

__host__ __device__ __forceinline__ int lds_byte(int r, int c) { const int st = (r >> 4) * 2 + (c >> 5), rr = r & 15, cc = c & 31, ob = rr * 64 + cc * 2; return st * 1024 + (ob ^ (((ob >> 9) & 1) << 5)); }
__host__ __device__ __forceinline__ void stage_rc(int b, int& R, int& C) { const int st = b / 1024, sb = b % 1024, swz = sb ^ (((sb >> 9) & 1) << 5); R = (st >> 1) * 16 + swz / 64; C = (st & 1) * 32 + (swz % 64) / 2; }
__host__ __device__ __forceinline__ int perm32(int rho) { const int n = rho >> 4, i = rho & 15; return 8 * (i >> 2) + 4 * n + (i & 3); }

struct Unit { int pm, pn; };
struct Gemm { const bf16_t* A; const bf16_t* Bt; int M, N, K; };

struct StaticOrder {
    int nM, nN, nwg, G, c;
    __host__ __device__ void init(int M, int N, int G_, int c_) { nM = M / BM; nN = N / BM; nwg = nM * nN; G = G_; c = c_; }
    __host__ __device__ bool next(int i, Unit& u) const {
        const long L = (long)i * G + c; if (L >= nwg) return false;
        int wgid = (int)L; { const int q = nwg / NXCD, r = nwg % NXCD, xcd = wgid % NXCD, off = wgid / NXCD; wgid = (xcd < r ? xcd * (q + 1) : r * (q + 1) + (xcd - r) * q) + off; }
        const int nig = WGM * nN, gid = wgid / nig, fm = gid * WGM, gsz = (nM - fm) < WGM ? (nM - fm) : WGM;
        u.pm = fm + ((wgid % nig) % gsz); u.pn = (wgid % nig) / gsz; return true;
    }
    __device__ __forceinline__ void a_ready(const Unit&) const {}
    __device__ __forceinline__ void done(const Unit&) const {}
};
__device__ __forceinline__ unsigned cvt_pk_bf16(float lo, float hi) { unsigned r; asm volatile("v_cvt_pk_bf16_f32 %0, %1, %2" : "=v"(r) : "v"(lo), "v"(hi)); return r; }
template <class Epi, class Sched, bool STAMP = false>
__device__ __forceinline__ void gemm_phase(PG8_LAS unsigned char* lds, const Gemm g, const Sched& S, const Epi& E, unsigned long long* stamps, const int tid_) {
    const int tid = tid_, wid = __builtin_amdgcn_readfirstlane(tid >> 6), lane = tid & 63, wr = wid >> 2, wc = wid & 3, fr = lane & 15, fq = lane >> 4;
    const int K = g.K, nt = K / BK;
    int ts_lo = 0, ts_hi = 0, nts = 0; const unsigned long long rt_entry = STAMP ? (unsigned long long)wall_clock64() : 0ull;
#define PG8_STAMP() do { if (STAMP && wid == 0 && nts < 64) { const unsigned long long _c = (unsigned long long)clock64(); \
        ts_lo = (lane == nts) ? (int)(unsigned)_c : ts_lo; ts_hi = (lane == nts) ? (int)(unsigned)(_c >> 32) : ts_hi; ++nts; } } while (0)
    PG8_STAMP();
    unsigned voffA[2], voffB[2];
#pragma unroll
    for (int i = 0; i < 2; ++i) { int R, C; stage_rc(tid * 16 + i * 8192, R, C); const int Rb = Epi::PERM ? ((R & ~31) + perm32(R & 31)) : R;
        voffA[i] = (unsigned)(R * K + C) * 2u; voffB[i] = (unsigned)(Rb * K + C) * 2u; }
    const size_t kstep = (size_t)(BK * 2);
    const size_t hstep = (size_t)HALF * K * 2;
    const size_t tstep = 2 * hstep;
    const unsigned ldsw = (unsigned)wid * 1024u;
    const int aoff = lds_byte(wr * 64 + fr, fq * 8), boff = lds_byte(wc * 32 + fr, fq * 8);
#define PG8_SA(b, h) (((b) * 2 + (h)) * HTB)
#define PG8_SB(b, h) ((4 + (b) * 2 + (h)) * HTB)
#define PG8_STAGE(bufoff, gbase, voff) do { _Pragma("unroll") for (int _i = 0; _i < 2; ++_i) \
        __builtin_amdgcn_global_load_lds((const unsigned*)((const char*)(gbase) + (voff)[_i]), (PG8_LAS unsigned*)(lds + (bufoff) + ldsw + _i * 8192), 16, 0, 0); } while (0)
#define PG8_LDA(dst, b, h) do { _Pragma("unroll") for (int m = 0; m < 4; ++m) _Pragma("unroll") for (int k = 0; k < 2; ++k) dst[m][k] = *(const PG8_LAS bf16x8*)(lds + PG8_SA(b, h) + aoff + m * 2048 + k * 1024); } while (0)
#define PG8_LDB(dst, b, h) do { _Pragma("unroll") for (int n = 0; n < 2; ++n) _Pragma("unroll") for (int k = 0; k < 2; ++k) dst[n][k] = *(const PG8_LAS bf16x8*)(lds + PG8_SB(b, h) + boff + n * 2048 + k * 1024); } while (0)
#define PG8_MMA(ai, bj, At, Bt) do { __builtin_amdgcn_s_setprio(1); _Pragma("unroll") for (int m = 0; m < 4; ++m) _Pragma("unroll") for (int n = 0; n < 2; ++n) _Pragma("unroll") for (int k = 0; k < 2; ++k) \
        acc[ai][bj][m][n] = __builtin_amdgcn_mfma_f32_16x16x32_bf16(Bt[n][k], At[m][k], acc[ai][bj][m][n], 0, 0, 0); __builtin_amdgcn_s_setprio(0); } while (0)
#define PG8_WAIT_V(n) asm volatile("s_waitcnt vmcnt(" #n ")" ::: "memory")
#define PG8_WAIT_L(n) asm volatile("s_waitcnt lgkmcnt(" #n ")" ::: "memory")
#define PG8_BAR __builtin_amdgcn_s_barrier()
#define PG8_SCHED __builtin_amdgcn_sched_barrier(0)
    Unit cur, nxt; int ui = 0;
    if (!S.next(0, cur)) return;
    f32x4 acc[2][2][4][2];
#pragma unroll
    for (int a = 0; a < 2; ++a)
#pragma unroll
        for (int b = 0; b < 2; ++b)
#pragma unroll
            for (int m = 0; m < 4; ++m)
#pragma unroll
                for (int n = 0; n < 2; ++n) acc[a][b][m][n] = (f32x4){0.f, 0.f, 0.f, 0.f};
    bf16x8 At[4][2], B0[2][2], B1[2][2];
    const char* cA = (const char*)g.A + (size_t)cur.pm * tstep; const char* cB = (const char*)g.Bt + (size_t)cur.pn * tstep;
    S.a_ready(cur);
    PG8_STAGE(PG8_SB(0, 0), cB, voffB); PG8_STAGE(PG8_SA(0, 0), cA, voffA); PG8_STAGE(PG8_SB(0, 1), cB + hstep, voffB); PG8_STAGE(PG8_SA(0, 1), cA + hstep, voffA);
    if (wr == 1) PG8_BAR;
    PG8_WAIT_V(4); PG8_BAR;
    PG8_STAGE(PG8_SB(1, 0), cB + kstep, voffB); PG8_STAGE(PG8_SA(1, 0), cA + kstep, voffA); PG8_STAGE(PG8_SB(1, 1), cB + hstep + kstep, voffB);
    PG8_WAIT_V(6); PG8_BAR;
    PG8_STAMP();
    for (;;) {
        const bool has_next = S.next(ui + 1, nxt);
        const char* nA = has_next ? (const char*)g.A + (size_t)nxt.pm * tstep : cA; const char* nB = has_next ? (const char*)g.Bt + (size_t)nxt.pn * tstep : cB;
        for (int t = 0; t < nt; t += 2) {
            const bool last = (t == nt - 2);
            const char* a1 = cA + (size_t)(t + 1) * kstep;
            const char* a2 = last ? nA : cA + (size_t)(t + 2) * kstep; const char* b2 = last ? nB : cB + (size_t)(t + 2) * kstep;
            const char* a3 = a2 + kstep; const char* b3 = b2 + kstep;
            if (last && has_next) S.a_ready(nxt);
            PG8_LDB(B0, 0, 0); PG8_SCHED; PG8_LDA(At, 0, 0); PG8_STAGE(PG8_SA(1, 1), a1 + hstep, voffA);
            PG8_WAIT_L(8); PG8_BAR; PG8_WAIT_L(0); PG8_MMA(0, 0, At, B0); PG8_BAR; PG8_SCHED;
            PG8_LDB(B1, 0, 1); PG8_STAGE(PG8_SB(0, 0), b2, voffB);
            PG8_BAR; PG8_WAIT_L(0); PG8_MMA(0, 1, At, B1); PG8_BAR;
            PG8_LDA(At, 0, 1); PG8_STAGE(PG8_SA(0, 0), a2, voffA);
            PG8_BAR; PG8_WAIT_L(0); PG8_MMA(1, 0, At, B0); PG8_BAR; PG8_SCHED;
            PG8_STAGE(PG8_SB(0, 1), b2 + hstep, voffB);
            PG8_WAIT_V(6); PG8_BAR; PG8_MMA(1, 1, At, B1); PG8_BAR;
            PG8_LDB(B0, 1, 0); PG8_SCHED; PG8_LDA(At, 1, 0); PG8_STAGE(PG8_SA(0, 1), a2 + hstep, voffA);
            PG8_WAIT_L(8); PG8_BAR; PG8_WAIT_L(0); PG8_MMA(0, 0, At, B0); PG8_BAR; PG8_SCHED;
            PG8_LDB(B1, 1, 1); PG8_STAGE(PG8_SB(1, 0), b3, voffB);
            PG8_BAR; PG8_WAIT_L(0); PG8_MMA(0, 1, At, B1); PG8_BAR;
            PG8_LDA(At, 1, 1); PG8_STAGE(PG8_SA(1, 0), a3, voffA);
            PG8_BAR; PG8_WAIT_L(0); PG8_MMA(1, 0, At, B0); PG8_BAR; PG8_SCHED;
            PG8_STAGE(PG8_SB(1, 1), b3 + hstep, voffB);
            PG8_WAIT_V(6); PG8_BAR; PG8_MMA(1, 1, At, B1); PG8_BAR;
        }
        PG8_STAMP();
        if constexpr (!Epi::AFTER_DRAIN) { E(acc, cur, wr, wc, fr, fq); S.done(cur); }
        PG8_STAMP();
        if (!has_next) break;
#pragma unroll
        for (int a = 0; a < 2; ++a)
#pragma unroll
            for (int b = 0; b < 2; ++b)
#pragma unroll
                for (int m = 0; m < 4; ++m)
#pragma unroll
                    for (int n = 0; n < 2; ++n) acc[a][b][m][n] = (f32x4){0.f, 0.f, 0.f, 0.f};
        cur = nxt; cA = nA; cB = nB; ++ui;
    }
    PG8_WAIT_V(0);
    if (wr == 0) PG8_BAR;
    PG8_BAR;
    if constexpr (Epi::AFTER_DRAIN) { E.fused(acc, cur, wr, wc, fr, fq, lds, wid, lane); S.done(cur); }
    PG8_STAMP();
    if (STAMP && wid == 0) { stamps[lane] = lane < nts ? (((unsigned long long)(unsigned)ts_hi << 32) | (unsigned)ts_lo) : 0ull;
        if (lane == 62) stamps[62] = rt_entry; if (lane == 63) stamps[63] = (unsigned long long)wall_clock64(); }
#undef PG8_STAMP
#undef PG8_SA
#undef PG8_SB
#undef PG8_STAGE
#undef PG8_LDA
#undef PG8_LDB
#undef PG8_MMA
#undef PG8_WAIT_V
#undef PG8_WAIT_L
#undef PG8_BAR
#undef PG8_SCHED
}
}
#define XB_TMO      128
#define XB_XCNT(j)  (256  + 64 * (j))
#define XB_XSUB(j)  (1280 + 64 * (j))
#define XB_XGEN(j)  (2304 + 64 * (j))
#define XB_TOP      3328
#define XB_TOPGEN   3392
#define XCD_BAR_WORDS 3456
#define XB_SPIN_CAP (1u << 18)

__device__ __forceinline__ unsigned xb_ld(unsigned* p)              { return __hip_atomic_load(p, __ATOMIC_RELAXED, __HIP_MEMORY_SCOPE_AGENT); }
__device__ __forceinline__ unsigned xb_add(unsigned* p, unsigned v) { return __hip_atomic_fetch_add(p, v, __ATOMIC_RELAXED, __HIP_MEMORY_SCOPE_AGENT); }
__device__ __forceinline__ unsigned xb_xcc_id() { return (unsigned)__builtin_amdgcn_s_getreg((3 << 11) | 20) & 0xFu; }
#define XB_SPIN(cond, bar) do { unsigned _sp = 0; while (cond) { __builtin_amdgcn_s_sleep(1); \
    if ((++_sp & 255u) == 0u) { if (xb_ld(&(bar)[XB_TMO])) break; if (_sp > XB_SPIN_CAP) { atomicAdd(&(bar)[XB_TMO], 1u); break; } } } } while (0)

struct XcdBarrier {
    unsigned* bar; unsigned x;
    volatile LAS unsigned* st;
};

__device__ __forceinline__ XcdBarrier xcd_barrier_post(unsigned* bar, volatile LAS unsigned* st, const bool tid0_) {
    XcdBarrier b; b.bar = bar; b.x = xb_xcc_id(); b.st = st;
    if (tid0_) (void)xb_add(&bar[XB_XCNT(b.x)], 1u);
    return b;
}
__device__ __forceinline__ void xcd_barrier_complete(unsigned* bar, unsigned x, unsigned& nloc, unsigned& nx) {
    const unsigned G = gridDim.x * gridDim.y * gridDim.z;
    unsigned sum, cnt, mine, sp = 0u;
    for (;;) {
        sum = 0u; cnt = 0u; mine = 0u;
#pragma unroll
        for (unsigned j = 0; j < 16; ++j) { const unsigned c = xb_ld(&bar[XB_XCNT(j)]); sum += c; cnt += (c > 0u) ? 1u : 0u; mine = (j == x) ? c : mine; }
        if (sum == G) break;
        __builtin_amdgcn_s_sleep(1);
        if ((++sp & 255u) == 0u) { if (xb_ld(&bar[XB_TMO])) break; if (sp > XB_SPIN_CAP) { atomicAdd(&bar[XB_TMO], 1u); break; } }
    }
    nloc = mine > 0u ? mine : 1u; nx = cnt > 0u ? cnt : 1u;
}

__device__ __forceinline__ void xcd_barrier(const XcdBarrier& b, const bool tid0_) {
    asm volatile("s_waitcnt vmcnt(0)" ::: "memory");
    __syncthreads();
    if (tid0_) {
        unsigned* bar = b.bar;
        __builtin_amdgcn_s_waitcnt(0);
        unsigned nloc = b.st[0], nx = b.st[1];
        if (nloc == 0u) { xcd_barrier_complete(bar, b.x, nloc, nx); b.st[0] = nloc; b.st[1] = nx; }
        const unsigned old = xb_add(&bar[XB_XSUB(b.x)], 1u);
        const unsigned gen = old / nloc;
        if (old + 1u == (gen + 1u) * nloc) {
            __builtin_amdgcn_fence(__ATOMIC_RELEASE, "agent");
            asm volatile("s_waitcnt vmcnt(0)" ::: "memory");
            const unsigned og = xb_add(&bar[XB_TOP], 1u);
            const unsigned tg = og / nx;
            if (og + 1u == (tg + 1u) * nx) xb_add(&bar[XB_TOPGEN], 1u);
            else XB_SPIN(xb_ld(&bar[XB_TOPGEN]) == tg, bar);
            __builtin_amdgcn_fence(__ATOMIC_ACQUIRE, "agent");
            xb_add(&bar[XB_XGEN(b.x)], 1u);
            asm volatile("s_waitcnt vmcnt(0)" ::: "memory");
        } else {
            XB_SPIN(xb_ld(&bar[XB_XGEN(b.x)]) == gen, bar);
            __builtin_amdgcn_fence(__ATOMIC_ACQUIRE, "agent");
            asm volatile("s_waitcnt vmcnt(0)" ::: "memory");
        }
    }
    __syncthreads();
}

using pg8::bf16_t; using pg8::bf16x8; using pg8::f32x4; using pg8::u32x4;

constexpr int T = 49152, D = 2048, NP = 4608, DFF = 8192;
constexpr int P_K = 1024, P_V = 1280, P_LX = 1536, P_LG = 2048, P_RW = 2560;
constexpr size_t MiB = (size_t)1 << 20;
constexpr size_t WS_WIN = 0, WS_WOUT = WS_WIN + (size_t)NP * D * 2, WS_WUP = WS_WOUT + (size_t)D * D * 2, WS_WDN = WS_WUP + (size_t)DFF * D * 2;
constexpr size_t WS_SMALL = 90 * MiB, WS_LB = WS_SMALL, WS_W2T = WS_SMALL + 262144, WS_A2T = WS_SMALL + 393216, WS_G2T = WS_SMALL + 524288,
                 WS_RS1 = WS_SMALL + 1048576, WS_RS2 = WS_SMALL + 1310720, WS_BAR = WS_SMALL + 1572864;
constexpr size_t WS_XB = 92 * MiB, WS_P = 284 * MiB, WS_PREP = 716 * MiB, WS_YFB = 908 * MiB, WS_AGG = 1004 * MiB, WS_END = 1012 * MiB;
constexpr size_t WS_F = WS_P, WS_U = 476 * MiB;
constexpr int LDS_BYTES = 131072 + 16;

struct Params { const float* in[30]; float* out; unsigned char* ws; int ph_lo, ph_hi; };

#define DI __device__ __forceinline__
DI unsigned pk_bf16(float lo, float hi) { unsigned r; asm("v_cvt_pk_bf16_f32 %0, %1, %2" : "=v"(r) : "v"(lo), "v"(hi)); return r; }
DI float bf_lo(unsigned w) { return __uint_as_float(w << 16); }
DI float bf_hi(unsigned w) { return __uint_as_float(w & 0xffff0000u); }
DI float bf_at(const u32x4& v, int j) { const unsigned w = v[j >> 1]; return (j & 1) ? bf_hi(w) : bf_lo(w); }
DI float sigm(float x) { return __builtin_amdgcn_rcpf(1.0f + __builtin_amdgcn_exp2f(-1.4426950408889634f * x)); }
DI float tanh_fast(float x) { return 1.0f - 2.0f * __builtin_amdgcn_rcpf(1.0f + __builtin_amdgcn_exp2f(2.8853900817779268f * x)); }
DI float exp_fast(float x) { return __builtin_amdgcn_exp2f(1.4426950408889634f * x); }
DI void seq_of(int row, int& s0, int& len) { if (row < 16384) { s0 = row & ~2047; len = 2048; } else { s0 = 16384 + ((row - 16384) & ~8191); len = 8192; } }
DI f32x4 mfma16(bf16x8 a, bf16x8 b, f32x4 c) { return __builtin_amdgcn_mfma_f32_16x16x32_bf16(a, b, c, 0, 0, 0); }

struct EpiBf16S {
    static constexpr bool PERM = true, AFTER_DRAIN = false;
    bf16_t* O; int ldc; const float* rs; int act;
    __device__ __forceinline__ void operator()(const f32x4 (&acc)[2][2][4][2], const pg8::Unit& u, int wr, int wc, int fr, int fq) const {
        const int row0 = u.pm * 256 + wr * 64 + fr, col0 = u.pn * 256 + wc * 32 + 8 * fq;
#pragma unroll
        for (int ai = 0; ai < 2; ++ai)
#pragma unroll
            for (int m = 0; m < 4; ++m) { const int row = row0 + ai * 128 + m * 16; const float s = rs ? rs[row] : 1.0f; bf16_t* rowp = O + (size_t)row * ldc + col0;
#pragma unroll
                for (int bj = 0; bj < 2; ++bj) { f32x4 v0 = acc[ai][bj][m][0] * s, v1 = acc[ai][bj][m][1] * s;
                    if (act) {
#pragma unroll
                        for (int j = 0; j < 4; ++j) { const float a = fmaxf(v0[j], 0.f), b = fmaxf(v1[j], 0.f); v0[j] = a * a; v1[j] = b * b; } }
                    u32x4 w; w.x = pk_bf16(v0[0], v0[1]); w.y = pk_bf16(v0[2], v0[3]); w.z = pk_bf16(v1[0], v1[1]); w.w = pk_bf16(v1[2], v1[3]);
                    *(u32x4*)(rowp + bj * 128) = w; } }
    }
};
struct EpiF32S {
    static constexpr bool PERM = false, AFTER_DRAIN = false;
    float* C; int ldc;
    __device__ __forceinline__ void operator()(const f32x4 (&acc)[2][2][4][2], const pg8::Unit& u, int wr, int wc, int fr, int fq) const {
        const int row0 = u.pm * 256 + wr * 64 + fr, col0 = u.pn * 256 + wc * 32 + 4 * fq;
#pragma unroll
        for (int ai = 0; ai < 2; ++ai)
#pragma unroll
            for (int m = 0; m < 4; ++m) { float* rowp = C + (size_t)(row0 + ai * 128 + m * 16) * ldc + col0;
#pragma unroll
                for (int bj = 0; bj < 2; ++bj)
#pragma unroll
                    for (int n = 0; n < 2; ++n) *(f32x4*)(rowp + bj * 128 + n * 16) = acc[ai][bj][m][n]; }
    }
};

struct WTile { const float* W; bf16_t* Wt; const float* gain; int ldw, k0, srcn0, ldt, dstn0; };
DI WTile wtile_of(int id, const float* w_in, const float* w_out, const float* w_up, const float* w_dn, const float* g_mix, const float* g_ffn, unsigned char* ws) {
    WTile t;
    if (id < 2304) { const int kt = id & 31, nt = id >> 5, dn = nt * 64; t = WTile{w_in, (bf16_t*)(ws + WS_WIN), g_mix, 4480, kt * 64, dn < 1536 ? dn + 2944 : (dn < 4480 ? dn - 1536 : -1), D, dn}; }
    else if (id < 3328) { const int j = id - 2304, kt = j & 31, nt = j >> 5; t = WTile{w_out, (bf16_t*)(ws + WS_WOUT), nullptr, D, kt * 64, nt * 64, D, nt * 64}; }
    else if (id < 7424) { const int j = id - 3328, kt = j & 31, nt = j >> 5; t = WTile{w_up, (bf16_t*)(ws + WS_WUP), g_ffn, DFF, kt * 64, nt * 64, D, nt * 64}; }
    else { const int j = id - 7424, kt = j & 127, nt = j >> 7; t = WTile{w_dn, (bf16_t*)(ws + WS_WDN), nullptr, D, kt * 64, nt * 64, DFF, nt * 64}; }
    return t; }
DI void wtile_load(const WTile& t, int tid, float4 (&v)[2]) {
#pragma unroll
    for (int it = 0; it < 2; ++it) { const int kk = (tid >> 4) + 32 * it, n4 = (tid & 15) * 4; v[it] = make_float4(0.f, 0.f, 0.f, 0.f);
        if (t.srcn0 >= 0) { v[it] = *(const float4*)(t.W + (size_t)(t.k0 + kk) * t.ldw + t.srcn0 + n4); if (t.gain) { const float g = t.gain[t.k0 + kk]; v[it].x *= g; v[it].y *= g; v[it].z *= g; v[it].w *= g; } } } }
__device__ void wprep_phase(const Params& p, int l, LAS unsigned char* lds, const int tid_) {
    LAS float* tile = (LAS float*)lds; const int tid = tid_;
    const float* w_in = p.in[6] + (size_t)l * D * 4480; const float* w_out = p.in[7] + (size_t)l * D * D;
    const float* w_up = p.in[28] + (size_t)l * D * DFF; const float* w_dn = p.in[29] + (size_t)l * DFF * D;
    const float* g_mix = p.in[2] + l * D; const float* g_ffn = p.in[4] + l * D;
    float4 v[2], vn[2];
    int id = blockIdx.x;
    WTile t = wtile_of(id < 11520 ? id : 0, w_in, w_out, w_up, w_dn, g_mix, g_ffn, p.ws);
    if (id < 11520) wtile_load(t, tid, v);
    for (; id < 11520; id += gridDim.x) {
        const int idn = id + gridDim.x;
        const WTile tn = wtile_of(idn < 11520 ? idn : 0, w_in, w_out, w_up, w_dn, g_mix, g_ffn, p.ws);
        if (idn < 11520) wtile_load(tn, tid, vn);
#pragma unroll
        for (int it = 0; it < 2; ++it) { const int kk = (tid >> 4) + 32 * it, n4 = (tid & 15) * 4;
            tile[kk * 65 + n4 + 0] = v[it].x; tile[kk * 65 + n4 + 1] = v[it].y; tile[kk * 65 + n4 + 2] = v[it].z; tile[kk * 65 + n4 + 3] = v[it].w; }
        __syncthreads();
        { const int nn = tid >> 3, kc = tid & 7; float e[8];
#pragma unroll
          for (int j = 0; j < 8; ++j) e[j] = tile[(8 * kc + j) * 65 + nn];
          u32x4 w; w.x = pk_bf16(e[0], e[1]); w.y = pk_bf16(e[2], e[3]); w.z = pk_bf16(e[4], e[5]); w.w = pk_bf16(e[6], e[7]);
          *(u32x4*)(t.Wt + (size_t)(t.dstn0 + nn) * t.ldt + t.k0 + 8 * kc) = w; }
        __syncthreads();
        t = tn; v[0] = vn[0]; v[1] = vn[1];
    }
    const int gt = blockIdx.x * 512 + tid_, gs = gridDim.x * 512;
    bf16_t* LB = (bf16_t*)(p.ws + WS_LB); bf16_t* W2T = (bf16_t*)(p.ws + WS_W2T); bf16_t* A2T = (bf16_t*)(p.ws + WS_A2T); bf16_t* G2T = (bf16_t*)(p.ws + WS_G2T);
    const float* wa = p.in[10] + (size_t)l * 65536; const float* wx = p.in[12] + (size_t)l * 65536;
    for (int e = gt; e < 131072; e += gs) { const int i = e & 63, c = (e >> 6) & 63, gate = (e >> 12) & 1, d = (e >> 13) & 1, n = e >> 14;
        const float v = (gate ? wx : wa)[((d * 8 + n) * 64 + i) * 64 + c]; LB[e] = (bf16_t)(pk_bf16(v, 0.f) & 0xffffu); }
    const float* w2 = p.in[17] + (size_t)l * 65536; const float* a2 = p.in[19] + (size_t)l * 65536; const float* g2 = p.in[20] + (size_t)l * 65536;
    for (int e = gt; e < 65536; e += gs) { const int rk = e & 63, c = (e >> 6) & 511, d = e >> 15;
        W2T[e] = (bf16_t)(pk_bf16(w2[(d * 64 + rk) * 512 + c], 0.f) & 0xffffu); A2T[e] = (bf16_t)(pk_bf16(a2[(d * 64 + rk) * 512 + c], 0.f) & 0xffffu); }
    for (int e = gt; e < 65536; e += gs) { const int rk = e & 127, c = e >> 7; G2T[e] = (bf16_t)(pk_bf16(g2[rk * 512 + c], 0.f) & 0xffffu); }
}

DI float wave_sum(float v) {
#pragma unroll
    for (int o = 32; o >= 1; o >>= 1) v += __shfl_xor(v, o);
    return v; }
__device__ void rowpass0(const Params& p, const int tid_) {
    const int lane = tid_ & 63, gw = blockIdx.x * 8 + (tid_ >> 6), nw = gridDim.x * 8;
    bf16_t* XB = (bf16_t*)(p.ws + WS_XB); float* RS1 = (float*)(p.ws + WS_RS1);
    for (int row = gw; row < T; row += nw) {
        const float* src = row < 16384 ? p.in[0] + (size_t)row * D : p.in[1] + (size_t)(row - 16384) * D;
        float ss = 0.f; float4 v[8];
#pragma unroll
        for (int i = 0; i < 8; ++i) { v[i] = ((const float4*)src)[lane + 64 * i]; ss += v[i].x * v[i].x + v[i].y * v[i].y + v[i].z * v[i].z + v[i].w * v[i].w; }
        ss = wave_sum(ss);
        const float rs = rsqrtf(ss * (1.0f / 2048.0f) + 1e-6f);
#pragma unroll
        for (int i = 0; i < 8; ++i) { u32x2 w; w.x = pk_bf16(v[i].x * rs, v[i].y * rs); w.y = pk_bf16(v[i].z * rs, v[i].w * rs); *(u32x2*)(XB + (size_t)row * D + 4 * (lane + 64 * i)) = w; }
        if (lane == 0) RS1[row] = rs;
    }
}
__device__ void rowpass_post(const Params& p, const bf16_t* Y, const float* gpost, int xmode, const float* RSin, float* RS, int outmode, const int tid_) {
    const int lane = tid_ & 63, gw = blockIdx.x * 8 + (tid_ >> 6), nw = gridDim.x * 8;
    bf16_t* XB = (bf16_t*)(p.ws + WS_XB); bf16_t* XS = (bf16_t*)p.out;
    float g[4][8];
#pragma unroll
    for (int i = 0; i < 4; ++i)
#pragma unroll
        for (int j = 0; j < 8; ++j) g[i][j] = gpost[8 * (lane + 64 * i) + j];
    for (int row = gw; row < T; row += nw) {
        float y[4][8], x[4][8]; float ss = 0.f;
#pragma unroll
        for (int i = 0; i < 4; ++i) { const size_t off = (size_t)row * D + 8 * (lane + 64 * i);
            const u32x4 yv = *(const u32x4*)(Y + off);
#pragma unroll
            for (int j = 0; j < 8; ++j) { y[i][j] = bf_at(yv, j); ss += y[i][j] * y[i][j]; }
            if (xmode == 0) { const float* xs = row < 16384 ? p.in[0] + off : p.in[1] + (off - (size_t)16384 * D);
                const float4 a = *(const float4*)xs, b = *(const float4*)(xs + 4);
                x[i][0] = a.x; x[i][1] = a.y; x[i][2] = a.z; x[i][3] = a.w; x[i][4] = b.x; x[i][5] = b.y; x[i][6] = b.z; x[i][7] = b.w; }
            else { const u32x4 xv = *(const u32x4*)((xmode == 1 ? XS : XB) + off); const float us = xmode == 2 ? 1.0f / RSin[row] : 1.0f;
#pragma unroll
                for (int j = 0; j < 8; ++j) x[i][j] = bf_at(xv, j) * us; } }
        ss = wave_sum(ss);
        const float ry = rsqrtf(ss * (1.0f / 2048.0f) + 1e-6f);
        float s2 = 0.f;
#pragma unroll
        for (int i = 0; i < 4; ++i)
#pragma unroll
            for (int j = 0; j < 8; ++j) { x[i][j] += y[i][j] * ry * g[i][j]; s2 += x[i][j] * x[i][j]; }
        s2 = wave_sum(s2);
        const float rsn = rsqrtf(s2 * (1.0f / 2048.0f) + 1e-6f);
#pragma unroll
        for (int i = 0; i < 4; ++i) { const size_t off = (size_t)row * D + 8 * (lane + 64 * i);
            if (outmode == 2) { *(float4*)(p.out + off) = make_float4(x[i][0], x[i][1], x[i][2], x[i][3]); *(float4*)(p.out + off + 4) = make_float4(x[i][4], x[i][5], x[i][6], x[i][7]); }
            else { u32x4 w; w.x = pk_bf16(x[i][0] * rsn, x[i][1] * rsn); w.y = pk_bf16(x[i][2] * rsn, x[i][3] * rsn); w.z = pk_bf16(x[i][4] * rsn, x[i][5] * rsn); w.w = pk_bf16(x[i][6] * rsn, x[i][7] * rsn);
                *(u32x4*)(XB + off) = w;
                if (outmode == 1) { u32x4 u; u.x = pk_bf16(x[i][0], x[i][1]); u.y = pk_bf16(x[i][2], x[i][3]); u.z = pk_bf16(x[i][4], x[i][5]); u.w = pk_bf16(x[i][6], x[i][7]); *(u32x4*)(XS + off) = u; } } }
        if (outmode != 2 && lane == 0) RS[row] = rsn;
    }
}

__device__ void attn_unit(const Params& p, int l, int unit, LAS unsigned char* lds, const int tid_) {
    const int tid = tid_, lane = tid & 63, w = tid >> 6, r = lane & 15, q = lane >> 4;
    const int qb = unit >> 3, hq = unit & 7, kvh = hq >> 2;
    const int g0 = qb * 128; int s0, len; seq_of(g0, s0, len);
    const bf16_t* P = (const bf16_t*)(p.ws + WS_P); bf16_t* MB = (bf16_t*)(p.ws + WS_XB);
    LAS bf16_t* Ks = (LAS bf16_t*)lds;
    LAS bf16_t* Vt = (LAS bf16_t*)(lds + 34816);
    LAS float* btab = (LAS float*)(lds + 69632);
    const int ql = 16 * w + r;
    __syncthreads();
    {
        const int rel = tid - 256, n = rel < 0 ? -rel : rel;
        const int bkt = (rel > 0 ? 16 : 0) + (n < 8 ? n : n < 12 ? 8 : n < 16 ? 9 : n < 23 ? 10 : n < 32 ? 11 : n < 46 ? 12 : n < 64 ? 13 : n < 91 ? 14 : 15);
        btab[tid] = n <= 128 ? p.in[27][bkt * 8 + hq] : -1e30f; }
    bf16x8 qf[4];
#pragma unroll
    for (int ks = 0; ks < 4; ++ks) qf[ks] = *(const bf16x8*)(P + (size_t)(g0 + ql) * NP + hq * 128 + 32 * ks + 8 * q);
    float m = p.in[26][l * 8 + hq], lsum = q == 0 ? 1.0f : 0.0f; f32x4 o[8];
#pragma unroll
    for (int dt = 0; dt < 8; ++dt) o[dt] = (f32x4){0.f, 0.f, 0.f, 0.f};
    const float scale = 0.08838834764831845f;
#pragma unroll 1
    for (int kbi = 0; kbi < 3; ++kbi) {
        const int gk0 = g0 + (kbi - 1) * 128;
        if (gk0 < s0 || gk0 >= s0 + len) continue;
        __syncthreads();
#pragma unroll
        for (int i = 0; i < 4; ++i) { const int id = tid + 512 * i, row = id >> 4, ch = id & 15;
            const u32x4 v = *(const u32x4*)(P + (size_t)(gk0 + row) * NP + P_K + kvh * 128 + 8 * ch); *(LAS u32x4*)(Ks + row * 136 + 8 * ch) = v; }
#pragma unroll
        for (int i = 0; i < 4; ++i) { const int id = tid + 512 * i, key = id & 127, dc = id >> 7;
            const u32x4 v = *(const u32x4*)(P + (size_t)(gk0 + key) * NP + P_V + kvh * 128 + 8 * dc);
#pragma unroll
            for (int j = 0; j < 4; ++j) { Vt[(8 * dc + 2 * j) * 136 + key] = (bf16_t)(v[j] & 0xffffu); Vt[(8 * dc + 2 * j + 1) * 136 + key] = (bf16_t)(v[j] >> 16); } }
        __syncthreads();
        f32x4 s[8];
#pragma unroll
        for (int kt = 0; kt < 8; ++kt) { f32x4 acc = (f32x4){0.f, 0.f, 0.f, 0.f};
#pragma unroll
            for (int ks = 0; ks < 4; ++ks) { const bf16x8 a = *(const LAS bf16x8*)(Ks + (16 * kt + r) * 136 + 32 * ks + 8 * q); acc = mfma16(a, qf[ks], acc); }
            s[kt] = acc; }
        float mx = -1e30f;
        const LAS float* bt = btab + ((kbi - 1) * 128 + 4 * q - ql + 256);
#pragma unroll
        for (int kt = 0; kt < 8; ++kt)
#pragma unroll
            for (int i = 0; i < 4; ++i) { const float v = s[kt][i] * scale + bt[16 * kt + i]; s[kt][i] = v; mx = fmaxf(mx, v); }
        mx = fmaxf(mx, __shfl_xor(mx, 16)); mx = fmaxf(mx, __shfl_xor(mx, 32));
        const float mn = fmaxf(m, mx), alpha = exp_fast(m - mn); m = mn;
        float ps = 0.f;
#pragma unroll
        for (int kt = 0; kt < 8; ++kt)
#pragma unroll
            for (int i = 0; i < 4; ++i) { const float pv = exp_fast(s[kt][i] - mn); s[kt][i] = pv; ps += pv; }
        lsum = lsum * alpha + ps;
#pragma unroll
        for (int dt = 0; dt < 8; ++dt) o[dt] *= alpha;
#pragma unroll
        for (int kk = 0; kk < 4; ++kk) {
            u32x4 pw; pw.x = pk_bf16(s[2 * kk][0], s[2 * kk][1]); pw.y = pk_bf16(s[2 * kk][2], s[2 * kk][3]); pw.z = pk_bf16(s[2 * kk + 1][0], s[2 * kk + 1][1]); pw.w = pk_bf16(s[2 * kk + 1][2], s[2 * kk + 1][3]);
            const bf16x8 pf = __builtin_bit_cast(bf16x8, pw);
#pragma unroll
            for (int dt = 0; dt < 8; ++dt) {
                const u32x2 lo = *(const LAS u32x2*)(Vt + (16 * dt + r) * 136 + 32 * kk + 4 * q), hi = *(const LAS u32x2*)(Vt + (16 * dt + r) * 136 + 32 * kk + 16 + 4 * q);
                u32x4 vw; vw.x = lo.x; vw.y = lo.y; vw.z = hi.x; vw.w = hi.y;
                o[dt] = mfma16(__builtin_bit_cast(bf16x8, vw), pf, o[dt]); }
        }
    }
    float lt = lsum; lt += __shfl_xor(lt, 16); lt += __shfl_xor(lt, 32);
    const float inv = 1.0f / lt;
    bf16_t* dst = MB + (size_t)(g0 + ql) * D + 1024 + hq * 128 + 4 * q;
#pragma unroll
    for (int dt = 0; dt < 8; ++dt) { u32x2 wv; wv.x = pk_bf16(o[dt][0] * inv, o[dt][1] * inv); wv.y = pk_bf16(o[dt][2] * inv, o[dt][3] * inv); *(u32x2*)(dst + 16 * dt) = wv; }
}

__device__ void rwkv_prep_tile(const Params& p, int l, int tile, LAS unsigned char* lds, const int tid_) {
    const int tid = tid_, lane = tid & 63, w = tid >> 6, r = lane & 15, q = lane >> 4;
    const int t0 = tile * 64; int s0, len; seq_of(t0, s0, len);
    LAS bf16_t* raw = (LAS bf16_t*)lds;
    LAS bf16_t* A = (LAS bf16_t*)(lds + 50688);
    const bf16_t* P = (const bf16_t*)(p.ws + WS_P); bf16_t* MB = (bf16_t*)(p.ws + WS_XB); _Float16* PREP = (_Float16*)(p.ws + WS_PREP);
    const bf16_t* W2T = (const bf16_t*)(p.ws + WS_W2T); const bf16_t* A2T = (const bf16_t*)(p.ws + WS_A2T); const bf16_t* G2T = (const bf16_t*)(p.ws + WS_G2T);
    const float* mu = p.in[15] + l * 1920 + 1536; const float* w0 = p.in[16] + l * 1024; const float* a0 = p.in[18] + l * 1024;
    __syncthreads();
    for (int id = tid; id < 66 * 48; id += 512) { const int row = id / 48, ch = id % 48, gr = t0 - 1 + row; u32x4 v = (u32x4){0u, 0u, 0u, 0u};
        if (gr >= s0 && gr < s0 + len) v = *(const u32x4*)(P + (size_t)gr * NP + P_RW + 1536 + 8 * ch);
        *(LAS u32x4*)(raw + row * 384 + 8 * ch) = v; }
    __syncthreads();
    for (int id = tid; id < 64 * 48; id += 512) { const int tok = id / 48, ch = id % 48, col = 8 * ch;
        const u32x4 a = *(const LAS u32x4*)(raw + tok * 384 + col), b = *(const LAS u32x4*)(raw + (tok + 1) * 384 + col), c = *(const LAS u32x4*)(raw + (tok + 2) * 384 + col);
        float o[8];
#pragma unroll
        for (int j = 0; j < 8; ++j) { const float zm = bf_at(a, j), z = bf_at(b, j), zp = bf_at(c, j); float zz = z + (0.5f * (zm + zp) - z) * mu[col + j];
            if (col < 128) zz = tanh_fast(zz); else if (col >= 256) zz = sigm(zz); o[j] = zz; }
        u32x4 wv; wv.x = pk_bf16(o[0], o[1]); wv.y = pk_bf16(o[2], o[3]); wv.z = pk_bf16(o[4], o[5]); wv.w = pk_bf16(o[6], o[7]);
        *(LAS u32x4*)(A + tok * 392 + col) = wv; }
    __syncthreads();
#pragma unroll 1
    for (int og = 0; og < 5; ++og) {
        const int nks = og < 4 ? 2 : 4, acol0 = og < 4 ? 64 * og : 256, ldb = og < 4 ? 64 : 128;
        const bf16_t* Bt = og < 2 ? W2T + og * 32768 : (og < 4 ? A2T + (og - 2) * 32768 : G2T);
        f32x4 acc[4][4];
#pragma unroll
        for (int mt = 0; mt < 4; ++mt)
#pragma unroll
            for (int nt = 0; nt < 4; ++nt) acc[mt][nt] = (f32x4){0.f, 0.f, 0.f, 0.f};
#pragma unroll 1
        for (int ks = 0; ks < nks; ++ks) {
            bf16x8 bfr[4];
#pragma unroll
            for (int nt = 0; nt < 4; ++nt) bfr[nt] = *(const bf16x8*)(Bt + (size_t)(64 * w + 16 * nt + r) * ldb + 32 * ks + 8 * q);
#pragma unroll
            for (int mt = 0; mt < 4; ++mt) { const bf16x8 a = *(const LAS bf16x8*)(A + (16 * mt + r) * 392 + acol0 + 32 * ks + 8 * q);
#pragma unroll
                for (int nt = 0; nt < 4; ++nt) acc[mt][nt] = mfma16(bfr[nt], a, acc[mt][nt]); }
        }
        {
            _Float16* pb = PREP + (size_t)(t0 + r) * 2048 + og * 512 + 64 * w + 4 * q; bf16_t* mb = MB + (size_t)(t0 + r) * D + 512 + 64 * w + 4 * q;
            const float* bsrc = og < 2 ? w0 + og * 512 : a0 + (og - 2) * 512;
#pragma unroll
            for (int nt = 0; nt < 4; ++nt) { f32x4 bias = (f32x4){0.f, 0.f, 0.f, 0.f}; if (og < 4) bias = *(const f32x4*)(bsrc + 64 * w + 16 * nt + 4 * q);
#pragma unroll
                for (int mt = 0; mt < 4; ++mt) { const f32x4 x = acc[mt][nt] + bias;
                    if (og < 4) { f16x4 hv;
#pragma unroll
                        for (int i = 0; i < 4; ++i) { const float sg = sigm(x[i]); hv[i] = (_Float16)(og < 2 ? exp_fast(-0.606531f * sg) : sg); }
                        *(f16x4*)(pb + (size_t)mt * 16 * 2048 + 16 * nt) = hv; }
                    else { u32x2 wv; wv.x = pk_bf16(x[0], x[1]); wv.y = pk_bf16(x[2], x[3]); *(u32x2*)(mb + (size_t)mt * 16 * D + 16 * nt) = wv; }
                    asm volatile("" ::: "memory"); } }
        }
    }
}

DI float fma_s(float a, float b, float c) { float d; asm("v_fma_f32 %0, %1, %2, %3" : "=v"(d) : "v"(a), "v"(b), "v"(c)); return d; }
DI float mul_s(float a, float b) { float d; asm("v_mul_f32 %0, %1, %2" : "=v"(d) : "v"(a), "v"(b)); return d; }
template <int CTRL> DI float dpp_xadd(float v) { return v + __int_as_float(__builtin_amdgcn_update_dpp(0, __float_as_int(v), CTRL, 0xF, 0xF, true)); }
DI float sum16(float v) { v = dpp_xadd<0xB1>(v); v = dpp_xadd<0x4E>(v); v = dpp_xadd<0x141>(v); v = dpp_xadd<0x140>(v); return v; }
DI float sum8(float v) { v = dpp_xadd<0xB1>(v); v = dpp_xadd<0x4E>(v); v = dpp_xadd<0x141>(v); return v; }
__device__ void rwkv_scan_task(const Params& p, int l, int htask, LAS unsigned char* lds, const int tid_) {
    const int tid = tid_;
    const int task = htask >> 1, rhalf = htask & 1;
    int seq, hd; if (task < 64) { seq = 8 + (task >> 4); hd = task & 15; } else { const int j = task - 64; seq = j >> 4; hd = j & 15; }
    const int h = hd >> 1, d = hd & 1;
    const int s0 = seq < 8 ? seq * 2048 : 16384 + (seq - 8) * 8192, len = seq < 8 ? 2048 : 8192, ntiles = len / 32;
    LAS float* ldsf = (LAS float*)lds;
    const bf16_t* P = (const bf16_t*)(p.ws + WS_P); const _Float16* PREP = (const _Float16*)(p.ws + WS_PREP); bf16_t* YFB = (bf16_t*)(p.ws + WS_YFB);
    __syncthreads();
    if (tid >= 256) {
        const int pt = tid - 256, ptok = pt >> 3, cq = pt & 7, c0 = 64 * h + 8 * cq;
        const float* mu = p.in[15] + l * 1920;
        float mu_c[3][8], kk_c[8], ka_c[8];
#pragma unroll
        for (int j = 0; j < 8; ++j) { mu_c[0][j] = mu[c0 + j]; mu_c[1][j] = mu[512 + c0 + j]; mu_c[2][j] = mu[1024 + c0 + j]; kk_c[j] = p.in[21][l * 512 + c0 + j]; ka_c[j] = p.in[22][(l * 2 + d) * 512 + c0 + j]; }
        u32x4 raw[3][3], rw_w, rw_a;
        const u32x4 zero4 = (u32x4){0u, 0u, 0u, 0u};
#define RW_TT(ti) (d ? len - 32 * ((ti) + 1) + (31 - ptok) : 32 * (ti) + ptok)
#define RW_LOAD(ti) do { const int tt_ = RW_TT(ti); const size_t gr_ = (size_t)(s0 + tt_); \
            _Pragma("unroll") for (int X = 0; X < 3; ++X) { const bf16_t* b_ = P + gr_ * NP + P_RW + 512 * X + c0; raw[X][1] = *(const u32x4*)b_; \
                raw[X][0] = tt_ > 0 ? *(const u32x4*)(b_ - NP) : zero4; raw[X][2] = tt_ < len - 1 ? *(const u32x4*)(b_ + NP) : zero4; } \
            rw_w = *(const u32x4*)(PREP + gr_ * 2048 + d * 512 + c0); rw_a = *(const u32x4*)(PREP + gr_ * 2048 + (2 + d) * 512 + c0); } while (0)
#define RW_CONVERT(bufi) do { LAS float* ob_ = ldsf + (bufi) * 11264; float z_[3][8]; \
            _Pragma("unroll") for (int X = 0; X < 3; ++X) _Pragma("unroll") for (int j = 0; j < 8; ++j) { const float zc_ = bf_at(raw[X][1], j); z_[X][j] = zc_ + (0.5f * (bf_at(raw[X][0], j) + bf_at(raw[X][2], j)) - zc_) * mu_c[X][j]; } \
            const f16x8 wh_ = __builtin_bit_cast(f16x8, rw_w), ah_ = __builtin_bit_cast(f16x8, rw_a); float kkn_[8], ss_ = 0.f; \
            _Pragma("unroll") for (int j = 0; j < 8; ++j) { kkn_[j] = z_[1][j] * kk_c[j]; ss_ += kkn_[j] * kkn_[j]; } \
            ss_ = sum8(ss_); const float inv_ = rsqrtf(fmaxf(ss_, 1e-24f)); \
            _Pragma("unroll") for (int hh = 0; hh < 2; ++hh) { f32x4 vK, vW, vB, vKh, vR, vV; \
                _Pragma("unroll") for (int j = 0; j < 4; ++j) { const int jj = 4 * hh + j; const float av = (float)ah_[jj]; vK[j] = kkn_[jj] * inv_; vW[j] = (float)wh_[jj]; vB[j] = vK[j] * av; \
                    vKh[j] = z_[1][jj] * (1.0f + (av - 1.0f) * ka_c[jj]); vR[j] = z_[0][jj]; vV[j] = z_[2][jj]; } \
                const int o_ = ptok * 64 + 8 * cq + 4 * hh; \
                *(LAS f32x4*)(ob_ + o_) = vK; *(LAS f32x4*)(ob_ + 2048 + o_) = vW; *(LAS f32x4*)(ob_ + 4096 + o_) = vB; *(LAS f32x4*)(ob_ + 6144 + o_) = vKh; *(LAS f32x4*)(ob_ + 8192 + o_) = vR; \
                if ((cq >> 2) == rhalf) *(LAS f32x4*)(ob_ + 10240 + ptok * 32 + 8 * (cq & 3) + 4 * hh) = vV; } } while (0)
#define RW_STOREY(ti) do { const int tt_ = RW_TT(ti); const f32x4 yv_ = *(const LAS f32x4*)(ldsf + 22528 + ((ti) & 1) * 1024 + ptok * 32 + 4 * cq); \
            u32x2 wv_; wv_.x = pk_bf16(yv_[0], yv_[1]); wv_.y = pk_bf16(yv_[2], yv_[3]); \
            *(u32x2*)(YFB + ((size_t)d * T + (size_t)(s0 + tt_)) * 512 + 64 * h + 32 * rhalf + 4 * cq) = wv_; } while (0)
        RW_LOAD(0); RW_CONVERT(0); RW_LOAD(1);
        __syncthreads();
        for (int ti = 0; ti < ntiles; ++ti) {
            if (ti + 1 < ntiles) { RW_CONVERT((ti + 1) & 1); if (ti + 2 < ntiles) RW_LOAD(ti + 2); }
            if (ti > 0) RW_STOREY(ti - 1);
            __syncthreads();
        }
        RW_STOREY(ntiles - 1);
#undef RW_LOAD
#undef RW_CONVERT
#undef RW_STOREY
#undef RW_TT
    } else {
        const int rv = tid >> 3, rg = tid & 7;
        __builtin_amdgcn_s_setprio(3);
        f32x2 st[4];
#pragma unroll
        for (int i = 0; i < 4; ++i) st[i] = (f32x2){0.f, 0.f};
        __syncthreads();
        for (int ti = 0; ti < ntiles; ++ti) {
            const LAS float* ob = ldsf + (ti & 1) * 11264 + 8 * rg; const LAS float* ov = ldsf + (ti & 1) * 11264 + 10240 + rv; LAS float* yb = ldsf + 22528 + (ti & 1) * 1024 + rv;
#define RW_FETCH(dst, dv, s) do { _Pragma("unroll") for (int a_ = 0; a_ < 5; ++a_) { dst[2 * a_] = *(const LAS f32x4*)(ob + a_ * 2048 + (s) * 64); dst[2 * a_ + 1] = *(const LAS f32x4*)(ob + a_ * 2048 + (s) * 64 + 4); } dv = ov[(s) * 32]; } while (0)
            f32x4 cur[10], nxt[10]; float cv, nv;
            RW_FETCH(cur, cv, 0);
#pragma unroll 1
            for (int s8 = 0; s8 < 32; s8 += 8) {
                float yk = 0.f;
#pragma unroll
                for (int j = 0; j < 8; ++j) { const int s = s8 + j;
                    { const int sn = s + 1 < 32 ? s + 1 : 31; RW_FETCH(nxt, nv, sn); }
                    const f32x2 vv2 = (f32x2){cv, cv};
                    const f32x2 t0 = st[0] * (f32x2){cur[2][0], cur[2][1]} + vv2 * (f32x2){cur[6][0], cur[6][1]}, t1 = st[1] * (f32x2){cur[2][2], cur[2][3]} + vv2 * (f32x2){cur[6][2], cur[6][3]};
                    const f32x2 t2 = st[2] * (f32x2){cur[3][0], cur[3][1]} + vv2 * (f32x2){cur[7][0], cur[7][1]}, t3 = st[3] * (f32x2){cur[3][2], cur[3][3]} + vv2 * (f32x2){cur[7][2], cur[7][3]};
                    const f32x2 sa2 = (st[0] * (f32x2){cur[0][0], cur[0][1]} + st[1] * (f32x2){cur[0][2], cur[0][3]}) + (st[2] * (f32x2){cur[1][0], cur[1][1]} + st[3] * (f32x2){cur[1][2], cur[1][3]});
                    const float sa = sum8(sa2[0] + sa2[1]);
                    const f32x2 nsa = (f32x2){-sa, -sa};
                    st[0] = nsa * (f32x2){cur[4][0], cur[4][1]} + t0; st[1] = nsa * (f32x2){cur[4][2], cur[4][3]} + t1;
                    st[2] = nsa * (f32x2){cur[5][0], cur[5][1]} + t2; st[3] = nsa * (f32x2){cur[5][2], cur[5][3]} + t3;
                    const f32x2 y2 = (st[0] * (f32x2){cur[8][0], cur[8][1]} + st[1] * (f32x2){cur[8][2], cur[8][3]}) + (st[2] * (f32x2){cur[9][0], cur[9][1]} + st[3] * (f32x2){cur[9][2], cur[9][3]});
                    const float y = sum8(y2[0] + y2[1]);
                    yk = (rg == j) ? y : yk;
#pragma unroll
                    for (int a_ = 0; a_ < 10; ++a_) cur[a_] = nxt[a_];
                    cv = nv; }
                yb[(s8 + rg) * 32] = yk;
            }
#undef RW_FETCH
            __syncthreads();
        }
        __builtin_amdgcn_s_setprio(0);
    }
}

__device__ void rwkv_final(const Params& p, int l, const int tid_) {
    const int lane = tid_ & 63, gw = blockIdx.x * 8 + (tid_ >> 6), nw = gridDim.x * 8, c0 = 8 * lane, h = lane >> 3;
    const bf16_t* P = (const bf16_t*)(p.ws + WS_P); const _Float16* PREP = (const _Float16*)(p.ws + WS_PREP); const bf16_t* YFB = (const bf16_t*)(p.ws + WS_YFB); bf16_t* MB = (bf16_t*)(p.ws + WS_XB);
    const float* mu = p.in[15] + l * 1920;
    float mu_c[3][8], ka0[8], ka1[8], rk[8], gnw[8], gnb[8];
#pragma unroll
    for (int j = 0; j < 8; ++j) { mu_c[0][j] = mu[c0 + j]; mu_c[1][j] = mu[512 + c0 + j]; mu_c[2][j] = mu[1024 + c0 + j];
        ka0[j] = p.in[22][(l * 2 + 0) * 512 + c0 + j]; ka1[j] = p.in[22][(l * 2 + 1) * 512 + c0 + j]; rk[j] = p.in[23][l * 512 + h * 64 + (c0 & 63) + j];
        gnw[j] = p.in[24][l * 512 + c0 + j]; gnb[j] = p.in[25][l * 512 + c0 + j]; }
    for (int row = gw; row < T; row += nw) {
        int s0, len; seq_of(row, s0, len); const bool hm = row > s0, hp = row < s0 + len - 1;
        const u32x4 yf = *(const u32x4*)(YFB + (size_t)row * 512 + c0), yb = *(const u32x4*)(YFB + ((size_t)T + row) * 512 + c0);
        float y[8], sum = 0.f;
#pragma unroll
        for (int j = 0; j < 8; ++j) { y[j] = bf_at(yf, j) + bf_at(yb, j); sum += y[j]; }
        sum += __shfl_xor(sum, 1); sum += __shfl_xor(sum, 2); sum += __shfl_xor(sum, 4);
        const float mean = sum * (1.0f / 64.0f); float var = 0.f;
#pragma unroll
        for (int j = 0; j < 8; ++j) { const float dd = y[j] - mean; var += dd * dd; }
        var += __shfl_xor(var, 1); var += __shfl_xor(var, 2); var += __shfl_xor(var, 4);
        const float rstd = rsqrtf(var * (1.0f / 64.0f) + 64e-5f);
        float z[3][8];
        const u32x4 zero4 = (u32x4){0u, 0u, 0u, 0u};
#pragma unroll
        for (int X = 0; X < 3; ++X) { const bf16_t* b = P + (size_t)row * NP + P_RW + 512 * X + c0;
            const u32x4 zc = *(const u32x4*)b, zm = hm ? *(const u32x4*)(b - NP) : zero4, zp = hp ? *(const u32x4*)(b + NP) : zero4;
#pragma unroll
            for (int j = 0; j < 8; ++j) { const float c = bf_at(zc, j); z[X][j] = c + (0.5f * (bf_at(zm, j) + bf_at(zp, j)) - c) * mu_c[X][j]; } }
        const f16x8 a0 = *(const f16x8*)(PREP + (size_t)row * 2048 + 1024 + c0), a1 = *(const f16x8*)(PREP + (size_t)row * 2048 + 1536 + c0);
        float bs = 0.f;
#pragma unroll
        for (int j = 0; j < 8; ++j) { const float k0 = z[1][j] * (1.0f + ((float)a0[j] - 1.0f) * ka0[j]), k1 = z[1][j] * (1.0f + ((float)a1[j] - 1.0f) * ka1[j]); bs += z[0][j] * (k0 + k1) * rk[j]; }
        bs += __shfl_xor(bs, 1); bs += __shfl_xor(bs, 2); bs += __shfl_xor(bs, 4);
        const u32x4 gv = *(const u32x4*)(MB + (size_t)row * D + 512 + c0);
        float o[8];
#pragma unroll
        for (int j = 0; j < 8; ++j) o[j] = ((y[j] - mean) * rstd * gnw[j] + gnb[j] + bs * z[2][j]) * bf_at(gv, j);
        u32x4 wv; wv.x = pk_bf16(o[0], o[1]); wv.y = pk_bf16(o[2], o[3]); wv.z = pk_bf16(o[4], o[5]); wv.w = pk_bf16(o[6], o[7]);
        *(u32x4*)(MB + (size_t)row * D + 512 + c0) = wv;
    }
}

DI float gelu_tanh(float x) { const float u = 0.7978845608028654f * (x + 0.044715f * x * x * x); return 0.5f * x * (1.0f + tanh_fast(u)); }
__device__ void lru_run(const Params& p, int l, int n, int tile_first, int tile_stride, int tile_count, int mode, LAS unsigned char* lds, const int tid_) {
    const int tid = tid_, lane = tid & 63, w = tid >> 6, r = lane & 15, q = lane >> 4;
    LAS float* xcf = (LAS float*)lds;
    LAS bf16_t* Ab = (LAS bf16_t*)(lds + 16384);
    LAS float* aL = (LAS float*)(lds + 25600);
    LAS float* uL = (LAS float*)(lds + 58368);
    LAS float* agg = (LAS float*)(lds + 91136);
    LAS float* carry = (LAS float*)(lds + 95232);
    const bf16_t* P = (const bf16_t*)(p.ws + WS_P); bf16_t* MB = (bf16_t*)(p.ws + WS_XB); const bf16_t* LB = (const bf16_t*)(p.ws + WS_LB);
    f32x2* AGG = (f32x2*)(p.ws + WS_AGG);
    const int tok = tid >> 3, cg8 = tid & 7, ch0 = 64 * n + 8 * cg8;
    LAS float* cwl = (LAS float*)(lds + 95744);
    __syncthreads();
    if (tid < 320) { const int k = tid >> 6, c = tid & 63; cwl[tid] = k < 4 ? p.in[8][(l * 4 + k) * 512 + 64 * n + c] : p.in[9][l * 512 + 64 * n + c]; }
    const int gd = w >> 2, ct = w & 3, chl = 16 * ct + r, gc = 64 * n + chl;
    bf16x8 br[2], bi[2];
#pragma unroll
    for (int ks = 0; ks < 2; ++ks) { br[ks] = *(const bf16x8*)(LB + (size_t)(n * 256 + (gd * 2 + 0) * 64 + chl) * 64 + 32 * ks + 8 * q);
                                     bi[ks] = *(const bf16x8*)(LB + (size_t)(n * 256 + (gd * 2 + 1) * 64 + chl) * 64 + 32 * ks + 8 * q); }
    const float ba_c = p.in[11][(l * 2 + gd) * 512 + gc], bx_c = p.in[13][(l * 2 + gd) * 512 + gc];
    float sp_c; { const float lam = p.in[14][(l * 2 + gd) * 512 + gc]; const float e = exp_fast(-lam); sp_c = e < 0.1f ? e * (1.0f - e * (0.5f - e * (0.33333334f - e * (0.25f - e * 0.2f)))) : 0.6931471805599453f * __builtin_amdgcn_logf(1.0f + e); }
    const int sd = tid >> 8, sc = (tid >> 6) & 3, scn = tid & 63;
    const u32x4 zero4 = (u32x4){0u, 0u, 0u, 0u};
    u32x4 xr[4];
#define LRU_LOADX(gt_) do { const int t0g_ = (gt_) * 64; int s0_, len_; seq_of(t0g_, s0_, len_); \
        _Pragma("unroll") for (int k = 0; k < 4; ++k) { const int gr_ = t0g_ + tok - 2 + k; xr[k] = (gr_ >= s0_ && gr_ < s0_ + len_) ? *(const u32x4*)(P + (size_t)gr_ * NP + P_LX + ch0) : zero4; } } while (0)
    if (tile_count > 0) LRU_LOADX(tile_first);
    for (int it = 0; it < tile_count; ++it) {
        int tl_ = tid_; asm volatile("" : "+v"(tl_));
        const int tid = tl_, lane = tid & 63, w = tid >> 6, r = lane & 15, q = lane >> 4, tok = tid >> 3, cg8 = tid & 7, ch0 = 64 * n + 8 * cg8;
        const int gd = w >> 2, ct = w & 3, chl = 16 * ct + r, sd = tid >> 8, sc = (tid >> 6) & 3, scn = tid & 63;
        const int gt = tile_first + it * tile_stride, t0g = gt * 64; int s0, len; seq_of(t0g, s0, len);
        const int ti = (t0g - s0) >> 6, N = len >> 6;
        u32x4 gv = zero4;
        if (mode) gv = *(const u32x4*)(P + (size_t)(t0g + tok) * NP + P_LG + ch0);
        __syncthreads();
        {   float acc[8];
            { const f32x4 c0_ = *(const LAS f32x4*)(cwl + 256 + 8 * cg8), c1_ = *(const LAS f32x4*)(cwl + 256 + 8 * cg8 + 4);
#pragma unroll
              for (int j = 0; j < 4; ++j) { acc[j] = c0_[j]; acc[4 + j] = c1_[j]; } }
#pragma unroll
            for (int k = 0; k < 4; ++k) { const f32x4 c0_ = *(const LAS f32x4*)(cwl + 64 * k + 8 * cg8), c1_ = *(const LAS f32x4*)(cwl + 64 * k + 8 * cg8 + 4);
#pragma unroll
                for (int j = 0; j < 4; ++j) { acc[j] += c0_[j] * bf_at(xr[k], j); acc[4 + j] += c1_[j] * bf_at(xr[k], 4 + j); } }
            *(LAS f32x4*)(xcf + tok * 64 + 8 * cg8) = (f32x4){acc[0], acc[1], acc[2], acc[3]};
            *(LAS f32x4*)(xcf + tok * 64 + 8 * cg8 + 4) = (f32x4){acc[4], acc[5], acc[6], acc[7]};
            u32x4 wv; wv.x = pk_bf16(acc[0], acc[1]); wv.y = pk_bf16(acc[2], acc[3]); wv.z = pk_bf16(acc[4], acc[5]); wv.w = pk_bf16(acc[6], acc[7]);
            *(LAS u32x4*)(Ab + tok * 72 + 8 * cg8) = wv; }
        if (it + 1 < tile_count) LRU_LOADX(gt + tile_stride);
        float pA = 1.f, pH = 0.f;
        if (mode) { const int cnt = sd == 0 ? ti : N - 1 - ti, lo = (cnt * sc) >> 2, hi = (cnt * (sc + 1)) >> 2;
            const f32x2* ab = AGG + ((size_t)(gt - ti) * 8 + n) * 128 + sd * 64 + scn;
            f32x2 e[32];
#pragma unroll
            for (int u = 0; u < 32; ++u) { const int j = lo + u, tj = sd == 0 ? j : N - 1 - j; e[u] = j < hi ? ab[(size_t)tj * 1024] : (f32x2){1.f, 0.f}; }
#pragma unroll
            for (int u = 0; u < 32; ++u) { pH = e[u][0] * pH + e[u][1]; pA *= e[u][0]; } }
        __syncthreads();
        {   f32x4 accr[4], acci[4];
#pragma unroll
            for (int mt = 0; mt < 4; ++mt) { accr[mt] = (f32x4){0.f, 0.f, 0.f, 0.f}; acci[mt] = (f32x4){0.f, 0.f, 0.f, 0.f};
#pragma unroll
                for (int ks = 0; ks < 2; ++ks) { const bf16x8 a = *(const LAS bf16x8*)(Ab + (16 * mt + r) * 72 + 32 * ks + 8 * q);
                    accr[mt] = mfma16(a, br[ks], accr[mt]); acci[mt] = mfma16(a, bi[ks], acci[mt]); } }
            const int t0 = t0g - s0;
#pragma unroll
            for (int mt = 0; mt < 4; ++mt)
#pragma unroll
                for (int i = 0; i < 4; ++i) { const int tk = 16 * mt + 4 * q + i, tt = t0 + tk;
                    const float rg_ = sigm(accr[mt][i] + ba_c), ig_ = sigm(acci[mt][i] + bx_c);
                    const float la = -8.0f * rg_ * sp_c, a = exp_fast(la), e2 = 2.0f * la;
                    const float om = e2 > -0.05f ? -e2 * (1.0f + e2 * (0.5f + e2 * (0.16666667f + e2 * 0.041666668f))) : 1.0f - exp_fast(e2);
                    float mult = sqrtf(om); if (gd == 0 ? tt == 0 : tt == len - 1) mult = 1.0f;
                    const float u = mult * ig_ * xcf[tk * 64 + chl];
                    aL[(gd * 64 + tk) * 64 + chl] = a; uL[(gd * 64 + tk) * 64 + chl] = u; }
        }
        if (mode) { agg[((sd * 64 + scn) * 4 + sc) * 2 + 0] = pA; agg[((sd * 64 + scn) * 4 + sc) * 2 + 1] = pH; }
        __syncthreads();
        {
            float hh = 0.f;
            if (mode) {
#pragma unroll
                for (int s2 = 0; s2 < 4; ++s2) hh = agg[((sd * 64 + scn) * 4 + s2) * 2 + 0] * hh + agg[((sd * 64 + scn) * 4 + s2) * 2 + 1]; }
            float A = 1.f, H = 0.f;
#pragma unroll
            for (int j = 0; j < 16; ++j) { const int tk = sd == 0 ? 16 * sc + j : 63 - 16 * sc - j; const float a_ = aL[(sd * 64 + tk) * 64 + scn], u_ = uL[(sd * 64 + tk) * 64 + scn]; H = a_ * H + u_; A *= a_; }
            __syncthreads();
            agg[((sd * 64 + scn) * 4 + sc) * 2 + 0] = A; agg[((sd * 64 + scn) * 4 + sc) * 2 + 1] = H;
            __syncthreads();
            if (mode == 0) { if (sc == 0) { float tA = 1.f, tH = 0.f;
#pragma unroll
                    for (int s2 = 0; s2 < 4; ++s2) { const float a_ = agg[((sd * 64 + scn) * 4 + s2) * 2 + 0], h_ = agg[((sd * 64 + scn) * 4 + s2) * 2 + 1]; tH = a_ * tH + h_; tA *= a_; }
                    AGG[((size_t)gt * 8 + n) * 128 + sd * 64 + scn] = (f32x2){tA, tH}; } }
            else {
                for (int s2 = 0; s2 < sc; ++s2) hh = agg[((sd * 64 + scn) * 4 + s2) * 2 + 0] * hh + agg[((sd * 64 + scn) * 4 + s2) * 2 + 1];
#pragma unroll
                for (int j = 0; j < 16; ++j) { const int tk = sd == 0 ? 16 * sc + j : 63 - 16 * sc - j; hh = aL[(sd * 64 + tk) * 64 + scn] * hh + uL[(sd * 64 + tk) * 64 + scn]; uL[(sd * 64 + tk) * 64 + scn] = hh; }
            }
        }
        if (mode) {
            __syncthreads();
            const f32x4 f0 = *(const LAS f32x4*)(uL + tok * 64 + 8 * cg8), f1 = *(const LAS f32x4*)(uL + tok * 64 + 8 * cg8 + 4);
            const f32x4 b0 = *(const LAS f32x4*)(uL + (64 + tok) * 64 + 8 * cg8), b1 = *(const LAS f32x4*)(uL + (64 + tok) * 64 + 8 * cg8 + 4);
            float hv[8] = {f0[0] + b0[0], f0[1] + b0[1], f0[2] + b0[2], f0[3] + b0[3], f1[0] + b1[0], f1[1] + b1[1], f1[2] + b1[2], f1[3] + b1[3]};
#pragma unroll
            for (int j = 0; j < 8; ++j) hv[j] *= gelu_tanh(bf_at(gv, j));
            u32x4 wv; wv.x = pk_bf16(hv[0], hv[1]); wv.y = pk_bf16(hv[2], hv[3]); wv.z = pk_bf16(hv[4], hv[5]); wv.w = pk_bf16(hv[6], hv[7]);
            *(u32x4*)(MB + (size_t)(t0g + tok) * D + ch0) = wv;
        }
    }
#undef LRU_LOADX
}

#ifndef NCH
#define NCH 2
#endif
constexpr int FCH = NCH, FROWS = T / FCH, PER = 7 + 2 * FCH, N_PHASES = 1 + 2 * PER, ATTN_IN_SCAN = 0;
__device__ void run_phase(const Params& p, int ph, LAS unsigned char* lds, const int tid_) {
    bf16_t* XB = (bf16_t*)(p.ws + WS_XB); float* RS1 = (float*)(p.ws + WS_RS1); float* RS2 = (float*)(p.ws + WS_RS2);
    if (ph == 0) { wprep_phase(p, 0, lds, tid_); rowpass0(p, tid_); return; }
    const int l = (ph - 1) / PER, k = (ph - 1) % PER;
    if (k == 0) {
        pg8::Gemm g{XB, (const bf16_t*)(p.ws + WS_WIN), T, NP, D}; pg8::StaticOrder S; S.init(T, NP, (int)gridDim.x, (int)blockIdx.x);
        EpiBf16S E{(bf16_t*)(p.ws + WS_P), NP, nullptr, 0};
        pg8::gemm_phase<EpiBf16S, pg8::StaticOrder>(lds, g, S, E, nullptr, tid_);
    } else if (k == 1) {
        for (int u = ATTN_IN_SCAN + blockIdx.x; u < 3072; u += gridDim.x) { int t2 = tid_; asm volatile("" : "+v"(t2)); attn_unit(p, l, u, lds, t2); }
        for (int t = blockIdx.x; t < 768; t += gridDim.x) { int t2 = tid_; asm volatile("" : "+v"(t2)); rwkv_prep_tile(p, l, t, lds, t2); }
        { const int per = (int)gridDim.x >> 3; if ((int)blockIdx.x < per * 8) { const int first = (int)blockIdx.x >> 3; lru_run(p, l, (int)blockIdx.x & 7, first, per, (768 - first + per - 1) / per, 0, lds, tid_); } }
    } else if (k == 2) {
        for (int vb = blockIdx.x; vb < 256; vb += gridDim.x) {
#ifndef PROBE2
#define PROBE2 0
#endif
            if (vb < 192) { const int n = vb < 128 ? 1 : 4, b0 = vb < 128 ? vb : 128 + 4 * (vb - 128); for (int i = 0; i < n * (PROBE2 == 1 ? 2 : 1); ++i) rwkv_scan_task(p, l, b0 + (i % n), lds, tid_); }
            else { const int j = vb - 192; for (int rep = 0; rep < (PROBE2 == 2 ? 2 : 1); ++rep) lru_run(p, l, j & 7, j >> 3, 8, 96, 1, lds, tid_);
                for (int u = j; u < ATTN_IN_SCAN; u += 64) { int t2 = tid_; asm volatile("" : "+v"(t2)); attn_unit(p, l, u, lds, t2); } }
        }
    } else if (k == 3) { rwkv_final(p, l, tid_);
    } else if (k == 4) {
        pg8::Gemm g{XB, (const bf16_t*)(p.ws + WS_WOUT), T, D, D}; pg8::StaticOrder S; S.init(T, D, (int)gridDim.x, (int)blockIdx.x);
        EpiBf16S E{(bf16_t*)(p.ws + WS_F), D, nullptr, 0};
        pg8::gemm_phase<EpiBf16S, pg8::StaticOrder>(lds, g, S, E, nullptr, tid_);
    } else if (k == 5) { rowpass_post(p, (const bf16_t*)(p.ws + WS_F), p.in[3] + l * D, l == 0 ? 0 : 1, nullptr, RS2, 0, tid_);
    } else if (k < 6 + 2 * FCH) {
        const int th = (k - 6) >> 1; const size_t rb = (size_t)th * FROWS;
        if (((k - 6) & 1) == 0) {
            pg8::Gemm g{XB + rb * D, (const bf16_t*)(p.ws + WS_WUP), FROWS, DFF, D}; pg8::StaticOrder S; S.init(FROWS, DFF, (int)gridDim.x, (int)blockIdx.x);
            EpiBf16S E{(bf16_t*)(p.ws + WS_U), DFF, nullptr, 1};
            pg8::gemm_phase<EpiBf16S, pg8::StaticOrder>(lds, g, S, E, nullptr, tid_);
        } else {
            pg8::Gemm g{(const bf16_t*)(p.ws + WS_U), (const bf16_t*)(p.ws + WS_WDN), FROWS, D, DFF}; pg8::StaticOrder S; S.init(FROWS, D, (int)gridDim.x, (int)blockIdx.x);
            EpiBf16S E{(bf16_t*)(p.ws + WS_F) + rb * D, D, nullptr, 0};
            pg8::gemm_phase<EpiBf16S, pg8::StaticOrder>(lds, g, S, E, nullptr, tid_);
        }
    } else {
        rowpass_post(p, (const bf16_t*)(p.ws + WS_F), p.in[5] + l * D, 2, RS2, RS1, l == 0 ? 1 : 2, tid_);
        if (l == 0) wprep_phase(p, 1, lds, tid_);
    }
}

__global__ void __launch_bounds__(512, 2) hymba_mega(Params p) {
    extern __shared__ __attribute__((aligned(16))) unsigned char smem[];
    LAS unsigned char* lds = (LAS unsigned char*)smem;
    volatile LAS unsigned* bst = (volatile LAS unsigned*)(lds + 131072);
    unsigned* bar = (unsigned*)(p.ws + WS_BAR);
    const bool coop = p.ph_hi - p.ph_lo > 1;
    if (coop) {
        if (threadIdx.x < 2) bst[threadIdx.x] = 0u;
        if (blockIdx.x == 0) for (int i = threadIdx.x; i < XCD_BAR_WORDS; i += 512) bar[i] = 0u;
        __syncthreads();
    }
    XcdBarrier xb; xb.bar = bar; xb.x = 0; xb.st = bst;
    bool posted = false;
    for (int ph = p.ph_lo; ph < p.ph_hi; ++ph) {
        int nrep = 1;
#if PROBE_MASK
        if ((ph > 0 && ((PROBE_MASK >> ((ph - 1) % PER)) & 1)) || (ph == 0 && ((PROBE_MASK >> 30) & 1))) nrep = 2;
#endif
        for (int rep = 0; rep < nrep; ++rep) {
            int tid_ = (int)__builtin_amdgcn_workitem_id_x(); asm volatile("" : "+v"(tid_));
            run_phase(p, ph, lds, tid_);
            if (ph + 1 < p.ph_hi || rep + 1 < nrep) {
                if (!posted) { cg::this_grid().sync(); xb = xcd_barrier_post(bar, bst, tid_ == 0); posted = true; }
                else xcd_barrier(xb, tid_ == 0);
            }
        }
    }
}

#ifndef PROBE_MASK
#define PROBE_MASK 0
#endif
#ifndef N_LAUNCH_PER_PHASE
#define N_LAUNCH_PER_PHASE 1
#endif
extern "C" void kernel_launch(void* const* d_in, const int* in_sizes, int n_in, void* d_out, int out_size, void* d_ws, size_t ws_size, hipStream_t stream) {
    static int grid = 0;
    if (grid == 0) {
        if (n_in != 30 || ws_size < WS_END) { fprintf(stderr, "kernel_launch: unexpected n_in %d / ws_size %zu\n", n_in, ws_size); grid = -1; return; }
        int dev = 0, cus = 0, per_cu = 0;
        hipGetDevice(&dev); hipDeviceGetAttribute(&cus, hipDeviceAttributeMultiprocessorCount, dev);
        if (hipFuncSetAttribute((const void*)hymba_mega, hipFuncAttributeMaxDynamicSharedMemorySize, LDS_BYTES) != hipSuccess) { fprintf(stderr, "kernel_launch: hipFuncSetAttribute failed\n"); grid = -1; return; }
        if (hipOccupancyMaxActiveBlocksPerMultiprocessor(&per_cu, (const void*)hymba_mega, 512, LDS_BYTES) != hipSuccess || per_cu < 1) { fprintf(stderr, "kernel_launch: occupancy query says %d\n", per_cu); per_cu = 1; }
        (void)hipGetLastError();
        grid = cus * (per_cu > 1 ? 1 : per_cu);
    }
    if (grid < 0) return;
    Params p{};
    for (int i = 0; i < 30; ++i) p.in[i] = (const float*)d_in[i];
    p.out = (float*)d_out; p.ws = (unsigned char*)d_ws;
#if N_LAUNCH_PER_PHASE
    for (int ph = 0; ph < N_PHASES; ++ph) { p.ph_lo = ph; p.ph_hi = ph + 1; hipLaunchKernelGGL(hymba_mega, dim3(grid), dim3(512), LDS_BYTES, stream, p); }
#else
    p.ph_lo = 0; p.ph_hi = N_PHASES;
    void* args[] = {&p};
    hipError_t e = hipLaunchCooperativeKernel((const void*)hymba_mega, dim3(grid), dim3(512), args, LDS_BYTES, stream);
    if (e != hipSuccess) fprintf(stderr, "kernel_launch: cooperative launch failed: %s (grid %d)\n", hipGetErrorString(e), grid);
#endif
}
```

```cpp
#include <hip/hip_runtime.h>
#include <hip/hip_cooperative_groups.h>
#include <cstdio>
namespace cg = cooperative_groups;

#define LAS __attribute__((address_space(3)))
typedef float f32x2 __attribute__((ext_vector_type(2)));
typedef unsigned u32x2 __attribute__((ext_vector_type(2)));
typedef _Float16 f16x4 __attribute__((ext_vector_type(4)));
typedef _Float16 f16x8 __attribute__((ext_vector_type(8)));
#define N_LAUNCH_PER_PHASE 0
#define PROBE_MASK 0
#define PROBE2 0
#define NCH 6
namespace pg8 {
#define PG8_LAS __attribute__((address_space(3)))
typedef unsigned short bf16_t;
typedef short bf16x8 __attribute__((ext_vector_type(8)));
typedef float f32x4 __attribute__((ext_vector_type(4)));
typedef unsigned u32x4 __attribute__((ext_vector_type(4)));
constexpr int BM = 256, BK = 64, HALF = 128, HTB = HALF * BK * 2  , STAGE_BYTES = 8 * HTB, NXCD = 8, WGM = 8;

__host__ __device__ __forceinline__ int lds_byte(int r, int c) { const int st = (r >> 4) * 2 + (c >> 5), rr = r & 15, cc = c & 31, ob = rr * 64 + cc * 2; return st * 1024 + (ob ^ (((ob >> 9) & 1) << 5)); }
__host__ __device__ __forceinline__ void stage_rc(int b, int& R, int& C) { const int st = b / 1024, sb = b % 1024, swz = sb ^ (((sb >> 9) & 1) << 5); R = (st >> 1) * 16 + swz / 64; C = (st & 1) * 32 + (swz % 64) / 2; }
__host__ __device__ __forceinline__ int perm32(int rho) { const int n = rho >> 4, i = rho & 15; return 8 * (i >> 2) + 4 * n + (i & 3); }

struct Unit { int pm, pn; };
struct Gemm { const bf16_t* A; const bf16_t* Bt; int M, N, K; };

struct StaticOrder {
    int nM, nN, nwg, G, c;
    __host__ __device__ void init(int M, int N, int G_, int c_) { nM = M / BM; nN = N / BM; nwg = nM * nN; G = G_; c = c_; }
    __host__ __device__ bool next(int i, Unit& u) const {
        const long L = (long)i * G + c; if (L >= nwg) return false;
        int wgid = (int)L; { const int q = nwg / NXCD, r = nwg % NXCD, xcd = wgid % NXCD, off = wgid / NXCD; wgid = (xcd < r ? xcd * (q + 1) : r * (q + 1) + (xcd - r) * q) + off; }
        const int nig = WGM * nN, gid = wgid / nig, fm = gid * WGM, gsz = (nM - fm) < WGM ? (nM - fm) : WGM;
        u.pm = fm + ((wgid % nig) % gsz); u.pn = (wgid % nig) / gsz; return true;
    }
    __device__ __forceinline__ void a_ready(const Unit&) const {}
    __device__ __forceinline__ void done(const Unit&) const {}
};
__device__ __forceinline__ unsigned cvt_pk_bf16(float lo, float hi) { unsigned r; asm volatile("v_cvt_pk_bf16_f32 %0, %1, %2" : "=v"(r) : "v"(lo), "v"(hi)); return r; }
template <class Epi, class Sched, bool STAMP = false>
__device__ __forceinline__ void gemm_phase(PG8_LAS unsigned char* lds, const Gemm g, const Sched& S, const Epi& E, unsigned long long* stamps, const int tid_) {
    const int tid = tid_, wid = __builtin_amdgcn_readfirstlane(tid >> 6), lane = tid & 63, wr = wid >> 2, wc = wid & 3, fr = lane & 15, fq = lane >> 4;
    const int K = g.K, nt = K / BK;
    int ts_lo = 0, ts_hi = 0, nts = 0; const unsigned long long rt_entry = STAMP ? (unsigned long long)wall_clock64() : 0ull;
#define PG8_STAMP() do { if (STAMP && wid == 0 && nts < 64) { const unsigned long long _c = (unsigned long long)clock64(); \
        ts_lo = (lane == nts) ? (int)(unsigned)_c : ts_lo; ts_hi = (lane == nts) ? (int)(unsigned)(_c >> 32) : ts_hi; ++nts; } } while (0)
    PG8_STAMP();
    unsigned voffA[2], voffB[2];
#pragma unroll
    for (int i = 0; i < 2; ++i) { int R, C; stage_rc(tid * 16 + i * 8192, R, C); const int Rb = Epi::PERM ? ((R & ~31) + perm32(R & 31)) : R;
        voffA[i] = (unsigned)(R * K + C) * 2u; voffB[i] = (unsigned)(Rb * K + C) * 2u; }
    const size_t kstep = (size_t)(BK * 2);
    const size_t hstep = (size_t)HALF * K * 2;
    const size_t tstep = 2 * hstep;
    const unsigned ldsw = (unsigned)wid * 1024u;
    const int aoff = lds_byte(wr * 64 + fr, fq * 8), boff = lds_byte(wc * 32 + fr, fq * 8);
#define PG8_SA(b, h) (((b) * 2 + (h)) * HTB)
#define PG8_SB(b, h) ((4 + (b) * 2 + (h)) * HTB)
#define PG8_STAGE(bufoff, gbase, voff) do { _Pragma("unroll") for (int _i = 0; _i < 2; ++_i) \
        __builtin_amdgcn_global_load_lds((const unsigned*)((const char*)(gbase) + (voff)[_i]), (PG8_LAS unsigned*)(lds + (bufoff) + ldsw + _i * 8192), 16, 0, 0); } while (0)
#define PG8_LDA(dst, b, h) do { _Pragma("unroll") for (int m = 0; m < 4; ++m) _Pragma("unroll") for (int k = 0; k < 2; ++k) dst[m][k] = *(const PG8_LAS bf16x8*)(lds + PG8_SA(b, h) + aoff + m * 2048 + k * 1024); } while (0)
#define PG8_LDB(dst, b, h) do { _Pragma("unroll") for (int n = 0; n < 2; ++n) _Pragma("unroll") for (int k = 0; k < 2; ++k) dst[n][k] = *(const PG8_LAS bf16x8*)(lds + PG8_SB(b, h) + boff + n * 2048 + k * 1024); } while (0)
#define PG8_MMA(ai, bj, At, Bt) do { __builtin_amdgcn_s_setprio(1); _Pragma("unroll") for (int m = 0; m < 4; ++m) _Pragma("unroll") for (int n = 0; n < 2; ++n) _Pragma("unroll") for (int k = 0; k < 2; ++k) \
        acc[ai][bj][m][n] = __builtin_amdgcn_mfma_f32_16x16x32_bf16(Bt[n][k], At[m][k], acc[ai][bj][m][n], 0, 0, 0); __builtin_amdgcn_s_setprio(0); } while (0)
#define PG8_WAIT_V(n) asm volatile("s_waitcnt vmcnt(" #n ")" ::: "memory")
#define PG8_WAIT_L(n) asm volatile("s_waitcnt lgkmcnt(" #n ")" ::: "memory")
#define PG8_BAR __builtin_amdgcn_s_barrier()
#define PG8_SCHED __builtin_amdgcn_sched_barrier(0)
    Unit cur, nxt; int ui = 0;
    if (!S.next(0, cur)) return;
    f32x4 acc[2][2][4][2];
#pragma unroll
    for (int a = 0; a < 2; ++a)
#pragma unroll
        for (int b = 0; b < 2; ++b)
#pragma unroll
            for (int m = 0; m < 4; ++m)
#pragma unroll
                for (int n = 0; n < 2; ++n) acc[a][b][m][n] = (f32x4){0.f, 0.f, 0.f, 0.f};
    bf16x8 At[4][2], B0[2][2], B1[2][2];
    const char* cA = (const char*)g.A + (size_t)cur.pm * tstep; const char* cB = (const char*)g.Bt + (size_t)cur.pn * tstep;
    S.a_ready(cur);
    PG8_STAGE(PG8_SB(0, 0), cB, voffB); PG8_STAGE(PG8_SA(0, 0), cA, voffA); PG8_STAGE(PG8_SB(0, 1), cB + hstep, voffB); PG8_STAGE(PG8_SA(0, 1), cA + hstep, voffA);
    if (wr == 1) PG8_BAR;
    PG8_WAIT_V(4); PG8_BAR;
    PG8_STAGE(PG8_SB(1, 0), cB + kstep, voffB); PG8_STAGE(PG8_SA(1, 0), cA + kstep, voffA); PG8_STAGE(PG8_SB(1, 1), cB + hstep + kstep, voffB);
    PG8_WAIT_V(6); PG8_BAR;
    PG8_STAMP();
    for (;;) {
        const bool has_next = S.next(ui + 1, nxt);
        const char* nA = has_next ? (const char*)g.A + (size_t)nxt.pm * tstep : cA; const char* nB = has_next ? (const char*)g.Bt + (size_t)nxt.pn * tstep : cB;
        for (int t = 0; t < nt; t += 2) {
            const bool last = (t == nt - 2);
            const char* a1 = cA + (size_t)(t + 1) * kstep;
            const char* a2 = last ? nA : cA + (size_t)(t + 2) * kstep; const char* b2 = last ? nB : cB + (size_t)(t + 2) * kstep;
            const char* a3 = a2 + kstep; const char* b3 = b2 + kstep;
            if (last && has_next) S.a_ready(nxt);
            PG8_LDB(B0, 0, 0); PG8_SCHED; PG8_LDA(At, 0, 0); PG8_STAGE(PG8_SA(1, 1), a1 + hstep, voffA);
            PG8_WAIT_L(8); PG8_BAR; PG8_WAIT_L(0); PG8_MMA(0, 0, At, B0); PG8_BAR; PG8_SCHED;
            PG8_LDB(B1, 0, 1); PG8_STAGE(PG8_SB(0, 0), b2, voffB);
            PG8_BAR; PG8_WAIT_L(0); PG8_MMA(0, 1, At, B1); PG8_BAR;
            PG8_LDA(At, 0, 1); PG8_STAGE(PG8_SA(0, 0), a2, voffA);
            PG8_BAR; PG8_WAIT_L(0); PG8_MMA(1, 0, At, B0); PG8_BAR; PG8_SCHED;
            PG8_STAGE(PG8_SB(0, 1), b2 + hstep, voffB);
            PG8_WAIT_V(6); PG8_BAR; PG8_MMA(1, 1, At, B1); PG8_BAR;
            PG8_LDB(B0, 1, 0); PG8_SCHED; PG8_LDA(At, 1, 0); PG8_STAGE(PG8_SA(0, 1), a2 + hstep, voffA);
            PG8_WAIT_L(8); PG8_BAR; PG8_WAIT_L(0); PG8_MMA(0, 0, At, B0); PG8_BAR; PG8_SCHED;
            PG8_LDB(B1, 1, 1); PG8_STAGE(PG8_SB(1, 0), b3, voffB);
            PG8_BAR; PG8_WAIT_L(0); PG8_MMA(0, 1, At, B1); PG8_BAR;
            PG8_LDA(At, 1, 1); PG8_STAGE(PG8_SA(1, 0), a3, voffA);
            PG8_BAR; PG8_WAIT_L(0); PG8_MMA(1, 0, At, B0); PG8_BAR; PG8_SCHED;
            PG8_STAGE(PG8_SB(1, 1), b3 + hstep, voffB);
            PG8_WAIT_V(6); PG8_BAR; PG8_MMA(1, 1, At, B1); PG8_BAR;
        }
        PG8_STAMP();
        if constexpr (!Epi::AFTER_DRAIN) { E(acc, cur, wr, wc, fr, fq); S.done(cur); }
        PG8_STAMP();
        if (!has_next) break;
#pragma unroll
        for (int a = 0; a < 2; ++a)
#pragma unroll
            for (int b = 0; b < 2; ++b)
#pragma unroll
                for (int m = 0; m < 4; ++m)
#pragma unroll
                    for (int n = 0; n < 2; ++n) acc[a][b][m][n] = (f32x4){0.f, 0.f, 0.f, 0.f};
        cur = nxt; cA = nA; cB = nB; ++ui;
    }
    PG8_WAIT_V(0);
    if (wr == 0) PG8_BAR;
    PG8_BAR;
    if constexpr (Epi::AFTER_DRAIN) { E.fused(acc, cur, wr, wc, fr, fq, lds, wid, lane); S.done(cur); }
    PG8_STAMP();
    if (STAMP && wid == 0) { stamps[lane] = lane < nts ? (((unsigned long long)(unsigned)ts_hi << 32) | (unsigned)ts_lo) : 0ull;
        if (lane == 62) stamps[62] = rt_entry; if (lane == 63) stamps[63] = (unsigned long long)wall_clock64(); }
#undef PG8_STAMP
#undef PG8_SA
#undef PG8_SB
#undef PG8_STAGE
#undef PG8_LDA
#undef PG8_LDB
#undef PG8_MMA
#undef PG8_WAIT_V
#undef PG8_WAIT_L
#undef PG8_BAR
#undef PG8_SCHED
}
}
#define XB_TMO      128
#define XB_XCNT(j)  (256  + 64 * (j))
#define XB_XSUB(j)  (1280 + 64 * (j))
#define XB_XGEN(j)  (2304 + 64 * (j))
#define XB_TOP      3328
#define XB_TOPGEN   3392
#define XCD_BAR_WORDS 3456
#define XB_SPIN_CAP (1u << 18)

__device__ __forceinline__ unsigned xb_ld(unsigned* p)              { return __hip_atomic_load(p, __ATOMIC_RELAXED, __HIP_MEMORY_SCOPE_AGENT); }
__device__ __forceinline__ unsigned xb_add(unsigned* p, unsigned v) { return __hip_atomic_fetch_add(p, v, __ATOMIC_RELAXED, __HIP_MEMORY_SCOPE_AGENT); }
__device__ __forceinline__ unsigned xb_xcc_id() { return (unsigned)__builtin_amdgcn_s_getreg((3 << 11) | 20) & 0xFu; }
#define XB_SPIN(cond, bar) do { unsigned _sp = 0; while (cond) { __builtin_amdgcn_s_sleep(1); \
    if ((++_sp & 255u) == 0u) { if (xb_ld(&(bar)[XB_TMO])) break; if (_sp > XB_SPIN_CAP) { atomicAdd(&(bar)[XB_TMO], 1u); break; } } } } while (0)

struct XcdBarrier {
    unsigned* bar; unsigned x;
    volatile LAS unsigned* st;
};

__device__ __forceinline__ XcdBarrier xcd_barrier_post(unsigned* bar, volatile LAS unsigned* st, const bool tid0_) {
    XcdBarrier b; b.bar = bar; b.x = xb_xcc_id(); b.st = st;
    if (tid0_) (void)xb_add(&bar[XB_XCNT(b.x)], 1u);
    return b;
}
__device__ __forceinline__ void xcd_barrier_complete(unsigned* bar, unsigned x, unsigned& nloc, unsigned& nx) {
    const unsigned G = gridDim.x * gridDim.y * gridDim.z;
    unsigned sum, cnt, mine, sp = 0u;
    for (;;) {
        sum = 0u; cnt = 0u; mine = 0u;
#pragma unroll
        for (unsigned j = 0; j < 16; ++j) { const unsigned c = xb_ld(&bar[XB_XCNT(j)]); sum += c; cnt += (c > 0u) ? 1u : 0u; mine = (j == x) ? c : mine; }
        if (sum == G) break;
        __builtin_amdgcn_s_sleep(1);
        if ((++sp & 255u) == 0u) { if (xb_ld(&bar[XB_TMO])) break; if (sp > XB_SPIN_CAP) { atomicAdd(&bar[XB_TMO], 1u); break; } }
    }
    nloc = mine > 0u ? mine : 1u; nx = cnt > 0u ? cnt : 1u;
}

__device__ __forceinline__ void xcd_barrier(const XcdBarrier& b, const bool tid0_) {
    asm volatile("s_waitcnt vmcnt(0)" ::: "memory");
    __syncthreads();
    if (tid0_) {
        unsigned* bar = b.bar;
        __builtin_amdgcn_s_waitcnt(0);
        unsigned nloc = b.st[0], nx = b.st[1];
        if (nloc == 0u) { xcd_barrier_complete(bar, b.x, nloc, nx); b.st[0] = nloc; b.st[1] = nx; }
        const unsigned old = xb_add(&bar[XB_XSUB(b.x)], 1u);
        const unsigned gen = old / nloc;
        if (old + 1u == (gen + 1u) * nloc) {
            __builtin_amdgcn_fence(__ATOMIC_RELEASE, "agent");
            asm volatile("s_waitcnt vmcnt(0)" ::: "memory");
            const unsigned og = xb_add(&bar[XB_TOP], 1u);
            const unsigned tg = og / nx;
            if (og + 1u == (tg + 1u) * nx) xb_add(&bar[XB_TOPGEN], 1u);
            else XB_SPIN(xb_ld(&bar[XB_TOPGEN]) == tg, bar);
            __builtin_amdgcn_fence(__ATOMIC_ACQUIRE, "agent");
            xb_add(&bar[XB_XGEN(b.x)], 1u);
            asm volatile("s_waitcnt vmcnt(0)" ::: "memory");
        } else {
            XB_SPIN(xb_ld(&bar[XB_XGEN(b.x)]) == gen, bar);
            __builtin_amdgcn_fence(__ATOMIC_ACQUIRE, "agent");
            asm volatile("s_waitcnt vmcnt(0)" ::: "memory");
        }
    }
    __syncthreads();
}

using pg8::bf16_t; using pg8::bf16x8; using pg8::f32x4; using pg8::u32x4;

constexpr int T = 49152, D = 2048, NP = 4608, DFF = 8192;
constexpr int P_K = 1024, P_V = 1280, P_LX = 1536, P_LG = 2048, P_RW = 2560;
constexpr size_t MiB = (size_t)1 << 20;
constexpr size_t WS_WIN = 0, WS_WOUT = WS_WIN + (size_t)NP * D * 2, WS_WUP = WS_WOUT + (size_t)D * D * 2, WS_WDN = WS_WUP + (size_t)DFF * D * 2;
constexpr size_t WS_SMALL = 90 * MiB, WS_LB = WS_SMALL, WS_W2T = WS_SMALL + 262144, WS_A2T = WS_SMALL + 393216, WS_G2T = WS_SMALL + 524288,
                 WS_RS1 = WS_SMALL + 1048576, WS_RS2 = WS_SMALL + 1310720, WS_BAR = WS_SMALL + 1572864;
constexpr size_t WS_XB = 92 * MiB, WS_P = 284 * MiB, WS_PREP = 716 * MiB, WS_YFB = 908 * MiB, WS_AGG = 1004 * MiB, WS_END = 1012 * MiB;
constexpr size_t WS_F = WS_P, WS_U = 476 * MiB;
constexpr int LDS_BYTES = 131072 + 16;

struct Params { const float* in[30]; float* out; unsigned char* ws; int ph_lo, ph_hi; };

#define DI __device__ __forceinline__
DI unsigned pk_bf16(float lo, float hi) { unsigned r; asm("v_cvt_pk_bf16_f32 %0, %1, %2" : "=v"(r) : "v"(lo), "v"(hi)); return r; }
DI float bf_lo(unsigned w) { return __uint_as_float(w << 16); }
DI float bf_hi(unsigned w) { return __uint_as_float(w & 0xffff0000u); }
DI float bf_at(const u32x4& v, int j) { const unsigned w = v[j >> 1]; return (j & 1) ? bf_hi(w) : bf_lo(w); }
DI float sigm(float x) { return __builtin_amdgcn_rcpf(1.0f + __builtin_amdgcn_exp2f(-1.4426950408889634f * x)); }
DI float tanh_fast(float x) { return 1.0f - 2.0f * __builtin_amdgcn_rcpf(1.0f + __builtin_amdgcn_exp2f(2.8853900817779268f * x)); }
DI float exp_fast(float x) { return __builtin_amdgcn_exp2f(1.4426950408889634f * x); }
DI void seq_of(int row, int& s0, int& len) { if (row < 16384) { s0 = row & ~2047; len = 2048; } else { s0 = 16384 + ((row - 16384) & ~8191); len = 8192; } }
DI f32x4 mfma16(bf16x8 a, bf16x8 b, f32x4 c) { return __builtin_amdgcn_mfma_f32_16x16x32_bf16(a, b, c, 0, 0, 0); }

struct EpiBf16S {
    static constexpr bool PERM = true, AFTER_DRAIN = false;
    bf16_t* O; int ldc; const float* rs; int act;
    __device__ __forceinline__ void operator()(const f32x4 (&acc)[2][2][4][2], const pg8::Unit& u, int wr, int wc, int fr, int fq) const {
        const int row0 = u.pm * 256 + wr * 64 + fr, col0 = u.pn * 256 + wc * 32 + 8 * fq;
#pragma unroll
        for (int ai = 0; ai < 2; ++ai)
#pragma unroll
            for (int m = 0; m < 4; ++m) { const int row = row0 + ai * 128 + m * 16; const float s = rs ? rs[row] : 1.0f; bf16_t* rowp = O + (size_t)row * ldc + col0;
#pragma unroll
                for (int bj = 0; bj < 2; ++bj) { f32x4 v0 = acc[ai][bj][m][0] * s, v1 = acc[ai][bj][m][1] * s;
                    if (act) {
#pragma unroll
                        for (int j = 0; j < 4; ++j) { const float a = fmaxf(v0[j], 0.f), b = fmaxf(v1[j], 0.f); v0[j] = a * a; v1[j] = b * b; } }
                    u32x4 w; w.x = pk_bf16(v0[0], v0[1]); w.y = pk_bf16(v0[2], v0[3]); w.z = pk_bf16(v1[0], v1[1]); w.w = pk_bf16(v1[2], v1[3]);
                    *(u32x4*)(rowp + bj * 128) = w; } }
    }
};
struct EpiF32S {
    static constexpr bool PERM = false, AFTER_DRAIN = false;
    float* C; int ldc;
    __device__ __forceinline__ void operator()(const f32x4 (&acc)[2][2][4][2], const pg8::Unit& u, int wr, int wc, int fr, int fq) const {
        const int row0 = u.pm * 256 + wr * 64 + fr, col0 = u.pn * 256 + wc * 32 + 4 * fq;
#pragma unroll
        for (int ai = 0; ai < 2; ++ai)
#pragma unroll
            for (int m = 0; m < 4; ++m) { float* rowp = C + (size_t)(row0 + ai * 128 + m * 16) * ldc + col0;
#pragma unroll
                for (int bj = 0; bj < 2; ++bj)
#pragma unroll
                    for (int n = 0; n < 2; ++n) *(f32x4*)(rowp + bj * 128 + n * 16) = acc[ai][bj][m][n]; }
    }
};

struct WTile { const float* W; bf16_t* Wt; const float* gain; int ldw, k0, srcn0, ldt, dstn0; };
DI WTile wtile_of(int id, const float* w_in, const float* w_out, const float* w_up, const float* w_dn, const float* g_mix, const float* g_ffn, unsigned char* ws) {
    WTile t;
    if (id < 2304) { const int kt = id & 31, nt = id >> 5, dn = nt * 64; t = WTile{w_in, (bf16_t*)(ws + WS_WIN), g_mix, 4480, kt * 64, dn < 1536 ? dn + 2944 : (dn < 4480 ? dn - 1536 : -1), D, dn}; }
    else if (id < 3328) { const int j = id - 2304, kt = j & 31, nt = j >> 5; t = WTile{w_out, (bf16_t*)(ws + WS_WOUT), nullptr, D, kt * 64, nt * 64, D, nt * 64}; }
    else if (id < 7424) { const int j = id - 3328, kt = j & 31, nt = j >> 5; t = WTile{w_up, (bf16_t*)(ws + WS_WUP), g_ffn, DFF, kt * 64, nt * 64, D, nt * 64}; }
    else { const int j = id - 7424, kt = j & 127, nt = j >> 7; t = WTile{w_dn, (bf16_t*)(ws + WS_WDN), nullptr, D, kt * 64, nt * 64, DFF, nt * 64}; }
    return t; }
DI void wtile_load(const WTile& t, int tid, float4 (&v)[2]) {
#pragma unroll
    for (int it = 0; it < 2; ++it) { const int kk = (tid >> 4) + 32 * it, n4 = (tid & 15) * 4; v[it] = make_float4(0.f, 0.f, 0.f, 0.f);
        if (t.srcn0 >= 0) { v[it] = *(const float4*)(t.W + (size_t)(t.k0 + kk) * t.ldw + t.srcn0 + n4); if (t.gain) { const float g = t.gain[t.k0 + kk]; v[it].x *= g; v[it].y *= g; v[it].z *= g; v[it].w *= g; } } } }
__device__ void wprep_phase(const Params& p, int l, LAS unsigned char* lds, const int tid_) {
    LAS float* tile = (LAS float*)lds; const int tid = tid_;
    const float* w_in = p.in[6] + (size_t)l * D * 4480; const float* w_out = p.in[7] + (size_t)l * D * D;
    const float* w_up = p.in[28] + (size_t)l * D * DFF; const float* w_dn = p.in[29] + (size_t)l * DFF * D;
    const float* g_mix = p.in[2] + l * D; const float* g_ffn = p.in[4] + l * D;
    float4 v[2], vn[2];
    int id = blockIdx.x;
    WTile t = wtile_of(id < 11520 ? id : 0, w_in, w_out, w_up, w_dn, g_mix, g_ffn, p.ws);
    if (id < 11520) wtile_load(t, tid, v);
    for (; id < 11520; id += gridDim.x) {
        const int idn = id + gridDim.x;
        const WTile tn = wtile_of(idn < 11520 ? idn : 0, w_in, w_out, w_up, w_dn, g_mix, g_ffn, p.ws);
        if (idn < 11520) wtile_load(tn, tid, vn);
#pragma unroll
        for (int it = 0; it < 2; ++it) { const int kk = (tid >> 4) + 32 * it, n4 = (tid & 15) * 4;
            tile[kk * 65 + n4 + 0] = v[it].x; tile[kk * 65 + n4 + 1] = v[it].y; tile[kk * 65 + n4 + 2] = v[it].z; tile[kk * 65 + n4 + 3] = v[it].w; }
        __syncthreads();
        { const int nn = tid >> 3, kc = tid & 7; float e[8];
#pragma unroll
          for (int j = 0; j < 8; ++j) e[j] = tile[(8 * kc + j) * 65 + nn];
          u32x4 w; w.x = pk_bf16(e[0], e[1]); w.y = pk_bf16(e[2], e[3]); w.z = pk_bf16(e[4], e[5]); w.w = pk_bf16(e[6], e[7]);
          *(u32x4*)(t.Wt + (size_t)(t.dstn0 + nn) * t.ldt + t.k0 + 8 * kc) = w; }
        __syncthreads();
        t = tn; v[0] = vn[0]; v[1] = vn[1];
    }
    const int gt = blockIdx.x * 512 + tid_, gs = gridDim.x * 512;
    bf16_t* LB = (bf16_t*)(p.ws + WS_LB); bf16_t* W2T = (bf16_t*)(p.ws + WS_W2T); bf16_t* A2T = (bf16_t*)(p.ws + WS_A2T); bf16_t* G2T = (bf16_t*)(p.ws + WS_G2T);
    const float* wa = p.in[10] + (size_t)l * 65536; const float* wx = p.in[12] + (size_t)l * 65536;
    for (int e = gt; e < 131072; e += gs) { const int i = e & 63, c = (e >> 6) & 63, gate = (e >> 12) & 1, d = (e >> 13) & 1, n = e >> 14;
        const float v = (gate ? wx : wa)[((d * 8 + n) * 64 + i) * 64 + c]; LB[e] = (bf16_t)(pk_bf16(v, 0.f) & 0xffffu); }
    const float* w2 = p.in[17] + (size_t)l * 65536; const float* a2 = p.in[19] + (size_t)l * 65536; const float* g2 = p.in[20] + (size_t)l * 65536;
    for (int e = gt; e < 65536; e += gs) { const int rk = e & 63, c = (e >> 6) & 511, d = e >> 15;
        W2T[e] = (bf16_t)(pk_bf16(w2[(d * 64 + rk) * 512 + c], 0.f) & 0xffffu); A2T[e] = (bf16_t)(pk_bf16(a2[(d * 64 + rk) * 512 + c], 0.f) & 0xffffu); }
    for (int e = gt; e < 65536; e += gs) { const int rk = e & 127, c = e >> 7; G2T[e] = (bf16_t)(pk_bf16(g2[rk * 512 + c], 0.f) & 0xffffu); }
}

DI float wave_sum(float v) {
#pragma unroll
    for (int o = 32; o >= 1; o >>= 1) v += __shfl_xor(v, o);
    return v; }
__device__ void rowpass0(const Params& p, const int tid_) {
    const int lane = tid_ & 63, gw = blockIdx.x * 8 + (tid_ >> 6), nw = gridDim.x * 8;
    bf16_t* XB = (bf16_t*)(p.ws + WS_XB); float* RS1 = (float*)(p.ws + WS_RS1);
    for (int row = gw; row < T; row += nw) {
        const float* src = row < 16384 ? p.in[0] + (size_t)row * D : p.in[1] + (size_t)(row - 16384) * D;
        float ss = 0.f; float4 v[8];
#pragma unroll
        for (int i = 0; i < 8; ++i) { v[i] = ((const float4*)src)[lane + 64 * i]; ss += v[i].x * v[i].x + v[i].y * v[i].y + v[i].z * v[i].z + v[i].w * v[i].w; }
        ss = wave_sum(ss);
        const float rs = rsqrtf(ss * (1.0f / 2048.0f) + 1e-6f);
#pragma unroll
        for (int i = 0; i < 8; ++i) { u32x2 w; w.x = pk_bf16(v[i].x * rs, v[i].y * rs); w.y = pk_bf16(v[i].z * rs, v[i].w * rs); *(u32x2*)(XB + (size_t)row * D + 4 * (lane + 64 * i)) = w; }
        if (lane == 0) RS1[row] = rs;
    }
}
__device__ void rowpass_post(const Params& p, const bf16_t* Y, const float* gpost, int xmode, const float* RSin, float* RS, int outmode, const int tid_) {
    const int lane = tid_ & 63, gw = blockIdx.x * 8 + (tid_ >> 6), nw = gridDim.x * 8;
    bf16_t* XB = (bf16_t*)(p.ws + WS_XB); bf16_t* XS = (bf16_t*)p.out;
    float g[4][8];
#pragma unroll
    for (int i = 0; i < 4; ++i)
#pragma unroll
        for (int j = 0; j < 8; ++j) g[i][j] = gpost[8 * (lane + 64 * i) + j];
    for (int row = gw; row < T; row += nw) {
        float y[4][8], x[4][8]; float ss = 0.f;
#pragma unroll
        for (int i = 0; i < 4; ++i) { const size_t off = (size_t)row * D + 8 * (lane + 64 * i);
            const u32x4 yv = *(const u32x4*)(Y + off);
#pragma unroll
            for (int j = 0; j < 8; ++j) { y[i][j] = bf_at(yv, j); ss += y[i][j] * y[i][j]; }
            if (xmode == 0) { const float* xs = row < 16384 ? p.in[0] + off : p.in[1] + (off - (size_t)16384 * D);
                const float4 a = *(const float4*)xs, b = *(const float4*)(xs + 4);
                x[i][0] = a.x; x[i][1] = a.y; x[i][2] = a.z; x[i][3] = a.w; x[i][4] = b.x; x[i][5] = b.y; x[i][6] = b.z; x[i][7] = b.w; }
            else { const u32x4 xv = *(const u32x4*)((xmode == 1 ? XS : XB) + off); const float us = xmode == 2 ? 1.0f / RSin[row] : 1.0f;
#pragma unroll
                for (int j = 0; j < 8; ++j) x[i][j] = bf_at(xv, j) * us; } }
        ss = wave_sum(ss);
        const float ry = rsqrtf(ss * (1.0f / 2048.0f) + 1e-6f);
        float s2 = 0.f;
#pragma unroll
        for (int i = 0; i < 4; ++i)
#pragma unroll
            for (int j = 0; j < 8; ++j) { x[i][j] += y[i][j] * ry * g[i][j]; s2 += x[i][j] * x[i][j]; }
        s2 = wave_sum(s2);
        const float rsn = rsqrtf(s2 * (1.0f / 2048.0f) + 1e-6f);
#pragma unroll
        for (int i = 0; i < 4; ++i) { const size_t off = (size_t)row * D + 8 * (lane + 64 * i);
            if (outmode == 2) { *(float4*)(p.out + off) = make_float4(x[i][0], x[i][1], x[i][2], x[i][3]); *(float4*)(p.out + off + 4) = make_float4(x[i][4], x[i][5], x[i][6], x[i][7]); }
            else { u32x4 w; w.x = pk_bf16(x[i][0] * rsn, x[i][1] * rsn); w.y = pk_bf16(x[i][2] * rsn, x[i][3] * rsn); w.z = pk_bf16(x[i][4] * rsn, x[i][5] * rsn); w.w = pk_bf16(x[i][6] * rsn, x[i][7] * rsn);
                *(u32x4*)(XB + off) = w;
                if (outmode == 1) { u32x4 u; u.x = pk_bf16(x[i][0], x[i][1]); u.y = pk_bf16(x[i][2], x[i][3]); u.z = pk_bf16(x[i][4], x[i][5]); u.w = pk_bf16(x[i][6], x[i][7]); *(u32x4*)(XS + off) = u; } } }
        if (outmode != 2 && lane == 0) RS[row] = rsn;
    }
}

__device__ void attn_unit(const Params& p, int l, int unit, LAS unsigned char* lds, const int tid_) {
    const int tid = tid_, lane = tid & 63, w = tid >> 6, r = lane & 15, q = lane >> 4;
    const int qb = unit >> 3, hq = unit & 7, kvh = hq >> 2;
    const int g0 = qb * 128; int s0, len; seq_of(g0, s0, len);
    const bf16_t* P = (const bf16_t*)(p.ws + WS_P); bf16_t* MB = (bf16_t*)(p.ws + WS_XB);
    LAS bf16_t* Ks = (LAS bf16_t*)lds;
    LAS bf16_t* Vt = (LAS bf16_t*)(lds + 34816);
    LAS float* btab = (LAS float*)(lds + 69632);
    const int ql = 16 * w + r;
    __syncthreads();
    {
        const int rel = tid - 256, n = rel < 0 ? -rel : rel;
        const int bkt = (rel > 0 ? 16 : 0) + (n < 8 ? n : n < 12 ? 8 : n < 16 ? 9 : n < 23 ? 10 : n < 32 ? 11 : n < 46 ? 12 : n < 64 ? 13 : n < 91 ? 14 : 15);
        btab[tid] = n <= 128 ? p.in[27][bkt * 8 + hq] : -1e30f; }
    bf16x8 qf[4];
#pragma unroll
    for (int ks = 0; ks < 4; ++ks) qf[ks] = *(const bf16x8*)(P + (size_t)(g0 + ql) * NP + hq * 128 + 32 * ks + 8 * q);
    float m = p.in[26][l * 8 + hq], lsum = q == 0 ? 1.0f : 0.0f; f32x4 o[8];
#pragma unroll
    for (int dt = 0; dt < 8; ++dt) o[dt] = (f32x4){0.f, 0.f, 0.f, 0.f};
    const float scale = 0.08838834764831845f;
#pragma unroll 1
    for (int kbi = 0; kbi < 3; ++kbi) {
        const int gk0 = g0 + (kbi - 1) * 128;
        if (gk0 < s0 || gk0 >= s0 + len) continue;
        __syncthreads();
#pragma unroll
        for (int i = 0; i < 4; ++i) { const int id = tid + 512 * i, row = id >> 4, ch = id & 15;
            const u32x4 v = *(const u32x4*)(P + (size_t)(gk0 + row) * NP + P_K + kvh * 128 + 8 * ch); *(LAS u32x4*)(Ks + row * 136 + 8 * ch) = v; }
#pragma unroll
        for (int i = 0; i < 4; ++i) { const int id = tid + 512 * i, key = id & 127, dc = id >> 7;
            const u32x4 v = *(const u32x4*)(P + (size_t)(gk0 + key) * NP + P_V + kvh * 128 + 8 * dc);
#pragma unroll
            for (int j = 0; j < 4; ++j) { Vt[(8 * dc + 2 * j) * 136 + key] = (bf16_t)(v[j] & 0xffffu); Vt[(8 * dc + 2 * j + 1) * 136 + key] = (bf16_t)(v[j] >> 16); } }
        __syncthreads();
        f32x4 s[8];
#pragma unroll
        for (int kt = 0; kt < 8; ++kt) { f32x4 acc = (f32x4){0.f, 0.f, 0.f, 0.f};
#pragma unroll
            for (int ks = 0; ks < 4; ++ks) { const bf16x8 a = *(const LAS bf16x8*)(Ks + (16 * kt + r) * 136 + 32 * ks + 8 * q); acc = mfma16(a, qf[ks], acc); }
            s[kt] = acc; }
        float mx = -1e30f;
        const LAS float* bt = btab + ((kbi - 1) * 128 + 4 * q - ql + 256);
#pragma unroll
        for (int kt = 0; kt < 8; ++kt)
#pragma unroll
            for (int i = 0; i < 4; ++i) { const float v = s[kt][i] * scale + bt[16 * kt + i]; s[kt][i] = v; mx = fmaxf(mx, v); }
        mx = fmaxf(mx, __shfl_xor(mx, 16)); mx = fmaxf(mx, __shfl_xor(mx, 32));
        const float mn = fmaxf(m, mx), alpha = exp_fast(m - mn); m = mn;
        float ps = 0.f;
#pragma unroll
        for (int kt = 0; kt < 8; ++kt)
#pragma unroll
            for (int i = 0; i < 4; ++i) { const float pv = exp_fast(s[kt][i] - mn); s[kt][i] = pv; ps += pv; }
        lsum = lsum * alpha + ps;
#pragma unroll
        for (int dt = 0; dt < 8; ++dt) o[dt] *= alpha;
#pragma unroll
        for (int kk = 0; kk < 4; ++kk) {
            u32x4 pw; pw.x = pk_bf16(s[2 * kk][0], s[2 * kk][1]); pw.y = pk_bf16(s[2 * kk][2], s[2 * kk][3]); pw.z = pk_bf16(s[2 * kk + 1][0], s[2 * kk + 1][1]); pw.w = pk_bf16(s[2 * kk + 1][2], s[2 * kk + 1][3]);
            const bf16x8 pf = __builtin_bit_cast(bf16x8, pw);
#pragma unroll
            for (int dt = 0; dt < 8; ++dt) {
                const u32x2 lo = *(const LAS u32x2*)(Vt + (16 * dt + r) * 136 + 32 * kk + 4 * q), hi = *(const LAS u32x2*)(Vt + (16 * dt + r) * 136 + 32 * kk + 16 + 4 * q);
                u32x4 vw; vw.x = lo.x; vw.y = lo.y; vw.z = hi.x; vw.w = hi.y;
                o[dt] = mfma16(__builtin_bit_cast(bf16x8, vw), pf, o[dt]); }
        }
    }
    float lt = lsum; lt += __shfl_xor(lt, 16); lt += __shfl_xor(lt, 32);
    const float inv = 1.0f / lt;
    bf16_t* dst = MB + (size_t)(g0 + ql) * D + 1024 + hq * 128 + 4 * q;
#pragma unroll
    for (int dt = 0; dt < 8; ++dt) { u32x2 wv; wv.x = pk_bf16(o[dt][0] * inv, o[dt][1] * inv); wv.y = pk_bf16(o[dt][2] * inv, o[dt][3] * inv); *(u32x2*)(dst + 16 * dt) = wv; }
}

__device__ void rwkv_prep_tile(const Params& p, int l, int tile, LAS unsigned char* lds, const int tid_) {
    const int tid = tid_, lane = tid & 63, w = tid >> 6, r = lane & 15, q = lane >> 4;
    const int t0 = tile * 64; int s0, len; seq_of(t0, s0, len);
    LAS bf16_t* raw = (LAS bf16_t*)lds;
    LAS bf16_t* A = (LAS bf16_t*)(lds + 50688);
    const bf16_t* P = (const bf16_t*)(p.ws + WS_P); bf16_t* MB = (bf16_t*)(p.ws + WS_XB); _Float16* PREP = (_Float16*)(p.ws + WS_PREP);
    const bf16_t* W2T = (const bf16_t*)(p.ws + WS_W2T); const bf16_t* A2T = (const bf16_t*)(p.ws + WS_A2T); const bf16_t* G2T = (const bf16_t*)(p.ws + WS_G2T);
    const float* mu = p.in[15] + l * 1920 + 1536; const float* w0 = p.in[16] + l * 1024; const float* a0 = p.in[18] + l * 1024;
    __syncthreads();
    for (int id = tid; id < 66 * 48; id += 512) { const int row = id / 48, ch = id % 48, gr = t0 - 1 + row; u32x4 v = (u32x4){0u, 0u, 0u, 0u};
        if (gr >= s0 && gr < s0 + len) v = *(const u32x4*)(P + (size_t)gr * NP + P_RW + 1536 + 8 * ch);
        *(LAS u32x4*)(raw + row * 384 + 8 * ch) = v; }
    __syncthreads();
    for (int id = tid; id < 64 * 48; id += 512) { const int tok = id / 48, ch = id % 48, col = 8 * ch;
        const u32x4 a = *(const LAS u32x4*)(raw + tok * 384 + col), b = *(const LAS u32x4*)(raw + (tok + 1) * 384 + col), c = *(const LAS u32x4*)(raw + (tok + 2) * 384 + col);
        float o[8];
#pragma unroll
        for (int j = 0; j < 8; ++j) { const float zm = bf_at(a, j), z = bf_at(b, j), zp = bf_at(c, j); float zz = z + (0.5f * (zm + zp) - z) * mu[col + j];
            if (col < 128) zz = tanh_fast(zz); else if (col >= 256) zz = sigm(zz); o[j] = zz; }
        u32x4 wv; wv.x = pk_bf16(o[0], o[1]); wv.y = pk_bf16(o[2], o[3]); wv.z = pk_bf16(o[4], o[5]); wv.w = pk_bf16(o[6], o[7]);
        *(LAS u32x4*)(A + tok * 392 + col) = wv; }
    __syncthreads();
#pragma unroll 1
    for (int og = 0; og < 5; ++og) {
        const int nks = og < 4 ? 2 : 4, acol0 = og < 4 ? 64 * og : 256, ldb = og < 4 ? 64 : 128;
        const bf16_t* Bt = og < 2 ? W2T + og * 32768 : (og < 4 ? A2T + (og - 2) * 32768 : G2T);
        f32x4 acc[4][4];
#pragma unroll
        for (int mt = 0; mt < 4; ++mt)
#pragma unroll
            for (int nt = 0; nt < 4; ++nt) acc[mt][nt] = (f32x4){0.f, 0.f, 0.f, 0.f};
#pragma unroll 1
        for (int ks = 0; ks < nks; ++ks) {
            bf16x8 bfr[4];
#pragma unroll
            for (int nt = 0; nt < 4; ++nt) bfr[nt] = *(const bf16x8*)(Bt + (size_t)(64 * w + 16 * nt + r) * ldb + 32 * ks + 8 * q);
#pragma unroll
            for (int mt = 0; mt < 4; ++mt) { const bf16x8 a = *(const LAS bf16x8*)(A + (16 * mt + r) * 392 + acol0 + 32 * ks + 8 * q);
#pragma unroll
                for (int nt = 0; nt < 4; ++nt) acc[mt][nt] = mfma16(bfr[nt], a, acc[mt][nt]); }
        }
        {
            _Float16* pb = PREP + (size_t)(t0 + r) * 2048 + og * 512 + 64 * w + 4 * q; bf16_t* mb = MB + (size_t)(t0 + r) * D + 512 + 64 * w + 4 * q;
            const float* bsrc = og < 2 ? w0 + og * 512 : a0 + (og - 2) * 512;
#pragma unroll
            for (int nt = 0; nt < 4; ++nt) { f32x4 bias = (f32x4){0.f, 0.f, 0.f, 0.f}; if (og < 4) bias = *(const f32x4*)(bsrc + 64 * w + 16 * nt + 4 * q);
#pragma unroll
                for (int mt = 0; mt < 4; ++mt) { const f32x4 x = acc[mt][nt] + bias;
                    if (og < 4) { f16x4 hv;
#pragma unroll
                        for (int i = 0; i < 4; ++i) { const float sg = sigm(x[i]); hv[i] = (_Float16)(og < 2 ? exp_fast(-0.606531f * sg) : sg); }
                        *(f16x4*)(pb + (size_t)mt * 16 * 2048 + 16 * nt) = hv; }
                    else { u32x2 wv; wv.x = pk_bf16(x[0], x[1]); wv.y = pk_bf16(x[2], x[3]); *(u32x2*)(mb + (size_t)mt * 16 * D + 16 * nt) = wv; }
                    asm volatile("" ::: "memory"); } }
        }
    }
}

DI float fma_s(float a, float b, float c) { float d; asm("v_fma_f32 %0, %1, %2, %3" : "=v"(d) : "v"(a), "v"(b), "v"(c)); return d; }
DI float mul_s(float a, float b) { float d; asm("v_mul_f32 %0, %1, %2" : "=v"(d) : "v"(a), "v"(b)); return d; }
template <int CTRL> DI float dpp_xadd(float v) { return v + __int_as_float(__builtin_amdgcn_update_dpp(0, __float_as_int(v), CTRL, 0xF, 0xF, true)); }
DI float sum16(float v) { v = dpp_xadd<0xB1>(v); v = dpp_xadd<0x4E>(v); v = dpp_xadd<0x141>(v); v = dpp_xadd<0x140>(v); return v; }
DI float sum8(float v) { v = dpp_xadd<0xB1>(v); v = dpp_xadd<0x4E>(v); v = dpp_xadd<0x141>(v); return v; }
__device__ void rwkv_scan_task(const Params& p, int l, int htask, LAS unsigned char* lds, const int tid_) {
    const int tid = tid_;
    const int task = htask >> 1, rhalf = htask & 1;
    int seq, hd; if (task < 64) { seq = 8 + (task >> 4); hd = task & 15; } else { const int j = task - 64; seq = j >> 4; hd = j & 15; }
    const int h = hd >> 1, d = hd & 1;
    const int s0 = seq < 8 ? seq * 2048 : 16384 + (seq - 8) * 8192, len = seq < 8 ? 2048 : 8192, ntiles = len / 32;
    LAS float* ldsf = (LAS float*)lds;
    const bf16_t* P = (const bf16_t*)(p.ws + WS_P); const _Float16* PREP = (const _Float16*)(p.ws + WS_PREP); bf16_t* YFB = (bf16_t*)(p.ws + WS_YFB);
    __syncthreads();
    if (tid >= 256) {
        const int pt = tid - 256, ptok = pt >> 3, cq = pt & 7, c0 = 64 * h + 8 * cq;
        const float* mu = p.in[15] + l * 1920;
        float mu_c[3][8], kk_c[8], ka_c[8];
#pragma unroll
        for (int j = 0; j < 8; ++j) { mu_c[0][j] = mu[c0 + j]; mu_c[1][j] = mu[512 + c0 + j]; mu_c[2][j] = mu[1024 + c0 + j]; kk_c[j] = p.in[21][l * 512 + c0 + j]; ka_c[j] = p.in[22][(l * 2 + d) * 512 + c0 + j]; }
        u32x4 raw[3][3], rw_w, rw_a;
        const u32x4 zero4 = (u32x4){0u, 0u, 0u, 0u};
#define RW_TT(ti) (d ? len - 32 * ((ti) + 1) + (31 - ptok) : 32 * (ti) + ptok)
#define RW_LOAD(ti) do { const int tt_ = RW_TT(ti); const size_t gr_ = (size_t)(s0 + tt_); \
            _Pragma("unroll") for (int X = 0; X < 3; ++X) { const bf16_t* b_ = P + gr_ * NP + P_RW + 512 * X + c0; raw[X][1] = *(const u32x4*)b_; \
                raw[X][0] = tt_ > 0 ? *(const u32x4*)(b_ - NP) : zero4; raw[X][2] = tt_ < len - 1 ? *(const u32x4*)(b_ + NP) : zero4; } \
            rw_w = *(const u32x4*)(PREP + gr_ * 2048 + d * 512 + c0); rw_a = *(const u32x4*)(PREP + gr_ * 2048 + (2 + d) * 512 + c0); } while (0)
#define RW_CONVERT(bufi) do { LAS float* ob_ = ldsf + (bufi) * 11264; float z_[3][8]; \
            _Pragma("unroll") for (int X = 0; X < 3; ++X) _Pragma("unroll") for (int j = 0; j < 8; ++j) { const float zc_ = bf_at(raw[X][1], j); z_[X][j] = zc_ + (0.5f * (bf_at(raw[X][0], j) + bf_at(raw[X][2], j)) - zc_) * mu_c[X][j]; } \
            const f16x8 wh_ = __builtin_bit_cast(f16x8, rw_w), ah_ = __builtin_bit_cast(f16x8, rw_a); float kkn_[8], ss_ = 0.f; \
            _Pragma("unroll") for (int j = 0; j < 8; ++j) { kkn_[j] = z_[1][j] * kk_c[j]; ss_ += kkn_[j] * kkn_[j]; } \
            ss_ = sum8(ss_); const float inv_ = rsqrtf(fmaxf(ss_, 1e-24f)); \
            _Pragma("unroll") for (int hh = 0; hh < 2; ++hh) { f32x4 vK, vW, vB, vKh, vR, vV; \
                _Pragma("unroll") for (int j = 0; j < 4; ++j) { const int jj = 4 * hh + j; const float av = (float)ah_[jj]; vK[j] = kkn_[jj] * inv_; vW[j] = (float)wh_[jj]; vB[j] = vK[j] * av; \
                    vKh[j] = z_[1][jj] * (1.0f + (av - 1.0f) * ka_c[jj]); vR[j] = z_[0][jj]; vV[j] = z_[2][jj]; } \
                const int o_ = ptok * 64 + 8 * cq + 4 * hh; \
                *(LAS f32x4*)(ob_ + o_) = vK; *(LAS f32x4*)(ob_ + 2048 + o_) = vW; *(LAS f32x4*)(ob_ + 4096 + o_) = vB; *(LAS f32x4*)(ob_ + 6144 + o_) = vKh; *(LAS f32x4*)(ob_ + 8192 + o_) = vR; \
                if ((cq >> 2) == rhalf) *(LAS f32x4*)(ob_ + 10240 + ptok * 32 + 8 * (cq & 3) + 4 * hh) = vV; } } while (0)
#define RW_STOREY(ti) do { const int tt_ = RW_TT(ti); const f32x4 yv_ = *(const LAS f32x4*)(ldsf + 22528 + ((ti) & 1) * 1024 + ptok * 32 + 4 * cq); \
            u32x2 wv_; wv_.x = pk_bf16(yv_[0], yv_[1]); wv_.y = pk_bf16(yv_[2], yv_[3]); \
            *(u32x2*)(YFB + ((size_t)d * T + (size_t)(s0 + tt_)) * 512 + 64 * h + 32 * rhalf + 4 * cq) = wv_; } while (0)
        RW_LOAD(0); RW_CONVERT(0); RW_LOAD(1);
        __syncthreads();
        for (int ti = 0; ti < ntiles; ++ti) {
            if (ti + 1 < ntiles) { RW_CONVERT((ti + 1) & 1); if (ti + 2 < ntiles) RW_LOAD(ti + 2); }
            if (ti > 0) RW_STOREY(ti - 1);
            __syncthreads();
        }
        RW_STOREY(ntiles - 1);
#undef RW_LOAD
#undef RW_CONVERT
#undef RW_STOREY
#undef RW_TT
    } else {
        const int rv = tid >> 3, rg = tid & 7;
        __builtin_amdgcn_s_setprio(3);
        f32x2 st[4];
#pragma unroll
        for (int i = 0; i < 4; ++i) st[i] = (f32x2){0.f, 0.f};
        __syncthreads();
        for (int ti = 0; ti < ntiles; ++ti) {
            const LAS float* ob = ldsf + (ti & 1) * 11264 + 8 * rg; const LAS float* ov = ldsf + (ti & 1) * 11264 + 10240 + rv; LAS float* yb = ldsf + 22528 + (ti & 1) * 1024 + rv;
#define RW_FETCH(dst, dv, s) do { _Pragma("unroll") for (int a_ = 0; a_ < 5; ++a_) { dst[2 * a_] = *(const LAS f32x4*)(ob + a_ * 2048 + (s) * 64); dst[2 * a_ + 1] = *(const LAS f32x4*)(ob + a_ * 2048 + (s) * 64 + 4); } dv = ov[(s) * 32]; } while (0)
            f32x4 cur[10], nxt[10]; float cv, nv;
            RW_FETCH(cur, cv, 0);
#pragma unroll 1
            for (int s8 = 0; s8 < 32; s8 += 8) {
                float yk = 0.f;
#pragma unroll
                for (int j = 0; j < 8; ++j) { const int s = s8 + j;
                    { const int sn = s + 1 < 32 ? s + 1 : 31; RW_FETCH(nxt, nv, sn); }
                    const f32x2 vv2 = (f32x2){cv, cv};
                    const f32x2 t0 = st[0] * (f32x2){cur[2][0], cur[2][1]} + vv2 * (f32x2){cur[6][0], cur[6][1]}, t1 = st[1] * (f32x2){cur[2][2], cur[2][3]} + vv2 * (f32x2){cur[6][2], cur[6][3]};
                    const f32x2 t2 = st[2] * (f32x2){cur[3][0], cur[3][1]} + vv2 * (f32x2){cur[7][0], cur[7][1]}, t3 = st[3] * (f32x2){cur[3][2], cur[3][3]} + vv2 * (f32x2){cur[7][2], cur[7][3]};
                    const f32x2 sa2 = (st[0] * (f32x2){cur[0][0], cur[0][1]} + st[1] * (f32x2){cur[0][2], cur[0][3]}) + (st[2] * (f32x2){cur[1][0], cur[1][1]} + st[3] * (f32x2){cur[1][2], cur[1][3]});
                    const float sa = sum8(sa2[0] + sa2[1]);
                    const f32x2 nsa = (f32x2){-sa, -sa};
                    st[0] = nsa * (f32x2){cur[4][0], cur[4][1]} + t0; st[1] = nsa * (f32x2){cur[4][2], cur[4][3]} + t1;
                    st[2] = nsa * (f32x2){cur[5][0], cur[5][1]} + t2; st[3] = nsa * (f32x2){cur[5][2], cur[5][3]} + t3;
                    const f32x2 y2 = (st[0] * (f32x2){cur[8][0], cur[8][1]} + st[1] * (f32x2){cur[8][2], cur[8][3]}) + (st[2] * (f32x2){cur[9][0], cur[9][1]} + st[3] * (f32x2){cur[9][2], cur[9][3]});
                    const float y = sum8(y2[0] + y2[1]);
                    yk = (rg == j) ? y : yk;
#pragma unroll
                    for (int a_ = 0; a_ < 10; ++a_) cur[a_] = nxt[a_];
                    cv = nv; }
                yb[(s8 + rg) * 32] = yk;
            }
#undef RW_FETCH
            __syncthreads();
        }
        __builtin_amdgcn_s_setprio(0);
    }
}

__device__ void rwkv_final(const Params& p, int l, const int tid_) {
    const int lane = tid_ & 63, gw = blockIdx.x * 8 + (tid_ >> 6), nw = gridDim.x * 8, c0 = 8 * lane, h = lane >> 3;
    const bf16_t* P = (const bf16_t*)(p.ws + WS_P); const _Float16* PREP = (const _Float16*)(p.ws + WS_PREP); const bf16_t* YFB = (const bf16_t*)(p.ws + WS_YFB); bf16_t* MB = (bf16_t*)(p.ws + WS_XB);
    const float* mu = p.in[15] + l * 1920;
    float mu_c[3][8], ka0[8], ka1[8], rk[8], gnw[8], gnb[8];
#pragma unroll
    for (int j = 0; j < 8; ++j) { mu_c[0][j] = mu[c0 + j]; mu_c[1][j] = mu[512 + c0 + j]; mu_c[2][j] = mu[1024 + c0 + j];
        ka0[j] = p.in[22][(l * 2 + 0) * 512 + c0 + j]; ka1[j] = p.in[22][(l * 2 + 1) * 512 + c0 + j]; rk[j] = p.in[23][l * 512 + h * 64 + (c0 & 63) + j];
        gnw[j] = p.in[24][l * 512 + c0 + j]; gnb[j] = p.in[25][l * 512 + c0 + j]; }
    for (int row = gw; row < T; row += nw) {
        int s0, len; seq_of(row, s0, len); const bool hm = row > s0, hp = row < s0 + len - 1;
        const u32x4 yf = *(const u32x4*)(YFB + (size_t)row * 512 + c0), yb = *(const u32x4*)(YFB + ((size_t)T + row) * 512 + c0);
        float y[8], sum = 0.f;
#pragma unroll
        for (int j = 0; j < 8; ++j) { y[j] = bf_at(yf, j) + bf_at(yb, j); sum += y[j]; }
        sum += __shfl_xor(sum, 1); sum += __shfl_xor(sum, 2); sum += __shfl_xor(sum, 4);
        const float mean = sum * (1.0f / 64.0f); float var = 0.f;
#pragma unroll
        for (int j = 0; j < 8; ++j) { const float dd = y[j] - mean; var += dd * dd; }
        var += __shfl_xor(var, 1); var += __shfl_xor(var, 2); var += __shfl_xor(var, 4);
        const float rstd = rsqrtf(var * (1.0f / 64.0f) + 64e-5f);
        float z[3][8];
        const u32x4 zero4 = (u32x4){0u, 0u, 0u, 0u};
#pragma unroll
        for (int X = 0; X < 3; ++X) { const bf16_t* b = P + (size_t)row * NP + P_RW + 512 * X + c0;
            const u32x4 zc = *(const u32x4*)b, zm = hm ? *(const u32x4*)(b - NP) : zero4, zp = hp ? *(const u32x4*)(b + NP) : zero4;
#pragma unroll
            for (int j = 0; j < 8; ++j) { const float c = bf_at(zc, j); z[X][j] = c + (0.5f * (bf_at(zm, j) + bf_at(zp, j)) - c) * mu_c[X][j]; } }
        const f16x8 a0 = *(const f16x8*)(PREP + (size_t)row * 2048 + 1024 + c0), a1 = *(const f16x8*)(PREP + (size_t)row * 2048 + 1536 + c0);
        float bs = 0.f;
#pragma unroll
        for (int j = 0; j < 8; ++j) { const float k0 = z[1][j] * (1.0f + ((float)a0[j] - 1.0f) * ka0[j]), k1 = z[1][j] * (1.0f + ((float)a1[j] - 1.0f) * ka1[j]); bs += z[0][j] * (k0 + k1) * rk[j]; }
        bs += __shfl_xor(bs, 1); bs += __shfl_xor(bs, 2); bs += __shfl_xor(bs, 4);
        const u32x4 gv = *(const u32x4*)(MB + (size_t)row * D + 512 + c0);
        float o[8];
#pragma unroll
        for (int j = 0; j < 8; ++j) o[j] = ((y[j] - mean) * rstd * gnw[j] + gnb[j] + bs * z[2][j]) * bf_at(gv, j);
        u32x4 wv; wv.x = pk_bf16(o[0], o[1]); wv.y = pk_bf16(o[2], o[3]); wv.z = pk_bf16(o[4], o[5]); wv.w = pk_bf16(o[6], o[7]);
        *(u32x4*)(MB + (size_t)row * D + 512 + c0) = wv;
    }
}

DI float gelu_tanh(float x) { const float u = 0.7978845608028654f * (x + 0.044715f * x * x * x); return 0.5f * x * (1.0f + tanh_fast(u)); }
__device__ void lru_run(const Params& p, int l, int n, int tile_first, int tile_stride, int tile_count, int mode, LAS unsigned char* lds, const int tid_) {
    const int tid = tid_, lane = tid & 63, w = tid >> 6, r = lane & 15, q = lane >> 4;
    LAS float* xcf = (LAS float*)lds;
    LAS bf16_t* Ab = (LAS bf16_t*)(lds + 16384);
    LAS float* aL = (LAS float*)(lds + 25600);
    LAS float* uL = (LAS float*)(lds + 58368);
    LAS float* agg = (LAS float*)(lds + 91136);
    LAS float* carry = (LAS float*)(lds + 95232);
    const bf16_t* P = (const bf16_t*)(p.ws + WS_P); bf16_t* MB = (bf16_t*)(p.ws + WS_XB); const bf16_t* LB = (const bf16_t*)(p.ws + WS_LB);
    f32x2* AGG = (f32x2*)(p.ws + WS_AGG);
    const int tok = tid >> 3, cg8 = tid & 7, ch0 = 64 * n + 8 * cg8;
    LAS float* cwl = (LAS float*)(lds + 95744);
    __syncthreads();
    if (tid < 320) { const int k = tid >> 6, c = tid & 63; cwl[tid] = k < 4 ? p.in[8][(l * 4 + k) * 512 + 64 * n + c] : p.in[9][l * 512 + 64 * n + c]; }
    const int gd = w >> 2, ct = w & 3, chl = 16 * ct + r, gc = 64 * n + chl;
    bf16x8 br[2], bi[2];
#pragma unroll
    for (int ks = 0; ks < 2; ++ks) { br[ks] = *(const bf16x8*)(LB + (size_t)(n * 256 + (gd * 2 + 0) * 64 + chl) * 64 + 32 * ks + 8 * q);
                                     bi[ks] = *(const bf16x8*)(LB + (size_t)(n * 256 + (gd * 2 + 1) * 64 + chl) * 64 + 32 * ks + 8 * q); }
    const float ba_c = p.in[11][(l * 2 + gd) * 512 + gc], bx_c = p.in[13][(l * 2 + gd) * 512 + gc];
    float sp_c; { const float lam = p.in[14][(l * 2 + gd) * 512 + gc]; const float e = exp_fast(-lam); sp_c = e < 0.1f ? e * (1.0f - e * (0.5f - e * (0.33333334f - e * (0.25f - e * 0.2f)))) : 0.6931471805599453f * __builtin_amdgcn_logf(1.0f + e); }
    const int sd = tid >> 8, sc = (tid >> 6) & 3, scn = tid & 63;
    const u32x4 zero4 = (u32x4){0u, 0u, 0u, 0u};
    u32x4 xr[4];
#define LRU_LOADX(gt_) do { const int t0g_ = (gt_) * 64; int s0_, len_; seq_of(t0g_, s0_, len_); \
        _Pragma("unroll") for (int k = 0; k < 4; ++k) { const int gr_ = t0g_ + tok - 2 + k; xr[k] = (gr_ >= s0_ && gr_ < s0_ + len_) ? *(const u32x4*)(P + (size_t)gr_ * NP + P_LX + ch0) : zero4; } } while (0)
    if (tile_count > 0) LRU_LOADX(tile_first);
    for (int it = 0; it < tile_count; ++it) {
        int tl_ = tid_; asm volatile("" : "+v"(tl_));
        const int tid = tl_, lane = tid & 63, w = tid >> 6, r = lane & 15, q = lane >> 4, tok = tid >> 3, cg8 = tid & 7, ch0 = 64 * n + 8 * cg8;
        const int gd = w >> 2, ct = w & 3, chl = 16 * ct + r, sd = tid >> 8, sc = (tid >> 6) & 3, scn = tid & 63;
        const int gt = tile_first + it * tile_stride, t0g = gt * 64; int s0, len; seq_of(t0g, s0, len);
        const int ti = (t0g - s0) >> 6, N = len >> 6;
        u32x4 gv = zero4;
        if (mode) gv = *(const u32x4*)(P + (size_t)(t0g + tok) * NP + P_LG + ch0);
        __syncthreads();
        {   float acc[8];
            { const f32x4 c0_ = *(const LAS f32x4*)(cwl + 256 + 8 * cg8), c1_ = *(const LAS f32x4*)(cwl + 256 + 8 * cg8 + 4);
#pragma unroll
              for (int j = 0; j < 4; ++j) { acc[j] = c0_[j]; acc[4 + j] = c1_[j]; } }
#pragma unroll
            for (int k = 0; k < 4; ++k) { const f32x4 c0_ = *(const LAS f32x4*)(cwl + 64 * k + 8 * cg8), c1_ = *(const LAS f32x4*)(cwl + 64 * k + 8 * cg8 + 4);
#pragma unroll
                for (int j = 0; j < 4; ++j) { acc[j] += c0_[j] * bf_at(xr[k], j); acc[4 + j] += c1_[j] * bf_at(xr[k], 4 + j); } }
            *(LAS f32x4*)(xcf + tok * 64 + 8 * cg8) = (f32x4){acc[0], acc[1], acc[2], acc[3]};
            *(LAS f32x4*)(xcf + tok * 64 + 8 * cg8 + 4) = (f32x4){acc[4], acc[5], acc[6], acc[7]};
            u32x4 wv; wv.x = pk_bf16(acc[0], acc[1]); wv.y = pk_bf16(acc[2], acc[3]); wv.z = pk_bf16(acc[4], acc[5]); wv.w = pk_bf16(acc[6], acc[7]);
            *(LAS u32x4*)(Ab + tok * 72 + 8 * cg8) = wv; }
        if (it + 1 < tile_count) LRU_LOADX(gt + tile_stride);
        float pA = 1.f, pH = 0.f;
        if (mode) { const int cnt = sd == 0 ? ti : N - 1 - ti, lo = (cnt * sc) >> 2, hi = (cnt * (sc + 1)) >> 2;
            const f32x2* ab = AGG + ((size_t)(gt - ti) * 8 + n) * 128 + sd * 64 + scn;
            f32x2 e[32];
#pragma unroll
            for (int u = 0; u < 32; ++u) { const int j = lo + u, tj = sd == 0 ? j : N - 1 - j; e[u] = j < hi ? ab[(size_t)tj * 1024] : (f32x2){1.f, 0.f}; }
#pragma unroll
            for (int u = 0; u < 32; ++u) { pH = e[u][0] * pH + e[u][1]; pA *= e[u][0]; } }
        __syncthreads();
        {   f32x4 accr[4], acci[4];
#pragma unroll
            for (int mt = 0; mt < 4; ++mt) { accr[mt] = (f32x4){0.f, 0.f, 0.f, 0.f}; acci[mt] = (f32x4){0.f, 0.f, 0.f, 0.f};
#pragma unroll
                for (int ks = 0; ks < 2; ++ks) { const bf16x8 a = *(const LAS bf16x8*)(Ab + (16 * mt + r) * 72 + 32 * ks + 8 * q);
                    accr[mt] = mfma16(a, br[ks], accr[mt]); acci[mt] = mfma16(a, bi[ks], acci[mt]); } }
            const int t0 = t0g - s0;
#pragma unroll
            for (int mt = 0; mt < 4; ++mt)
#pragma unroll
                for (int i = 0; i < 4; ++i) { const int tk = 16 * mt + 4 * q + i, tt = t0 + tk;
                    const float rg_ = sigm(accr[mt][i] + ba_c), ig_ = sigm(acci[mt][i] + bx_c);
                    const float la = -8.0f * rg_ * sp_c, a = exp_fast(la), e2 = 2.0f * la;
                    const float om = e2 > -0.05f ? -e2 * (1.0f + e2 * (0.5f + e2 * (0.16666667f + e2 * 0.041666668f))) : 1.0f - exp_fast(e2);
                    float mult = sqrtf(om); if (gd == 0 ? tt == 0 : tt == len - 1) mult = 1.0f;
                    const float u = mult * ig_ * xcf[tk * 64 + chl];
                    aL[(gd * 64 + tk) * 64 + chl] = a; uL[(gd * 64 + tk) * 64 + chl] = u; }
        }
        if (mode) { agg[((sd * 64 + scn) * 4 + sc) * 2 + 0] = pA; agg[((sd * 64 + scn) * 4 + sc) * 2 + 1] = pH; }
        __syncthreads();
        {
            float hh = 0.f;
            if (mode) {
#pragma unroll
                for (int s2 = 0; s2 < 4; ++s2) hh = agg[((sd * 64 + scn) * 4 + s2) * 2 + 0] * hh + agg[((sd * 64 + scn) * 4 + s2) * 2 + 1]; }
            float A = 1.f, H = 0.f;
#pragma unroll
            for (int j = 0; j < 16; ++j) { const int tk = sd == 0 ? 16 * sc + j : 63 - 16 * sc - j; const float a_ = aL[(sd * 64 + tk) * 64 + scn], u_ = uL[(sd * 64 + tk) * 64 + scn]; H = a_ * H + u_; A *= a_; }
            __syncthreads();
            agg[((sd * 64 + scn) * 4 + sc) * 2 + 0] = A; agg[((sd * 64 + scn) * 4 + sc) * 2 + 1] = H;
            __syncthreads();
            if (mode == 0) { if (sc == 0) { float tA = 1.f, tH = 0.f;
#pragma unroll
                    for (int s2 = 0; s2 < 4; ++s2) { const float a_ = agg[((sd * 64 + scn) * 4 + s2) * 2 + 0], h_ = agg[((sd * 64 + scn) * 4 + s2) * 2 + 1]; tH = a_ * tH + h_; tA *= a_; }
                    AGG[((size_t)gt * 8 + n) * 128 + sd * 64 + scn] = (f32x2){tA, tH}; } }
            else {
                for (int s2 = 0; s2 < sc; ++s2) hh = agg[((sd * 64 + scn) * 4 + s2) * 2 + 0] * hh + agg[((sd * 64 + scn) * 4 + s2) * 2 + 1];
#pragma unroll
                for (int j = 0; j < 16; ++j) { const int tk = sd == 0 ? 16 * sc + j : 63 - 16 * sc - j; hh = aL[(sd * 64 + tk) * 64 + scn] * hh + uL[(sd * 64 + tk) * 64 + scn]; uL[(sd * 64 + tk) * 64 + scn] = hh; }
            }
        }
        if (mode) {
            __syncthreads();
            const f32x4 f0 = *(const LAS f32x4*)(uL + tok * 64 + 8 * cg8), f1 = *(const LAS f32x4*)(uL + tok * 64 + 8 * cg8 + 4);
            const f32x4 b0 = *(const LAS f32x4*)(uL + (64 + tok) * 64 + 8 * cg8), b1 = *(const LAS f32x4*)(uL + (64 + tok) * 64 + 8 * cg8 + 4);
            float hv[8] = {f0[0] + b0[0], f0[1] + b0[1], f0[2] + b0[2], f0[3] + b0[3], f1[0] + b1[0], f1[1] + b1[1], f1[2] + b1[2], f1[3] + b1[3]};
#pragma unroll
            for (int j = 0; j < 8; ++j) hv[j] *= gelu_tanh(bf_at(gv, j));
            u32x4 wv; wv.x = pk_bf16(hv[0], hv[1]); wv.y = pk_bf16(hv[2], hv[3]); wv.z = pk_bf16(hv[4], hv[5]); wv.w = pk_bf16(hv[6], hv[7]);
            *(u32x4*)(MB + (size_t)(t0g + tok) * D + ch0) = wv;
        }
    }
#undef LRU_LOADX
}

#ifndef NCH
#define NCH 2
#endif
constexpr int FCH = NCH, FROWS = T / FCH, PER = 7 + 2 * FCH, N_PHASES = 1 + 2 * PER, ATTN_IN_SCAN = 768;
__device__ void run_phase(const Params& p, int ph, LAS unsigned char* lds, const int tid_) {
    bf16_t* XB = (bf16_t*)(p.ws + WS_XB); float* RS1 = (float*)(p.ws + WS_RS1); float* RS2 = (float*)(p.ws + WS_RS2);
    if (ph == 0) { wprep_phase(p, 0, lds, tid_); rowpass0(p, tid_); return; }
    const int l = (ph - 1) / PER, k = (ph - 1) % PER;
    if (k == 0) {
        pg8::Gemm g{XB, (const bf16_t*)(p.ws + WS_WIN), T, NP, D}; pg8::StaticOrder S; S.init(T, NP, (int)gridDim.x, (int)blockIdx.x);
        EpiBf16S E{(bf16_t*)(p.ws + WS_P), NP, nullptr, 0};
        pg8::gemm_phase<EpiBf16S, pg8::StaticOrder>(lds, g, S, E, nullptr, tid_);
    } else if (k == 1) {
        for (int u = ATTN_IN_SCAN + blockIdx.x; u < 3072; u += gridDim.x) { int t2 = tid_; asm volatile("" : "+v"(t2)); attn_unit(p, l, u, lds, t2); }
        for (int t = blockIdx.x; t < 768; t += gridDim.x) { int t2 = tid_; asm volatile("" : "+v"(t2)); rwkv_prep_tile(p, l, t, lds, t2); }
        { const int per = (int)gridDim.x >> 3; if ((int)blockIdx.x < per * 8) { const int first = (int)blockIdx.x >> 3; lru_run(p, l, (int)blockIdx.x & 7, first, per, (768 - first + per - 1) / per, 0, lds, tid_); } }
    } else if (k == 2) {
        for (int vb = blockIdx.x; vb < 256; vb += gridDim.x) {
#ifndef PROBE2
#define PROBE2 0
#endif
            if (vb < 192) { const int n = vb < 128 ? 1 : 4, b0 = vb < 128 ? vb : 128 + 4 * (vb - 128); for (int i = 0; i < n * (PROBE2 == 1 ? 2 : 1); ++i) rwkv_scan_task(p, l, b0 + (i % n), lds, tid_); }
            else { const int j = vb - 192; for (int rep = 0; rep < (PROBE2 == 2 ? 2 : 1); ++rep) lru_run(p, l, j & 7, j >> 3, 8, 96, 1, lds, tid_);
                for (int u = j; u < ATTN_IN_SCAN; u += 64) { int t2 = tid_; asm volatile("" : "+v"(t2)); attn_unit(p, l, u, lds, t2); } }
        }
    } else if (k == 3) { rwkv_final(p, l, tid_);
    } else if (k == 4) {
        pg8::Gemm g{XB, (const bf16_t*)(p.ws + WS_WOUT), T, D, D}; pg8::StaticOrder S; S.init(T, D, (int)gridDim.x, (int)blockIdx.x);
        EpiBf16S E{(bf16_t*)(p.ws + WS_F), D, nullptr, 0};
        pg8::gemm_phase<EpiBf16S, pg8::StaticOrder>(lds, g, S, E, nullptr, tid_);
    } else if (k == 5) { rowpass_post(p, (const bf16_t*)(p.ws + WS_F), p.in[3] + l * D, l == 0 ? 0 : 1, nullptr, RS2, 0, tid_);
    } else if (k < 6 + 2 * FCH) {
        const int th = (k - 6) >> 1; const size_t rb = (size_t)th * FROWS;
        if (((k - 6) & 1) == 0) {
            pg8::Gemm g{XB + rb * D, (const bf16_t*)(p.ws + WS_WUP), FROWS, DFF, D}; pg8::StaticOrder S; S.init(FROWS, DFF, (int)gridDim.x, (int)blockIdx.x);
            EpiBf16S E{(bf16_t*)(p.ws + WS_U), DFF, nullptr, 1};
            pg8::gemm_phase<EpiBf16S, pg8::StaticOrder>(lds, g, S, E, nullptr, tid_);
        } else {
            pg8::Gemm g{(const bf16_t*)(p.ws + WS_U), (const bf16_t*)(p.ws + WS_WDN), FROWS, D, DFF}; pg8::StaticOrder S; S.init(FROWS, D, (int)gridDim.x, (int)blockIdx.x);
            EpiBf16S E{(bf16_t*)(p.ws + WS_F) + rb * D, D, nullptr, 0};
            pg8::gemm_phase<EpiBf16S, pg8::StaticOrder>(lds, g, S, E, nullptr, tid_);
        }
    } else {
        rowpass_post(p, (const bf16_t*)(p.ws + WS_F), p.in[5] + l * D, 2, RS2, RS1, l == 0 ? 1 : 2, tid_);
        if (l == 0) wprep_phase(p, 1, lds, tid_);
    }
}

__global__ void __launch_bounds__(512, 2) hymba_mega(Params p) {
    extern __shared__ __attribute__((aligned(16))) unsigned char smem[];
    LAS unsigned char* lds = (LAS unsigned char*)smem;
    volatile LAS unsigned* bst = (volatile LAS unsigned*)(lds + 131072);
    unsigned* bar = (unsigned*)(p.ws + WS_BAR);
    const bool coop = p.ph_hi - p.ph_lo > 1;
    if (coop) {
        if (threadIdx.x < 2) bst[threadIdx.x] = 0u;
        if (blockIdx.x == 0) for (int i = threadIdx.x; i < XCD_BAR_WORDS; i += 512) bar[i] = 0u;
        __syncthreads();
    }
    XcdBarrier xb; xb.bar = bar; xb.x = 0; xb.st = bst;
    bool posted = false;
    for (int ph = p.ph_lo; ph < p.ph_hi; ++ph) {
        int nrep = 1;
#if PROBE_MASK
        if ((ph > 0 && ((PROBE_MASK >> ((ph - 1) % PER)) & 1)) || (ph == 0 && ((PROBE_MASK >> 30) & 1))) nrep = 2;
#endif
        for (int rep = 0; rep < nrep; ++rep) {
            int tid_ = (int)__builtin_amdgcn_workitem_id_x(); asm volatile("" : "+v"(tid_));
            run_phase(p, ph, lds, tid_);
            if (ph + 1 < p.ph_hi || rep + 1 < nrep) {
                if (!posted) { cg::this_grid().sync(); xb = xcd_barrier_post(bar, bst, tid_ == 0); posted = true; }
                else xcd_barrier(xb, tid_ == 0);
            }
        }
    }
}

#ifndef PROBE_MASK
#define PROBE_MASK 0
#endif
#ifndef N_LAUNCH_PER_PHASE
#define N_LAUNCH_PER_PHASE 1
#endif
extern "C" void kernel_launch(void* const* d_in, const int* in_sizes, int n_in, void* d_out, int out_size, void* d_ws, size_t ws_size, hipStream_t stream) {
    static int grid = 0;
    if (grid == 0) {
        if (n_in != 30 || ws_size < WS_END) { fprintf(stderr, "kernel_launch: unexpected n_in %d / ws_size %zu\n", n_in, ws_size); grid = -1; return; }
        int dev = 0, cus = 0, per_cu = 0;
        hipGetDevice(&dev); hipDeviceGetAttribute(&cus, hipDeviceAttributeMultiprocessorCount, dev);
        if (hipFuncSetAttribute((const void*)hymba_mega, hipFuncAttributeMaxDynamicSharedMemorySize, LDS_BYTES) != hipSuccess) { fprintf(stderr, "kernel_launch: hipFuncSetAttribute failed\n"); grid = -1; return; }
        if (hipOccupancyMaxActiveBlocksPerMultiprocessor(&per_cu, (const void*)hymba_mega, 512, LDS_BYTES) != hipSuccess || per_cu < 1) { fprintf(stderr, "kernel_launch: occupancy query says %d\n", per_cu); per_cu = 1; }
        (void)hipGetLastError();
        grid = cus * (per_cu > 1 ? 1 : per_cu);
    }
    if (grid < 0) return;
    Params p{};
    for (int i = 0; i < 30; ++i) p.in[i] = (const float*)d_in[i];
    p.out = (float*)d_out; p.ws = (unsigned char*)d_ws;
#if N_LAUNCH_PER_PHASE
    for (int ph = 0; ph < N_PHASES; ++ph) { p.ph_lo = ph; p.ph_hi = ph + 1; hipLaunchKernelGGL(hymba_mega, dim3(grid), dim3(512), LDS_BYTES, stream, p); }
#else
    p.ph_lo = 0; p.ph_hi = N_PHASES;
    void* args[] = {&p};
    hipError_t e = hipLaunchCooperativeKernel((const void*)hymba_mega, dim3(grid), dim3(512), args, LDS_BYTES, stream);
    if (e != hipSuccess) fprintf(stderr, "kernel_launch: cooperative launch failed: %s (grid %d)\n", hipGetErrorString(e), grid);
#endif
}
```

```cpp
#include <hip/hip_runtime.h>
#include <hip/hip_cooperative_groups.h>
#include <cstdio>
namespace cg = cooperative_groups;

#define LAS __attribute__((address_space(3)))
typedef float f32x2 __attribute__((ext_vector_type(2)));
typedef unsigned u32x2 __attribute__((ext_vector_type(2)));
typedef _Float16 f16x4 __attribute__((ext_vector_type(4)));
typedef _Float16 f16x8 __attribute__((ext_vector_type(8)));
#define N_LAUNCH_PER_PHASE 0
#define PROBE_MASK 0
#define PROBE2 0
#define NCH 6
namespace pg8 {
#define PG8_LAS __attribute__((address_space(3)))
typedef unsigned short bf16_t;
typedef short bf16x8 __attribute__((ext_vector_type(8)));
typedef float f32x4 __attribute__((ext_vector_type(4)));
typedef unsigned u32x4 __attribute__((ext_vector_type(4)));
constexpr int BM = 256, BK = 64, HALF = 128, HTB = HALF * BK * 2  , STAGE_BYTES = 8 * HTB, NXCD = 8, WGM = 8;

__host__ __device__ __forceinline__ int lds_byte(int r, int c) { const int st = (r >> 4) * 2 + (c >> 5), rr = r & 15, cc = c & 31, ob = rr * 64 + cc * 2; return st * 1024 + (ob ^ (((ob >> 9) & 1) << 5)); }
__host__ __device__ __forceinline__ void stage_rc(int b, int& R, int& C) { const int st = b / 1024, sb = b % 1024, swz = sb ^ (((sb >> 9) & 1) << 5); R = (st >> 1) * 16 + swz / 64; C = (st & 1) * 32 + (swz % 64) / 2; }
__host__ __device__ __forceinline__ int perm32(int rho) { const int n = rho >> 4, i = rho & 15; return 8 * (i >> 2) + 4 * n + (i & 3); }

struct Unit { int pm, pn; };
struct Gemm { const bf16_t* A; const bf16_t* Bt; int M, N, K; };

struct StaticOrder {
    int nM, nN, nwg, G, c;
    __host__ __device__ void init(int M, int N, int G_, int c_) { nM = M / BM; nN = N / BM; nwg = nM * nN; G = G_; c = c_; }
    __host__ __device__ bool next(int i, Unit& u) const {
        const long L = (long)i * G + c; if (L >= nwg) return false;
        int wgid = (int)L; { const int q = nwg / NXCD, r = nwg % NXCD, xcd = wgid % NXCD, off = wgid / NXCD; wgid = (xcd < r ? xcd * (q + 1) : r * (q + 1) + (xcd - r) * q) + off; }
        const int nig = WGM * nN, gid = wgid / nig, fm = gid * WGM, gsz = (nM - fm) < WGM ? (nM - fm) : WGM;
        u.pm = fm + ((wgid % nig) % gsz); u.pn = (wgid % nig) / gsz; return true;
    }
    __device__ __forceinline__ void a_ready(const Unit&) const {}
    __device__ __forceinline__ void done(const Unit&) const {}
};
__device__ __forceinline__ unsigned cvt_pk_bf16(float lo, float hi) { unsigned r; asm volatile("v_cvt_pk_bf16_f32 %0, %1, %2" : "=v"(r) : "v"(lo), "v"(hi)); return r; }
template <class Epi, class Sched, bool STAMP = false>
__device__ __forceinline__ void gemm_phase(PG8_LAS unsigned char* lds, const Gemm g, const Sched& S, const Epi& E, unsigned long long* stamps, const int tid_) {
    const int tid = tid_, wid = __builtin_amdgcn_readfirstlane(tid >> 6), lane = tid & 63, wr = wid >> 2, wc = wid & 3, fr = lane & 15, fq = lane >> 4;
    const int K = g.K, nt = K / BK;
    int ts_lo = 0, ts_hi = 0, nts = 0; const unsigned long long rt_entry = STAMP ? (unsigned long long)wall_clock64() : 0ull;
#define PG8_STAMP() do { if (STAMP && wid == 0 && nts < 64) { const unsigned long long _c = (unsigned long long)clock64(); \
        ts_lo = (lane == nts) ? (int)(unsigned)_c : ts_lo; ts_hi = (lane == nts) ? (int)(unsigned)(_c >> 32) : ts_hi; ++nts; } } while (0)
    PG8_STAMP();
    unsigned voffA[2], voffB[2];
#pragma unroll
    for (int i = 0; i < 2; ++i) { int R, C; stage_rc(tid * 16 + i * 8192, R, C); const int Rb = Epi::PERM ? ((R & ~31) + perm32(R & 31)) : R;
        voffA[i] = (unsigned)(R * K + C) * 2u; voffB[i] = (unsigned)(Rb * K + C) * 2u; }
    const size_t kstep = (size_t)(BK * 2);
    const size_t hstep = (size_t)HALF * K * 2;
    const size_t tstep = 2 * hstep;
    const unsigned ldsw = (unsigned)wid * 1024u;
    const int aoff = lds_byte(wr * 64 + fr, fq * 8), boff = lds_byte(wc * 32 + fr, fq * 8);
#define PG8_SA(b, h) (((b) * 2 + (h)) * HTB)
#define PG8_SB(b, h) ((4 + (b) * 2 + (h)) * HTB)
#define PG8_STAGE(bufoff, gbase, voff) do { _Pragma("unroll") for (int _i = 0; _i < 2; ++_i) \
        __builtin_amdgcn_global_load_lds((const unsigned*)((const char*)(gbase) + (voff)[_i]), (PG8_LAS unsigned*)(lds + (bufoff) + ldsw + _i * 8192), 16, 0, 0); } while (0)
#define PG8_LDA(dst, b, h) do { _Pragma("unroll") for (int m = 0; m < 4; ++m) _Pragma("unroll") for (int k = 0; k < 2; ++k) dst[m][k] = *(const PG8_LAS bf16x8*)(lds + PG8_SA(b, h) + aoff + m * 2048 + k * 1024); } while (0)
#define PG8_LDB(dst, b, h) do { _Pragma("unroll") for (int n = 0; n < 2; ++n) _Pragma("unroll") for (int k = 0; k < 2; ++k) dst[n][k] = *(const PG8_LAS bf16x8*)(lds + PG8_SB(b, h) + boff + n * 2048 + k * 1024); } while (0)
#define PG8_MMA(ai, bj, At, Bt) do { __builtin_amdgcn_s_setprio(1); _Pragma("unroll") for (int m = 0; m < 4; ++m) _Pragma("unroll") for (int n = 0; n < 2; ++n) _Pragma("unroll") for (int k = 0; k < 2; ++k) \
        acc[ai][bj][m][n] = __builtin_amdgcn_mfma_f32_16x16x32_bf16(Bt[n][k], At[m][k], acc[ai][bj][m][n], 0, 0, 0); __builtin_amdgcn_s_setprio(0); } while (0)
#define PG8_WAIT_V(n) asm volatile("s_waitcnt vmcnt(" #n ")" ::: "memory")
#define PG8_WAIT_L(n) asm volatile("s_waitcnt lgkmcnt(" #n ")" ::: "memory")
#define PG8_BAR __builtin_amdgcn_s_barrier()
#define PG8_SCHED __builtin_amdgcn_sched_barrier(0)
    Unit cur, nxt; int ui = 0;
    if (!S.next(0, cur)) return;
    f32x4 acc[2][2][4][2];
#pragma unroll
    for (int a = 0; a < 2; ++a)
#pragma unroll
        for (int b = 0; b < 2; ++b)
#pragma unroll
            for (int m = 0; m < 4; ++m)
#pragma unroll
                for (int n = 0; n < 2; ++n) acc[a][b][m][n] = (f32x4){0.f, 0.f, 0.f, 0.f};
    bf16x8 At[4][2], B0[2][2], B1[2][2];
    const char* cA = (const char*)g.A + (size_t)cur.pm * tstep; const char* cB = (const char*)g.Bt + (size_t)cur.pn * tstep;
    S.a_ready(cur);
    PG8_STAGE(PG8_SB(0, 0), cB, voffB); PG8_STAGE(PG8_SA(0, 0), cA, voffA); PG8_STAGE(PG8_SB(0, 1), cB + hstep, voffB); PG8_STAGE(PG8_SA(0, 1), cA + hstep, voffA);
    if (wr == 1) PG8_BAR;
    PG8_WAIT_V(4); PG8_BAR;
    PG8_STAGE(PG8_SB(1, 0), cB + kstep, voffB); PG8_STAGE(PG8_SA(1, 0), cA + kstep, voffA); PG8_STAGE(PG8_SB(1, 1), cB + hstep + kstep, voffB);
    PG8_WAIT_V(6); PG8_BAR;
    PG8_STAMP();
    for (;;) {
        const bool has_next = S.next(ui + 1, nxt);
        const char* nA = has_next ? (const char*)g.A + (size_t)nxt.pm * tstep : cA; const char* nB = has_next ? (const char*)g.Bt + (size_t)nxt.pn * tstep : cB;
        for (int t = 0; t < nt; t += 2) {
            const bool last = (t == nt - 2);
            const char* a1 = cA + (size_t)(t + 1) * kstep;
            const char* a2 = last ? nA : cA + (size_t)(t + 2) * kstep; const char* b2 = last ? nB : cB + (size_t)(t + 2) * kstep;
            const char* a3 = a2 + kstep; const char* b3 = b2 + kstep;
            if (last && has_next) S.a_ready(nxt);
            PG8_LDB(B0, 0, 0); PG8_SCHED; PG8_LDA(At, 0, 0); PG8_STAGE(PG8_SA(1, 1), a1 + hstep, voffA);
            PG8_WAIT_L(8); PG8_BAR; PG8_WAIT_L(0); PG8_MMA(0, 0, At, B0); PG8_BAR; PG8_SCHED;
            PG8_LDB(B1, 0, 1); PG8_STAGE(PG8_SB(0, 0), b2, voffB);
            PG8_BAR; PG8_WAIT_L(0); PG8_MMA(0, 1, At, B1); PG8_BAR;
            PG8_LDA(At, 0, 1); PG8_STAGE(PG8_SA(0, 0), a2, voffA);
            PG8_BAR; PG8_WAIT_L(0); PG8_MMA(1, 0, At, B0); PG8_BAR; PG8_SCHED;
            PG8_STAGE(PG8_SB(0, 1), b2 + hstep, voffB);
            PG8_WAIT_V(6); PG8_BAR; PG8_MMA(1, 1, At, B1); PG8_BAR;
            PG8_LDB(B0, 1, 0); PG8_SCHED; PG8_LDA(At, 1, 0); PG8_STAGE(PG8_SA(0, 1), a2 + hstep, voffA);
            PG8_WAIT_L(8); PG8_BAR; PG8_WAIT_L(0); PG8_MMA(0, 0, At, B0); PG8_BAR; PG8_SCHED;
            PG8_LDB(B1, 1, 1); PG8_STAGE(PG8_SB(1, 0), b3, voffB);
            PG8_BAR; PG8_WAIT_L(0); PG8_MMA(0, 1, At, B1); PG8_BAR;
            PG8_LDA(At, 1, 1); PG8_STAGE(PG8_SA(1, 0), a3, voffA);
            PG8_BAR; PG8_WAIT_L(0); PG8_MMA(1, 0, At, B0); PG8_BAR; PG8_SCHED;
            PG8_STAGE(PG8_SB(1, 1), b3 + hstep, voffB);
            PG8_WAIT_V(6); PG8_BAR; PG8_MMA(1, 1, At, B1); PG8_BAR;
        }
        PG8_STAMP();
        if constexpr (!Epi::AFTER_DRAIN) { E(acc, cur, wr, wc, fr, fq); S.done(cur); }
        PG8_STAMP();
        if (!has_next) break;
#pragma unroll
        for (int a = 0; a < 2; ++a)
#pragma unroll
            for (int b = 0; b < 2; ++b)
#pragma unroll
                for (int m = 0; m < 4; ++m)
#pragma unroll
                    for (int n = 0; n < 2; ++n) acc[a][b][m][n] = (f32x4){0.f, 0.f, 0.f, 0.f};
        cur = nxt; cA = nA; cB = nB; ++ui;
    }
    PG8_WAIT_V(0);
    if (wr == 0) PG8_BAR;
    PG8_BAR;
    if constexpr (Epi::AFTER_DRAIN) { E.fused(acc, cur, wr, wc, fr, fq, lds, wid, lane); S.done(cur); }
    PG8_STAMP();
    if (STAMP && wid == 0) { stamps[lane] = lane < nts ? (((unsigned long long)(unsigned)ts_hi << 32) | (unsigned)ts_lo) : 0ull;
        if (lane == 62) stamps[62] = rt_entry; if (lane == 63) stamps[63] = (unsigned long long)wall_clock64(); }
#undef PG8_STAMP
#undef PG8_SA
#undef PG8_SB
#undef PG8_STAGE
#undef PG8_LDA
#undef PG8_LDB
#undef PG8_MMA
#undef PG8_WAIT_V
#undef PG8_WAIT_L
#undef PG8_BAR
#undef PG8_SCHED
}
}
#define XB_TMO      128
#define XB_XCNT(j)  (256  + 64 * (j))
#define XB_XSUB(j)  (1280 + 64 * (j))
#define XB_XGEN(j)  (2304 + 64 * (j))
#define XB_TOP      3328
#define XB_TOPGEN   3392
#define XCD_BAR_WORDS 3456
#define XB_SPIN_CAP (1u << 18)

__device__ __forceinline__ unsigned xb_ld(unsigned* p)              { return __hip_atomic_load(p, __ATOMIC_RELAXED, __HIP_MEMORY_SCOPE_AGENT); }
__device__ __forceinline__ unsigned xb_add(unsigned* p, unsigned v) { return __hip_atomic_fetch_add(p, v, __ATOMIC_RELAXED, __HIP_MEMORY_SCOPE_AGENT); }
__device__ __forceinline__ unsigned xb_xcc_id() { return (unsigned)__builtin_amdgcn_s_getreg((3 << 11) | 20) & 0xFu; }
#define XB_SPIN(cond, bar) do { unsigned _sp = 0; while (cond) { __builtin_amdgcn_s_sleep(1); \
    if ((++_sp & 255u) == 0u) { if (xb_ld(&(bar)[XB_TMO])) break; if (_sp > XB_SPIN_CAP) { atomicAdd(&(bar)[XB_TMO], 1u); break; } } } } while (0)

struct XcdBarrier {
    unsigned* bar; unsigned x;
    volatile LAS unsigned* st;
};

__device__ __forceinline__ XcdBarrier xcd_barrier_post(unsigned* bar, volatile LAS unsigned* st, const bool tid0_) {
    XcdBarrier b; b.bar = bar; b.x = xb_xcc_id(); b.st = st;
    if (tid0_) (void)xb_add(&bar[XB_XCNT(b.x)], 1u);
    return b;
}
__device__ __forceinline__ void xcd_barrier_complete(unsigned* bar, unsigned x, unsigned& nloc, unsigned& nx) {
    const unsigned G = gridDim.x * gridDim.y * gridDim.z;
    unsigned sum, cnt, mine, sp = 0u;
    for (;;) {
        sum = 0u; cnt = 0u; mine = 0u;
#pragma unroll
        for (unsigned j = 0; j < 16; ++j) { const unsigned c = xb_ld(&bar[XB_XCNT(j)]); sum += c; cnt += (c > 0u) ? 1u : 0u; mine = (j == x) ? c : mine; }
        if (sum == G) break;
        __builtin_amdgcn_s_sleep(1);
        if ((++sp & 255u) == 0u) { if (xb_ld(&bar[XB_TMO])) break; if (sp > XB_SPIN_CAP) { atomicAdd(&bar[XB_TMO], 1u); break; } }
    }
    nloc = mine > 0u ? mine : 1u; nx = cnt > 0u ? cnt : 1u;
}

__device__ __forceinline__ void xcd_barrier(const XcdBarrier& b, const bool tid0_) {
    asm volatile("s_waitcnt vmcnt(0)" ::: "memory");
    __syncthreads();
    if (tid0_) {
        unsigned* bar = b.bar;
        __builtin_amdgcn_s_waitcnt(0);
        unsigned nloc = b.st[0], nx = b.st[1];
        if (nloc == 0u) { xcd_barrier_complete(bar, b.x, nloc, nx); b.st[0] = nloc; b.st[1] = nx; }
        const unsigned old = xb_add(&bar[XB_XSUB(b.x)], 1u);
        const unsigned gen = old / nloc;
        if (old + 1u == (gen + 1u) * nloc) {
            __builtin_amdgcn_fence(__ATOMIC_RELEASE, "agent");
            asm volatile("s_waitcnt vmcnt(0)" ::: "memory");
            const unsigned og = xb_add(&bar[XB_TOP], 1u);
            const unsigned tg = og / nx;
            if (og + 1u == (tg + 1u) * nx) xb_add(&bar[XB_TOPGEN], 1u);
            else XB_SPIN(xb_ld(&bar[XB_TOPGEN]) == tg, bar);
            __builtin_amdgcn_fence(__ATOMIC_ACQUIRE, "agent");
            xb_add(&bar[XB_XGEN(b.x)], 1u);
            asm volatile("s_waitcnt vmcnt(0)" ::: "memory");
        } else {
            XB_SPIN(xb_ld(&bar[XB_XGEN(b.x)]) == gen, bar);
            __builtin_amdgcn_fence(__ATOMIC_ACQUIRE, "agent");
            asm volatile("s_waitcnt vmcnt(0)" ::: "memory");
        }
    }
    __syncthreads();
}

using pg8::bf16_t; using pg8::bf16x8; using pg8::f32x4; using pg8::u32x4;

constexpr int T = 49152, D = 2048, NP = 4608, DFF = 8192;
constexpr int P_K = 1024, P_V = 1280, P_LX = 1536, P_LG = 2048, P_RW = 2560;
constexpr size_t MiB = (size_t)1 << 20;
constexpr size_t WS_WIN = 0, WS_WOUT = WS_WIN + (size_t)NP * D * 2, WS_WUP = WS_WOUT + (size_t)D * D * 2, WS_WDN = WS_WUP + (size_t)DFF * D * 2;
constexpr size_t WS_SMALL = 90 * MiB, WS_LB = WS_SMALL, WS_W2T = WS_SMALL + 262144, WS_A2T = WS_SMALL + 393216, WS_G2T = WS_SMALL + 524288,
                 WS_RS1 = WS_SMALL + 1048576, WS_RS2 = WS_SMALL + 1310720, WS_BAR = WS_SMALL + 1572864;
constexpr size_t WS_XB = 92 * MiB, WS_P = 284 * MiB, WS_PREP = 716 * MiB, WS_YFB = 908 * MiB, WS_AGG = 1004 * MiB, WS_END = 1012 * MiB;
constexpr size_t WS_F = WS_P, WS_U = 476 * MiB;
constexpr int LDS_BYTES = 131072 + 16;

struct Params { const float* in[30]; float* out; unsigned char* ws; int ph_lo, ph_hi; };

#define DI __device__ __forceinline__
DI pg8::bf16_t* mixbuf_of(const Params& p) { return (pg8::bf16_t*)p.out + (size_t)T * D; }
DI unsigned pk_bf16(float lo, float hi) { unsigned r; asm("v_cvt_pk_bf16_f32 %0, %1, %2" : "=v"(r) : "v"(lo), "v"(hi)); return r; }
DI float bf_lo(unsigned w) { return __uint_as_float(w << 16); }
DI float bf_hi(unsigned w) { return __uint_as_float(w & 0xffff0000u); }
DI float bf_at(const u32x4& v, int j) { const unsigned w = v[j >> 1]; return (j & 1) ? bf_hi(w) : bf_lo(w); }
DI float sigm(float x) { return __builtin_amdgcn_rcpf(1.0f + __builtin_amdgcn_exp2f(-1.4426950408889634f * x)); }
DI float tanh_fast(float x) { return 1.0f - 2.0f * __builtin_amdgcn_rcpf(1.0f + __builtin_amdgcn_exp2f(2.8853900817779268f * x)); }
DI float exp_fast(float x) { return __builtin_amdgcn_exp2f(1.4426950408889634f * x); }
DI void seq_of(int row, int& s0, int& len) { if (row < 16384) { s0 = row & ~2047; len = 2048; } else { s0 = 16384 + ((row - 16384) & ~8191); len = 8192; } }
DI f32x4 mfma16(bf16x8 a, bf16x8 b, f32x4 c) { return __builtin_amdgcn_mfma_f32_16x16x32_bf16(a, b, c, 0, 0, 0); }

struct EpiBf16S {
    static constexpr bool PERM = true, AFTER_DRAIN = false;
    bf16_t* O; int ldc; const float* rs; int act;
    __device__ __forceinline__ void operator()(const f32x4 (&acc)[2][2][4][2], const pg8::Unit& u, int wr, int wc, int fr, int fq) const {
        const int row0 = u.pm * 256 + wr * 64 + fr, col0 = u.pn * 256 + wc * 32 + 8 * fq;
#pragma unroll
        for (int ai = 0; ai < 2; ++ai)
#pragma unroll
            for (int m = 0; m < 4; ++m) { const int row = row0 + ai * 128 + m * 16; const float s = rs ? rs[row] : 1.0f; bf16_t* rowp = O + (size_t)row * ldc + col0;
#pragma unroll
                for (int bj = 0; bj < 2; ++bj) { f32x4 v0 = acc[ai][bj][m][0] * s, v1 = acc[ai][bj][m][1] * s;
                    if (act) {
#pragma unroll
                        for (int j = 0; j < 4; ++j) { const float a = fmaxf(v0[j], 0.f), b = fmaxf(v1[j], 0.f); v0[j] = a * a; v1[j] = b * b; } }
                    u32x4 w; w.x = pk_bf16(v0[0], v0[1]); w.y = pk_bf16(v0[2], v0[3]); w.z = pk_bf16(v1[0], v1[1]); w.w = pk_bf16(v1[2], v1[3]);
                    *(u32x4*)(rowp + bj * 128) = w; } }
    }
};
struct EpiF32S {
    static constexpr bool PERM = false, AFTER_DRAIN = false;
    float* C; int ldc;
    __device__ __forceinline__ void operator()(const f32x4 (&acc)[2][2][4][2], const pg8::Unit& u, int wr, int wc, int fr, int fq) const {
        const int row0 = u.pm * 256 + wr * 64 + fr, col0 = u.pn * 256 + wc * 32 + 4 * fq;
#pragma unroll
        for (int ai = 0; ai < 2; ++ai)
#pragma unroll
            for (int m = 0; m < 4; ++m) { float* rowp = C + (size_t)(row0 + ai * 128 + m * 16) * ldc + col0;
#pragma unroll
                for (int bj = 0; bj < 2; ++bj)
#pragma unroll
                    for (int n = 0; n < 2; ++n) *(f32x4*)(rowp + bj * 128 + n * 16) = acc[ai][bj][m][n]; }
    }
};

struct WTile { const float* W; bf16_t* Wt; const float* gain; int ldw, k0, srcn0, ldt, dstn0; };
DI WTile wtile_of(int id, const float* w_in, const float* w_out, const float* w_up, const float* w_dn, const float* g_mix, const float* g_ffn, unsigned char* ws) {
    WTile t;
    if (id < 2304) { const int kt = id & 31, nt = id >> 5, dn = nt * 64; t = WTile{w_in, (bf16_t*)(ws + WS_WIN), g_mix, 4480, kt * 64, dn < 1536 ? dn + 2944 : (dn < 4480 ? dn - 1536 : -1), D, dn}; }
    else if (id < 3328) { const int j = id - 2304, kt = j & 31, nt = j >> 5; t = WTile{w_out, (bf16_t*)(ws + WS_WOUT), nullptr, D, kt * 64, nt * 64, D, nt * 64}; }
    else if (id < 7424) { const int j = id - 3328, kt = j & 31, nt = j >> 5; t = WTile{w_up, (bf16_t*)(ws + WS_WUP), g_ffn, DFF, kt * 64, nt * 64, D, nt * 64}; }
    else { const int j = id - 7424, kt = j & 127, nt = j >> 7; t = WTile{w_dn, (bf16_t*)(ws + WS_WDN), nullptr, D, kt * 64, nt * 64, DFF, nt * 64}; }
    return t; }
DI void wtile_load(const WTile& t, int tid, float4 (&v)[2]) {
#pragma unroll
    for (int it = 0; it < 2; ++it) { const int kk = (tid >> 4) + 32 * it, n4 = (tid & 15) * 4; v[it] = make_float4(0.f, 0.f, 0.f, 0.f);
        if (t.srcn0 >= 0) { v[it] = *(const float4*)(t.W + (size_t)(t.k0 + kk) * t.ldw + t.srcn0 + n4); if (t.gain) { const float g = t.gain[t.k0 + kk]; v[it].x *= g; v[it].y *= g; v[it].z *= g; v[it].w *= g; } } } }
__device__ void wprep_phase(const Params& p, int l, LAS unsigned char* lds, const int tid_) {
    LAS float* tile = (LAS float*)lds; const int tid = tid_;
    const float* w_in = p.in[6] + (size_t)l * D * 4480; const float* w_out = p.in[7] + (size_t)l * D * D;
    const float* w_up = p.in[28] + (size_t)l * D * DFF; const float* w_dn = p.in[29] + (size_t)l * DFF * D;
    const float* g_mix = p.in[2] + l * D; const float* g_ffn = p.in[4] + l * D;
    float4 v[2], vn[2];
    int id = blockIdx.x;
    WTile t = wtile_of(id < 11520 ? id : 0, w_in, w_out, w_up, w_dn, g_mix, g_ffn, p.ws);
    if (id < 11520) wtile_load(t, tid, v);
    for (; id < 11520; id += gridDim.x) {
        const int idn = id + gridDim.x;
        const WTile tn = wtile_of(idn < 11520 ? idn : 0, w_in, w_out, w_up, w_dn, g_mix, g_ffn, p.ws);
        if (idn < 11520) wtile_load(tn, tid, vn);
#pragma unroll
        for (int it = 0; it < 2; ++it) { const int kk = (tid >> 4) + 32 * it, n4 = (tid & 15) * 4;
            tile[kk * 65 + n4 + 0] = v[it].x; tile[kk * 65 + n4 + 1] = v[it].y; tile[kk * 65 + n4 + 2] = v[it].z; tile[kk * 65 + n4 + 3] = v[it].w; }
        __syncthreads();
        { const int nn = tid >> 3, kc = tid & 7; float e[8];
#pragma unroll
          for (int j = 0; j < 8; ++j) e[j] = tile[(8 * kc + j) * 65 + nn];
          u32x4 w; w.x = pk_bf16(e[0], e[1]); w.y = pk_bf16(e[2], e[3]); w.z = pk_bf16(e[4], e[5]); w.w = pk_bf16(e[6], e[7]);
          *(u32x4*)(t.Wt + (size_t)(t.dstn0 + nn) * t.ldt + t.k0 + 8 * kc) = w; }
        __syncthreads();
        t = tn; v[0] = vn[0]; v[1] = vn[1];
    }
    const int gt = blockIdx.x * 512 + tid_, gs = gridDim.x * 512;
    bf16_t* LB = (bf16_t*)(p.ws + WS_LB); bf16_t* W2T = (bf16_t*)(p.ws + WS_W2T); bf16_t* A2T = (bf16_t*)(p.ws + WS_A2T); bf16_t* G2T = (bf16_t*)(p.ws + WS_G2T);
    const float* wa = p.in[10] + (size_t)l * 65536; const float* wx = p.in[12] + (size_t)l * 65536;
    for (int e = gt; e < 131072; e += gs) { const int i = e & 63, c = (e >> 6) & 63, gate = (e >> 12) & 1, d = (e >> 13) & 1, n = e >> 14;
        const float v = (gate ? wx : wa)[((d * 8 + n) * 64 + i) * 64 + c]; LB[e] = (bf16_t)(pk_bf16(v, 0.f) & 0xffffu); }
    const float* w2 = p.in[17] + (size_t)l * 65536; const float* a2 = p.in[19] + (size_t)l * 65536; const float* g2 = p.in[20] + (size_t)l * 65536;
    for (int e = gt; e < 65536; e += gs) { const int rk = e & 63, c = (e >> 6) & 511, d = e >> 15;
        W2T[e] = (bf16_t)(pk_bf16(w2[(d * 64 + rk) * 512 + c], 0.f) & 0xffffu); A2T[e] = (bf16_t)(pk_bf16(a2[(d * 64 + rk) * 512 + c], 0.f) & 0xffffu); }
    for (int e = gt; e < 65536; e += gs) { const int rk = e & 127, c = e >> 7; G2T[e] = (bf16_t)(pk_bf16(g2[rk * 512 + c], 0.f) & 0xffffu); }
}

DI float wave_sum(float v) {
#pragma unroll
    for (int o = 32; o >= 1; o >>= 1) v += __shfl_xor(v, o);
    return v; }
__device__ void rowpass0(const Params& p, const int tid_) {
    const int lane = tid_ & 63, gw = blockIdx.x * 8 + (tid_ >> 6), nw = gridDim.x * 8;
    bf16_t* XB = (bf16_t*)(p.ws + WS_XB); float* RS1 = (float*)(p.ws + WS_RS1);
    for (int row = gw; row < T; row += nw) {
        const float* src = row < 16384 ? p.in[0] + (size_t)row * D : p.in[1] + (size_t)(row - 16384) * D;
        float ss = 0.f; float4 v[8];
#pragma unroll
        for (int i = 0; i < 8; ++i) { v[i] = ((const float4*)src)[lane + 64 * i]; ss += v[i].x * v[i].x + v[i].y * v[i].y + v[i].z * v[i].z + v[i].w * v[i].w; }
        ss = wave_sum(ss);
        const float rs = rsqrtf(ss * (1.0f / 2048.0f) + 1e-6f);
#pragma unroll
        for (int i = 0; i < 8; ++i) { u32x2 w; w.x = pk_bf16(v[i].x * rs, v[i].y * rs); w.y = pk_bf16(v[i].z * rs, v[i].w * rs); *(u32x2*)(XB + (size_t)row * D + 4 * (lane + 64 * i)) = w; }
        if (lane == 0) RS1[row] = rs;
    }
}
__device__ void rowpass_post(const Params& p, const bf16_t* Y, const float* gpost, int xmode, const float* RSin, float* RS, int outmode, const int tid_) {
    const int lane = tid_ & 63, gw = blockIdx.x * 8 + (tid_ >> 6), nw = gridDim.x * 8;
    bf16_t* XB = (bf16_t*)(p.ws + WS_XB); bf16_t* XS = (bf16_t*)p.out;
    float g[4][8];
#pragma unroll
    for (int i = 0; i < 4; ++i)
#pragma unroll
        for (int j = 0; j < 8; ++j) g[i][j] = gpost[8 * (lane + 64 * i) + j];
    for (int row = gw; row < T; row += nw) {
        float y[4][8], x[4][8]; float ss = 0.f;
#pragma unroll
        for (int i = 0; i < 4; ++i) { const size_t off = (size_t)row * D + 8 * (lane + 64 * i);
            const u32x4 yv = *(const u32x4*)(Y + off);
#pragma unroll
            for (int j = 0; j < 8; ++j) { y[i][j] = bf_at(yv, j); ss += y[i][j] * y[i][j]; }
            if (xmode == 0) { const float* xs = row < 16384 ? p.in[0] + off : p.in[1] + (off - (size_t)16384 * D);
                const float4 a = *(const float4*)xs, b = *(const float4*)(xs + 4);
                x[i][0] = a.x; x[i][1] = a.y; x[i][2] = a.z; x[i][3] = a.w; x[i][4] = b.x; x[i][5] = b.y; x[i][6] = b.z; x[i][7] = b.w; }
            else { const u32x4 xv = *(const u32x4*)((xmode == 1 ? XS : XB) + off); const float us = xmode == 2 ? 1.0f / RSin[row] : 1.0f;
#pragma unroll
                for (int j = 0; j < 8; ++j) x[i][j] = bf_at(xv, j) * us; } }
        ss = wave_sum(ss);
        const float ry = rsqrtf(ss * (1.0f / 2048.0f) + 1e-6f);
        float s2 = 0.f;
#pragma unroll
        for (int i = 0; i < 4; ++i)
#pragma unroll
            for (int j = 0; j < 8; ++j) { x[i][j] += y[i][j] * ry * g[i][j]; s2 += x[i][j] * x[i][j]; }
        s2 = wave_sum(s2);
        const float rsn = rsqrtf(s2 * (1.0f / 2048.0f) + 1e-6f);
#pragma unroll
        for (int i = 0; i < 4; ++i) { const size_t off = (size_t)row * D + 8 * (lane + 64 * i);
            if (outmode == 2) { *(float4*)(p.out + off) = make_float4(x[i][0], x[i][1], x[i][2], x[i][3]); *(float4*)(p.out + off + 4) = make_float4(x[i][4], x[i][5], x[i][6], x[i][7]); }
            else { u32x4 w; w.x = pk_bf16(x[i][0] * rsn, x[i][1] * rsn); w.y = pk_bf16(x[i][2] * rsn, x[i][3] * rsn); w.z = pk_bf16(x[i][4] * rsn, x[i][5] * rsn); w.w = pk_bf16(x[i][6] * rsn, x[i][7] * rsn);
                *(u32x4*)(XB + off) = w;
                if (outmode == 1) { u32x4 u; u.x = pk_bf16(x[i][0], x[i][1]); u.y = pk_bf16(x[i][2], x[i][3]); u.z = pk_bf16(x[i][4], x[i][5]); u.w = pk_bf16(x[i][6], x[i][7]); *(u32x4*)(XS + off) = u; } } }
        if (outmode != 2 && lane == 0) RS[row] = rsn;
    }
}

__device__ void attn_unit(const Params& p, int l, int unit, LAS unsigned char* lds, const int tid_) {
    const int tid = tid_, lane = tid & 63, w = tid >> 6, r = lane & 15, q = lane >> 4;
    const int qb = unit >> 3, hq = unit & 7, kvh = hq >> 2;
    const int g0 = qb * 128; int s0, len; seq_of(g0, s0, len);
    const bf16_t* P = (const bf16_t*)(p.ws + WS_P); bf16_t* MB = mixbuf_of(p);
    LAS bf16_t* Ks = (LAS bf16_t*)lds;
    LAS bf16_t* Vt = (LAS bf16_t*)(lds + 34816);
    LAS float* btab = (LAS float*)(lds + 69632);
    const int ql = 16 * w + r;
    __syncthreads();
    {
        const int rel = tid - 256, n = rel < 0 ? -rel : rel;
        const int bkt = (rel > 0 ? 16 : 0) + (n < 8 ? n : n < 12 ? 8 : n < 16 ? 9 : n < 23 ? 10 : n < 32 ? 11 : n < 46 ? 12 : n < 64 ? 13 : n < 91 ? 14 : 15);
        btab[tid] = n <= 128 ? p.in[27][bkt * 8 + hq] : -1e30f; }
    bf16x8 qf[4];
#pragma unroll
    for (int ks = 0; ks < 4; ++ks) qf[ks] = *(const bf16x8*)(P + (size_t)(g0 + ql) * NP + hq * 128 + 32 * ks + 8 * q);
    float m = p.in[26][l * 8 + hq], lsum = q == 0 ? 1.0f : 0.0f; f32x4 o[8];
#pragma unroll
    for (int dt = 0; dt < 8; ++dt) o[dt] = (f32x4){0.f, 0.f, 0.f, 0.f};
    const float scale = 0.08838834764831845f;
#pragma unroll 1
    for (int kbi = 0; kbi < 3; ++kbi) {
        const int gk0 = g0 + (kbi - 1) * 128;
        if (gk0 < s0 || gk0 >= s0 + len) continue;
        __syncthreads();
#pragma unroll
        for (int i = 0; i < 4; ++i) { const int id = tid + 512 * i, row = id >> 4, ch = id & 15;
            const u32x4 v = *(const u32x4*)(P + (size_t)(gk0 + row) * NP + P_K + kvh * 128 + 8 * ch); *(LAS u32x4*)(Ks + row * 136 + 8 * ch) = v; }
#pragma unroll
        for (int i = 0; i < 4; ++i) { const int id = tid + 512 * i, key = id & 127, dc = id >> 7;
            const u32x4 v = *(const u32x4*)(P + (size_t)(gk0 + key) * NP + P_V + kvh * 128 + 8 * dc);
#pragma unroll
            for (int j = 0; j < 4; ++j) { Vt[(8 * dc + 2 * j) * 136 + key] = (bf16_t)(v[j] & 0xffffu); Vt[(8 * dc + 2 * j + 1) * 136 + key] = (bf16_t)(v[j] >> 16); } }
        __syncthreads();
        f32x4 s[8];
#pragma unroll
        for (int kt = 0; kt < 8; ++kt) { f32x4 acc = (f32x4){0.f, 0.f, 0.f, 0.f};
#pragma unroll
            for (int ks = 0; ks < 4; ++ks) { const bf16x8 a = *(const LAS bf16x8*)(Ks + (16 * kt + r) * 136 + 32 * ks + 8 * q); acc = mfma16(a, qf[ks], acc); }
            s[kt] = acc; }
        float mx = -1e30f;
        const LAS float* bt = btab + ((kbi - 1) * 128 + 4 * q - ql + 256);
#pragma unroll
        for (int kt = 0; kt < 8; ++kt)
#pragma unroll
            for (int i = 0; i < 4; ++i) { const float v = s[kt][i] * scale + bt[16 * kt + i]; s[kt][i] = v; mx = fmaxf(mx, v); }
        mx = fmaxf(mx, __shfl_xor(mx, 16)); mx = fmaxf(mx, __shfl_xor(mx, 32));
        const float mn = fmaxf(m, mx), alpha = exp_fast(m - mn); m = mn;
        float ps = 0.f;
#pragma unroll
        for (int kt = 0; kt < 8; ++kt)
#pragma unroll
            for (int i = 0; i < 4; ++i) { const float pv = exp_fast(s[kt][i] - mn); s[kt][i] = pv; ps += pv; }
        lsum = lsum * alpha + ps;
#pragma unroll
        for (int dt = 0; dt < 8; ++dt) o[dt] *= alpha;
#pragma unroll
        for (int kk = 0; kk < 4; ++kk) {
            u32x4 pw; pw.x = pk_bf16(s[2 * kk][0], s[2 * kk][1]); pw.y = pk_bf16(s[2 * kk][2], s[2 * kk][3]); pw.z = pk_bf16(s[2 * kk + 1][0], s[2 * kk + 1][1]); pw.w = pk_bf16(s[2 * kk + 1][2], s[2 * kk + 1][3]);
            const bf16x8 pf = __builtin_bit_cast(bf16x8, pw);
#pragma unroll
            for (int dt = 0; dt < 8; ++dt) {
                const u32x2 lo = *(const LAS u32x2*)(Vt + (16 * dt + r) * 136 + 32 * kk + 4 * q), hi = *(const LAS u32x2*)(Vt + (16 * dt + r) * 136 + 32 * kk + 16 + 4 * q);
                u32x4 vw; vw.x = lo.x; vw.y = lo.y; vw.z = hi.x; vw.w = hi.y;
                o[dt] = mfma16(__builtin_bit_cast(bf16x8, vw), pf, o[dt]); }
        }
    }
    float lt = lsum; lt += __shfl_xor(lt, 16); lt += __shfl_xor(lt, 32);
    const float inv = 1.0f / lt;
    bf16_t* dst = MB + (size_t)(g0 + ql) * D + 1024 + hq * 128 + 4 * q;
#pragma unroll
    for (int dt = 0; dt < 8; ++dt) { u32x2 wv; wv.x = pk_bf16(o[dt][0] * inv, o[dt][1] * inv); wv.y = pk_bf16(o[dt][2] * inv, o[dt][3] * inv); *(u32x2*)(dst + 16 * dt) = wv; }
}

__device__ void rwkv_prep_tile(const Params& p, int l, int tile, LAS unsigned char* lds, const int tid_) {
    const int tid = tid_, lane = tid & 63, w = tid >> 6, r = lane & 15, q = lane >> 4;
    const int t0 = tile * 64; int s0, len; seq_of(t0, s0, len);
    LAS bf16_t* raw = (LAS bf16_t*)lds;
    LAS bf16_t* A = (LAS bf16_t*)(lds + 50688);
    const bf16_t* P = (const bf16_t*)(p.ws + WS_P); bf16_t* MB = mixbuf_of(p); _Float16* PREP = (_Float16*)(p.ws + WS_PREP);
    const bf16_t* W2T = (const bf16_t*)(p.ws + WS_W2T); const bf16_t* A2T = (const bf16_t*)(p.ws + WS_A2T); const bf16_t* G2T = (const bf16_t*)(p.ws + WS_G2T);
    const float* mu = p.in[15] + l * 1920 + 1536; const float* w0 = p.in[16] + l * 1024; const float* a0 = p.in[18] + l * 1024;
    __syncthreads();
    for (int id = tid; id < 66 * 48; id += 512) { const int row = id / 48, ch = id % 48, gr = t0 - 1 + row; u32x4 v = (u32x4){0u, 0u, 0u, 0u};
        if (gr >= s0 && gr < s0 + len) v = *(const u32x4*)(P + (size_t)gr * NP + P_RW + 1536 + 8 * ch);
        *(LAS u32x4*)(raw + row * 384 + 8 * ch) = v; }
    __syncthreads();
    for (int id = tid; id < 64 * 48; id += 512) { const int tok = id / 48, ch = id % 48, col = 8 * ch;
        const u32x4 a = *(const LAS u32x4*)(raw + tok * 384 + col), b = *(const LAS u32x4*)(raw + (tok + 1) * 384 + col), c = *(const LAS u32x4*)(raw + (tok + 2) * 384 + col);
        float o[8];
#pragma unroll
        for (int j = 0; j < 8; ++j) { const float zm = bf_at(a, j), z = bf_at(b, j), zp = bf_at(c, j); float zz = z + (0.5f * (zm + zp) - z) * mu[col + j];
            if (col < 128) zz = tanh_fast(zz); else if (col >= 256) zz = sigm(zz); o[j] = zz; }
        u32x4 wv; wv.x = pk_bf16(o[0], o[1]); wv.y = pk_bf16(o[2], o[3]); wv.z = pk_bf16(o[4], o[5]); wv.w = pk_bf16(o[6], o[7]);
        *(LAS u32x4*)(A + tok * 392 + col) = wv; }
    __syncthreads();
#pragma unroll 1
    for (int og = 0; og < 5; ++og) {
        const int nks = og < 4 ? 2 : 4, acol0 = og < 4 ? 64 * og : 256, ldb = og < 4 ? 64 : 128;
        const bf16_t* Bt = og < 2 ? W2T + og * 32768 : (og < 4 ? A2T + (og - 2) * 32768 : G2T);
        f32x4 acc[4][4];
#pragma unroll
        for (int mt = 0; mt < 4; ++mt)
#pragma unroll
            for (int nt = 0; nt < 4; ++nt) acc[mt][nt] = (f32x4){0.f, 0.f, 0.f, 0.f};
#pragma unroll 1
        for (int ks = 0; ks < nks; ++ks) {
            bf16x8 bfr[4];
#pragma unroll
            for (int nt = 0; nt < 4; ++nt) bfr[nt] = *(const bf16x8*)(Bt + (size_t)(64 * w + 16 * nt + r) * ldb + 32 * ks + 8 * q);
#pragma unroll
            for (int mt = 0; mt < 4; ++mt) { const bf16x8 a = *(const LAS bf16x8*)(A + (16 * mt + r) * 392 + acol0 + 32 * ks + 8 * q);
#pragma unroll
                for (int nt = 0; nt < 4; ++nt) acc[mt][nt] = mfma16(bfr[nt], a, acc[mt][nt]); }
        }
        {
            _Float16* pb = PREP + (size_t)(t0 + r) * 2048 + og * 512 + 64 * w + 4 * q; bf16_t* mb = MB + (size_t)(t0 + r) * D + 512 + 64 * w + 4 * q;
            const float* bsrc = og < 2 ? w0 + og * 512 : a0 + (og - 2) * 512;
#pragma unroll
            for (int nt = 0; nt < 4; ++nt) { f32x4 bias = (f32x4){0.f, 0.f, 0.f, 0.f}; if (og < 4) bias = *(const f32x4*)(bsrc + 64 * w + 16 * nt + 4 * q);
#pragma unroll
                for (int mt = 0; mt < 4; ++mt) { const f32x4 x = acc[mt][nt] + bias;
                    if (og < 4) { f16x4 hv;
#pragma unroll
                        for (int i = 0; i < 4; ++i) { const float sg = sigm(x[i]); hv[i] = (_Float16)(og < 2 ? exp_fast(-0.606531f * sg) : sg); }
                        *(f16x4*)(pb + (size_t)mt * 16 * 2048 + 16 * nt) = hv; }
                    else { u32x2 wv; wv.x = pk_bf16(x[0], x[1]); wv.y = pk_bf16(x[2], x[3]); *(u32x2*)(mb + (size_t)mt * 16 * D + 16 * nt) = wv; }
                    asm volatile("" ::: "memory"); } }
        }
    }
}

DI float fma_s(float a, float b, float c) { float d; asm("v_fma_f32 %0, %1, %2, %3" : "=v"(d) : "v"(a), "v"(b), "v"(c)); return d; }
DI float mul_s(float a, float b) { float d; asm("v_mul_f32 %0, %1, %2" : "=v"(d) : "v"(a), "v"(b)); return d; }
template <int CTRL> DI float dpp_xadd(float v) { return v + __int_as_float(__builtin_amdgcn_update_dpp(0, __float_as_int(v), CTRL, 0xF, 0xF, true)); }
DI float sum16(float v) { v = dpp_xadd<0xB1>(v); v = dpp_xadd<0x4E>(v); v = dpp_xadd<0x141>(v); v = dpp_xadd<0x140>(v); return v; }
DI float sum8(float v) { v = dpp_xadd<0xB1>(v); v = dpp_xadd<0x4E>(v); v = dpp_xadd<0x141>(v); return v; }
__device__ void rwkv_scan_task(const Params& p, int l, int htask, LAS unsigned char* lds, const int tid_) {
    const int tid = tid_;
    const int task = htask >> 1, rhalf = htask & 1;
    int seq, hd; if (task < 64) { seq = 8 + (task >> 4); hd = task & 15; } else { const int j = task - 64; seq = j >> 4; hd = j & 15; }
    const int h = hd >> 1, d = hd & 1;
    const int s0 = seq < 8 ? seq * 2048 : 16384 + (seq - 8) * 8192, len = seq < 8 ? 2048 : 8192, ntiles = len / 32;
    LAS float* ldsf = (LAS float*)lds;
    const bf16_t* P = (const bf16_t*)(p.ws + WS_P); const _Float16* PREP = (const _Float16*)(p.ws + WS_PREP); bf16_t* YFB = (bf16_t*)(p.ws + WS_YFB);
    __syncthreads();
    if (tid >= 256) {
        const int pt = tid - 256, ptok = pt >> 3, cq = pt & 7, c0 = 64 * h + 8 * cq;
        const float* mu = p.in[15] + l * 1920;
        float mu_c[3][8], kk_c[8], ka_c[8];
#pragma unroll
        for (int j = 0; j < 8; ++j) { mu_c[0][j] = mu[c0 + j]; mu_c[1][j] = mu[512 + c0 + j]; mu_c[2][j] = mu[1024 + c0 + j]; kk_c[j] = p.in[21][l * 512 + c0 + j]; ka_c[j] = p.in[22][(l * 2 + d) * 512 + c0 + j]; }
        u32x4 raw[3][3], rw_w, rw_a;
        const u32x4 zero4 = (u32x4){0u, 0u, 0u, 0u};
#define RW_TT(ti) (d ? len - 32 * ((ti) + 1) + (31 - ptok) : 32 * (ti) + ptok)
#define RW_LOAD(ti) do { const int tt_ = RW_TT(ti); const size_t gr_ = (size_t)(s0 + tt_); \
            _Pragma("unroll") for (int X = 0; X < 3; ++X) { const bf16_t* b_ = P + gr_ * NP + P_RW + 512 * X + c0; raw[X][1] = *(const u32x4*)b_; \
                raw[X][0] = tt_ > 0 ? *(const u32x4*)(b_ - NP) : zero4; raw[X][2] = tt_ < len - 1 ? *(const u32x4*)(b_ + NP) : zero4; } \
            rw_w = *(const u32x4*)(PREP + gr_ * 2048 + d * 512 + c0); rw_a = *(const u32x4*)(PREP + gr_ * 2048 + (2 + d) * 512 + c0); } while (0)
#define RW_CONVERT(bufi) do { LAS float* ob_ = ldsf + (bufi) * 11264; float z_[3][8]; \
            _Pragma("unroll") for (int X = 0; X < 3; ++X) _Pragma("unroll") for (int j = 0; j < 8; ++j) { const float zc_ = bf_at(raw[X][1], j); z_[X][j] = zc_ + (0.5f * (bf_at(raw[X][0], j) + bf_at(raw[X][2], j)) - zc_) * mu_c[X][j]; } \
            const f16x8 wh_ = __builtin_bit_cast(f16x8, rw_w), ah_ = __builtin_bit_cast(f16x8, rw_a); float kkn_[8], ss_ = 0.f; \
            _Pragma("unroll") for (int j = 0; j < 8; ++j) { kkn_[j] = z_[1][j] * kk_c[j]; ss_ += kkn_[j] * kkn_[j]; } \
            ss_ = sum8(ss_); const float inv_ = rsqrtf(fmaxf(ss_, 1e-24f)); \
            _Pragma("unroll") for (int hh = 0; hh < 2; ++hh) { f32x4 vK, vW, vB, vKh, vR, vV; \
                _Pragma("unroll") for (int j = 0; j < 4; ++j) { const int jj = 4 * hh + j; const float av = (float)ah_[jj]; vK[j] = kkn_[jj] * inv_; vW[j] = (float)wh_[jj]; vB[j] = vK[j] * av; \
                    vKh[j] = z_[1][jj] * (1.0f + (av - 1.0f) * ka_c[jj]); vR[j] = z_[0][jj]; vV[j] = z_[2][jj]; } \
                const int o_ = ptok * 64 + 8 * cq + 4 * hh; \
                *(LAS f32x4*)(ob_ + o_) = vK; *(LAS f32x4*)(ob_ + 2048 + o_) = vW; *(LAS f32x4*)(ob_ + 4096 + o_) = vB; *(LAS f32x4*)(ob_ + 6144 + o_) = vKh; *(LAS f32x4*)(ob_ + 8192 + o_) = vR; \
                if ((cq >> 2) == rhalf) *(LAS f32x4*)(ob_ + 10240 + ptok * 32 + 8 * (cq & 3) + 4 * hh) = vV; } } while (0)
#define RW_STOREY(ti) do { const int tt_ = RW_TT(ti); const f32x4 yv_ = *(const LAS f32x4*)(ldsf + 22528 + ((ti) & 1) * 1024 + ptok * 32 + 4 * cq); \
            u32x2 wv_; wv_.x = pk_bf16(yv_[0], yv_[1]); wv_.y = pk_bf16(yv_[2], yv_[3]); \
            *(u32x2*)(YFB + ((size_t)d * T + (size_t)(s0 + tt_)) * 512 + 64 * h + 32 * rhalf + 4 * cq) = wv_; } while (0)
        RW_LOAD(0); RW_CONVERT(0); RW_LOAD(1);
        __syncthreads();
        for (int ti = 0; ti < ntiles; ++ti) {
            if (ti + 1 < ntiles) { RW_CONVERT((ti + 1) & 1); if (ti + 2 < ntiles) RW_LOAD(ti + 2); }
            if (ti > 0) RW_STOREY(ti - 1);
            __syncthreads();
        }
        RW_STOREY(ntiles - 1);
#undef RW_LOAD
#undef RW_CONVERT
#undef RW_STOREY
#undef RW_TT
    } else {
        const int rv = tid >> 3, rg = tid & 7;
        __builtin_amdgcn_s_setprio(3);
        f32x2 st[4];
#pragma unroll
        for (int i = 0; i < 4; ++i) st[i] = (f32x2){0.f, 0.f};
        __syncthreads();
        for (int ti = 0; ti < ntiles; ++ti) {
            const LAS float* ob = ldsf + (ti & 1) * 11264 + 8 * rg; const LAS float* ov = ldsf + (ti & 1) * 11264 + 10240 + rv; LAS float* yb = ldsf + 22528 + (ti & 1) * 1024 + rv;
#define RW_FETCH(dst, dv, s) do { _Pragma("unroll") for (int a_ = 0; a_ < 5; ++a_) { dst[2 * a_] = *(const LAS f32x4*)(ob + a_ * 2048 + (s) * 64); dst[2 * a_ + 1] = *(const LAS f32x4*)(ob + a_ * 2048 + (s) * 64 + 4); } dv = ov[(s) * 32]; } while (0)
            f32x4 cur[10], nxt[10]; float cv, nv;
            RW_FETCH(cur, cv, 0);
#pragma unroll 1
            for (int s8 = 0; s8 < 32; s8 += 8) {
                float yk = 0.f;
#pragma unroll
                for (int j = 0; j < 8; ++j) { const int s = s8 + j;
                    { const int sn = s + 1 < 32 ? s + 1 : 31; RW_FETCH(nxt, nv, sn); }
                    const f32x2 vv2 = (f32x2){cv, cv};
                    const f32x2 t0 = st[0] * (f32x2){cur[2][0], cur[2][1]} + vv2 * (f32x2){cur[6][0], cur[6][1]}, t1 = st[1] * (f32x2){cur[2][2], cur[2][3]} + vv2 * (f32x2){cur[6][2], cur[6][3]};
                    const f32x2 t2 = st[2] * (f32x2){cur[3][0], cur[3][1]} + vv2 * (f32x2){cur[7][0], cur[7][1]}, t3 = st[3] * (f32x2){cur[3][2], cur[3][3]} + vv2 * (f32x2){cur[7][2], cur[7][3]};
                    const f32x2 sa2 = (st[0] * (f32x2){cur[0][0], cur[0][1]} + st[1] * (f32x2){cur[0][2], cur[0][3]}) + (st[2] * (f32x2){cur[1][0], cur[1][1]} + st[3] * (f32x2){cur[1][2], cur[1][3]});
                    const float sa = sum8(sa2[0] + sa2[1]);
                    const f32x2 nsa = (f32x2){-sa, -sa};
                    st[0] = nsa * (f32x2){cur[4][0], cur[4][1]} + t0; st[1] = nsa * (f32x2){cur[4][2], cur[4][3]} + t1;
                    st[2] = nsa * (f32x2){cur[5][0], cur[5][1]} + t2; st[3] = nsa * (f32x2){cur[5][2], cur[5][3]} + t3;
                    const f32x2 y2 = (st[0] * (f32x2){cur[8][0], cur[8][1]} + st[1] * (f32x2){cur[8][2], cur[8][3]}) + (st[2] * (f32x2){cur[9][0], cur[9][1]} + st[3] * (f32x2){cur[9][2], cur[9][3]});
                    const float y = sum8(y2[0] + y2[1]);
                    yk = (rg == j) ? y : yk;
#pragma unroll
                    for (int a_ = 0; a_ < 10; ++a_) cur[a_] = nxt[a_];
                    cv = nv; }
                yb[(s8 + rg) * 32] = yk;
            }
#undef RW_FETCH
            __syncthreads();
        }
        __builtin_amdgcn_s_setprio(0);
    }
}

__device__ void rwkv_final(const Params& p, int l, const int tid_) {
    const int lane = tid_ & 63, gw = blockIdx.x * 8 + (tid_ >> 6), nw = gridDim.x * 8, c0 = 8 * lane, h = lane >> 3;
    const bf16_t* P = (const bf16_t*)(p.ws + WS_P); const _Float16* PREP = (const _Float16*)(p.ws + WS_PREP); const bf16_t* YFB = (const bf16_t*)(p.ws + WS_YFB); bf16_t* MB = mixbuf_of(p);
    const float* mu = p.in[15] + l * 1920;
    float mu_c[3][8], ka0[8], ka1[8], rk[8], gnw[8], gnb[8];
#pragma unroll
    for (int j = 0; j < 8; ++j) { mu_c[0][j] = mu[c0 + j]; mu_c[1][j] = mu[512 + c0 + j]; mu_c[2][j] = mu[1024 + c0 + j];
        ka0[j] = p.in[22][(l * 2 + 0) * 512 + c0 + j]; ka1[j] = p.in[22][(l * 2 + 1) * 512 + c0 + j]; rk[j] = p.in[23][l * 512 + h * 64 + (c0 & 63) + j];
        gnw[j] = p.in[24][l * 512 + c0 + j]; gnb[j] = p.in[25][l * 512 + c0 + j]; }
    for (int row = gw; row < T; row += nw) {
        int s0, len; seq_of(row, s0, len); const bool hm = row > s0, hp = row < s0 + len - 1;
        const u32x4 yf = *(const u32x4*)(YFB + (size_t)row * 512 + c0), yb = *(const u32x4*)(YFB + ((size_t)T + row) * 512 + c0);
        float y[8], sum = 0.f;
#pragma unroll
        for (int j = 0; j < 8; ++j) { y[j] = bf_at(yf, j) + bf_at(yb, j); sum += y[j]; }
        sum += __shfl_xor(sum, 1); sum += __shfl_xor(sum, 2); sum += __shfl_xor(sum, 4);
        const float mean = sum * (1.0f / 64.0f); float var = 0.f;
#pragma unroll
        for (int j = 0; j < 8; ++j) { const float dd = y[j] - mean; var += dd * dd; }
        var += __shfl_xor(var, 1); var += __shfl_xor(var, 2); var += __shfl_xor(var, 4);
        const float rstd = rsqrtf(var * (1.0f / 64.0f) + 64e-5f);
        float z[3][8];
        const u32x4 zero4 = (u32x4){0u, 0u, 0u, 0u};
#pragma unroll
        for (int X = 0; X < 3; ++X) { const bf16_t* b = P + (size_t)row * NP + P_RW + 512 * X + c0;
            const u32x4 zc = *(const u32x4*)b, zm = hm ? *(const u32x4*)(b - NP) : zero4, zp = hp ? *(const u32x4*)(b + NP) : zero4;
#pragma unroll
            for (int j = 0; j < 8; ++j) { const float c = bf_at(zc, j); z[X][j] = c + (0.5f * (bf_at(zm, j) + bf_at(zp, j)) - c) * mu_c[X][j]; } }
        const f16x8 a0 = *(const f16x8*)(PREP + (size_t)row * 2048 + 1024 + c0), a1 = *(const f16x8*)(PREP + (size_t)row * 2048 + 1536 + c0);
        float bs = 0.f;
#pragma unroll
        for (int j = 0; j < 8; ++j) { const float k0 = z[1][j] * (1.0f + ((float)a0[j] - 1.0f) * ka0[j]), k1 = z[1][j] * (1.0f + ((float)a1[j] - 1.0f) * ka1[j]); bs += z[0][j] * (k0 + k1) * rk[j]; }
        bs += __shfl_xor(bs, 1); bs += __shfl_xor(bs, 2); bs += __shfl_xor(bs, 4);
        const u32x4 gv = *(const u32x4*)(MB + (size_t)row * D + 512 + c0);
        float o[8];
#pragma unroll
        for (int j = 0; j < 8; ++j) o[j] = ((y[j] - mean) * rstd * gnw[j] + gnb[j] + bs * z[2][j]) * bf_at(gv, j);
        u32x4 wv; wv.x = pk_bf16(o[0], o[1]); wv.y = pk_bf16(o[2], o[3]); wv.z = pk_bf16(o[4], o[5]); wv.w = pk_bf16(o[6], o[7]);
        *(u32x4*)(MB + (size_t)row * D + 512 + c0) = wv;
    }
}

DI float gelu_tanh(float x) { const float u = 0.7978845608028654f * (x + 0.044715f * x * x * x); return 0.5f * x * (1.0f + tanh_fast(u)); }
__device__ void lru_run(const Params& p, int l, int n, int tile_first, int tile_stride, int tile_count, int mode, LAS unsigned char* lds, const int tid_) {
    const int tid = tid_, lane = tid & 63, w = tid >> 6, r = lane & 15, q = lane >> 4;
    LAS float* xcf = (LAS float*)lds;
    LAS bf16_t* Ab = (LAS bf16_t*)(lds + 16384);
    LAS float* aL = (LAS float*)(lds + 25600);
    LAS float* uL = (LAS float*)(lds + 58368);
    LAS float* agg = (LAS float*)(lds + 91136);
    LAS float* carry = (LAS float*)(lds + 95232);
    const bf16_t* P = (const bf16_t*)(p.ws + WS_P); bf16_t* MB = mixbuf_of(p); const bf16_t* LB = (const bf16_t*)(p.ws + WS_LB);
    f32x2* AGG = (f32x2*)(p.ws + WS_AGG);
    const int tok = tid >> 3, cg8 = tid & 7, ch0 = 64 * n + 8 * cg8;
    LAS float* cwl = (LAS float*)(lds + 95744);
    __syncthreads();
    if (tid < 320) { const int k = tid >> 6, c = tid & 63; cwl[tid] = k < 4 ? p.in[8][(l * 4 + k) * 512 + 64 * n + c] : p.in[9][l * 512 + 64 * n + c]; }
    const int gd = w >> 2, ct = w & 3, chl = 16 * ct + r, gc = 64 * n + chl;
    bf16x8 br[2], bi[2];
#pragma unroll
    for (int ks = 0; ks < 2; ++ks) { br[ks] = *(const bf16x8*)(LB + (size_t)(n * 256 + (gd * 2 + 0) * 64 + chl) * 64 + 32 * ks + 8 * q);
                                     bi[ks] = *(const bf16x8*)(LB + (size_t)(n * 256 + (gd * 2 + 1) * 64 + chl) * 64 + 32 * ks + 8 * q); }
    const float ba_c = p.in[11][(l * 2 + gd) * 512 + gc], bx_c = p.in[13][(l * 2 + gd) * 512 + gc];
    float sp_c; { const float lam = p.in[14][(l * 2 + gd) * 512 + gc]; const float e = exp_fast(-lam); sp_c = e < 0.1f ? e * (1.0f - e * (0.5f - e * (0.33333334f - e * (0.25f - e * 0.2f)))) : 0.6931471805599453f * __builtin_amdgcn_logf(1.0f + e); }
    const int sd = tid >> 8, sc = (tid >> 6) & 3, scn = tid & 63;
    const u32x4 zero4 = (u32x4){0u, 0u, 0u, 0u};
    u32x4 xr[4];
#define LRU_LOADX(gt_) do { const int t0g_ = (gt_) * 64; int s0_, len_; seq_of(t0g_, s0_, len_); \
        _Pragma("unroll") for (int k = 0; k < 4; ++k) { const int gr_ = t0g_ + tok - 2 + k; xr[k] = (gr_ >= s0_ && gr_ < s0_ + len_) ? *(const u32x4*)(P + (size_t)gr_ * NP + P_LX + ch0) : zero4; } } while (0)
    if (tile_count > 0) LRU_LOADX(tile_first);
    for (int it = 0; it < tile_count; ++it) {
        int tl_ = tid_; asm volatile("" : "+v"(tl_));
        const int tid = tl_, lane = tid & 63, w = tid >> 6, r = lane & 15, q = lane >> 4, tok = tid >> 3, cg8 = tid & 7, ch0 = 64 * n + 8 * cg8;
        const int gd = w >> 2, ct = w & 3, chl = 16 * ct + r, sd = tid >> 8, sc = (tid >> 6) & 3, scn = tid & 63;
        const int gt = tile_first + it * tile_stride, t0g = gt * 64; int s0, len; seq_of(t0g, s0, len);
        const int ti = (t0g - s0) >> 6, N = len >> 6;
        u32x4 gv = zero4;
        if (mode) gv = *(const u32x4*)(P + (size_t)(t0g + tok) * NP + P_LG + ch0);
        __syncthreads();
        {   float acc[8];
            { const f32x4 c0_ = *(const LAS f32x4*)(cwl + 256 + 8 * cg8), c1_ = *(const LAS f32x4*)(cwl + 256 + 8 * cg8 + 4);
#pragma unroll
              for (int j = 0; j < 4; ++j) { acc[j] = c0_[j]; acc[4 + j] = c1_[j]; } }
#pragma unroll
            for (int k = 0; k < 4; ++k) { const f32x4 c0_ = *(const LAS f32x4*)(cwl + 64 * k + 8 * cg8), c1_ = *(const LAS f32x4*)(cwl + 64 * k + 8 * cg8 + 4);
#pragma unroll
                for (int j = 0; j < 4; ++j) { acc[j] += c0_[j] * bf_at(xr[k], j); acc[4 + j] += c1_[j] * bf_at(xr[k], 4 + j); } }
            *(LAS f32x4*)(xcf + tok * 64 + 8 * cg8) = (f32x4){acc[0], acc[1], acc[2], acc[3]};
            *(LAS f32x4*)(xcf + tok * 64 + 8 * cg8 + 4) = (f32x4){acc[4], acc[5], acc[6], acc[7]};
            u32x4 wv; wv.x = pk_bf16(acc[0], acc[1]); wv.y = pk_bf16(acc[2], acc[3]); wv.z = pk_bf16(acc[4], acc[5]); wv.w = pk_bf16(acc[6], acc[7]);
            *(LAS u32x4*)(Ab + tok * 72 + 8 * cg8) = wv; }
        if (it + 1 < tile_count) LRU_LOADX(gt + tile_stride);
        float pA = 1.f, pH = 0.f;
        if (mode) { const int cnt = sd == 0 ? ti : N - 1 - ti, lo = (cnt * sc) >> 2, hi = (cnt * (sc + 1)) >> 2;
            const f32x2* ab = AGG + ((size_t)(gt - ti) * 8 + n) * 128 + sd * 64 + scn;
            f32x2 e[32];
#pragma unroll
            for (int u = 0; u < 32; ++u) { const int j = lo + u, tj = sd == 0 ? j : N - 1 - j; e[u] = j < hi ? ab[(size_t)tj * 1024] : (f32x2){1.f, 0.f}; }
#pragma unroll
            for (int u = 0; u < 32; ++u) { pH = e[u][0] * pH + e[u][1]; pA *= e[u][0]; } }
        __syncthreads();
        {   f32x4 accr[4], acci[4];
#pragma unroll
            for (int mt = 0; mt < 4; ++mt) { accr[mt] = (f32x4){0.f, 0.f, 0.f, 0.f}; acci[mt] = (f32x4){0.f, 0.f, 0.f, 0.f};
#pragma unroll
                for (int ks = 0; ks < 2; ++ks) { const bf16x8 a = *(const LAS bf16x8*)(Ab + (16 * mt + r) * 72 + 32 * ks + 8 * q);
                    accr[mt] = mfma16(a, br[ks], accr[mt]); acci[mt] = mfma16(a, bi[ks], acci[mt]); } }
            const int t0 = t0g - s0;
#pragma unroll
            for (int mt = 0; mt < 4; ++mt)
#pragma unroll
                for (int i = 0; i < 4; ++i) { const int tk = 16 * mt + 4 * q + i, tt = t0 + tk;
                    const float rg_ = sigm(accr[mt][i] + ba_c), ig_ = sigm(acci[mt][i] + bx_c);
                    const float la = -8.0f * rg_ * sp_c, a = exp_fast(la), e2 = 2.0f * la;
                    const float om = e2 > -0.05f ? -e2 * (1.0f + e2 * (0.5f + e2 * (0.16666667f + e2 * 0.041666668f))) : 1.0f - exp_fast(e2);
                    float mult = sqrtf(om); if (gd == 0 ? tt == 0 : tt == len - 1) mult = 1.0f;
                    const float u = mult * ig_ * xcf[tk * 64 + chl];
                    aL[(gd * 64 + tk) * 64 + chl] = a; uL[(gd * 64 + tk) * 64 + chl] = u; }
        }
        if (mode) { agg[((sd * 64 + scn) * 4 + sc) * 2 + 0] = pA; agg[((sd * 64 + scn) * 4 + sc) * 2 + 1] = pH; }
        __syncthreads();
        {
            float hh = 0.f;
            if (mode) {
#pragma unroll
                for (int s2 = 0; s2 < 4; ++s2) hh = agg[((sd * 64 + scn) * 4 + s2) * 2 + 0] * hh + agg[((sd * 64 + scn) * 4 + s2) * 2 + 1]; }
            float A = 1.f, H = 0.f;
#pragma unroll
            for (int j = 0; j < 16; ++j) { const int tk = sd == 0 ? 16 * sc + j : 63 - 16 * sc - j; const float a_ = aL[(sd * 64 + tk) * 64 + scn], u_ = uL[(sd * 64 + tk) * 64 + scn]; H = a_ * H + u_; A *= a_; }
            __syncthreads();
            agg[((sd * 64 + scn) * 4 + sc) * 2 + 0] = A; agg[((sd * 64 + scn) * 4 + sc) * 2 + 1] = H;
            __syncthreads();
            if (mode == 0) { if (sc == 0) { float tA = 1.f, tH = 0.f;
#pragma unroll
                    for (int s2 = 0; s2 < 4; ++s2) { const float a_ = agg[((sd * 64 + scn) * 4 + s2) * 2 + 0], h_ = agg[((sd * 64 + scn) * 4 + s2) * 2 + 1]; tH = a_ * tH + h_; tA *= a_; }
                    AGG[((size_t)gt * 8 + n) * 128 + sd * 64 + scn] = (f32x2){tA, tH}; } }
            else {
                for (int s2 = 0; s2 < sc; ++s2) hh = agg[((sd * 64 + scn) * 4 + s2) * 2 + 0] * hh + agg[((sd * 64 + scn) * 4 + s2) * 2 + 1];
#pragma unroll
                for (int j = 0; j < 16; ++j) { const int tk = sd == 0 ? 16 * sc + j : 63 - 16 * sc - j; hh = aL[(sd * 64 + tk) * 64 + scn] * hh + uL[(sd * 64 + tk) * 64 + scn]; uL[(sd * 64 + tk) * 64 + scn] = hh; }
            }
        }
        if (mode) {
            __syncthreads();
            const f32x4 f0 = *(const LAS f32x4*)(uL + tok * 64 + 8 * cg8), f1 = *(const LAS f32x4*)(uL + tok * 64 + 8 * cg8 + 4);
            const f32x4 b0 = *(const LAS f32x4*)(uL + (64 + tok) * 64 + 8 * cg8), b1 = *(const LAS f32x4*)(uL + (64 + tok) * 64 + 8 * cg8 + 4);
            float hv[8] = {f0[0] + b0[0], f0[1] + b0[1], f0[2] + b0[2], f0[3] + b0[3], f1[0] + b1[0], f1[1] + b1[1], f1[2] + b1[2], f1[3] + b1[3]};
#pragma unroll
            for (int j = 0; j < 8; ++j) hv[j] *= gelu_tanh(bf_at(gv, j));
            u32x4 wv; wv.x = pk_bf16(hv[0], hv[1]); wv.y = pk_bf16(hv[2], hv[3]); wv.z = pk_bf16(hv[4], hv[5]); wv.w = pk_bf16(hv[6], hv[7]);
            *(u32x4*)(MB + (size_t)(t0g + tok) * D + ch0) = wv;
        }
    }
#undef LRU_LOADX
}

#ifndef NCH
#define NCH 2
#endif
constexpr int FCH = NCH, FROWS = T / FCH, PER = 7 + 2 * FCH, N_PHASES = 1 + 2 * PER, ATTN_IN_SCAN = 768;
__device__ void run_phase(const Params& p, int ph, LAS unsigned char* lds, const int tid_) {
    bf16_t* XB = (bf16_t*)(p.ws + WS_XB); float* RS1 = (float*)(p.ws + WS_RS1); float* RS2 = (float*)(p.ws + WS_RS2);
    if (ph == 0) { wprep_phase(p, 0, lds, tid_); rowpass0(p, tid_); return; }
    const int l = (ph - 1) / PER, k = (ph - 1) % PER;
    if (k == 0) {
        pg8::Gemm g{XB, (const bf16_t*)(p.ws + WS_WIN), T, NP, D}; pg8::StaticOrder S; S.init(T, NP, (int)gridDim.x, (int)blockIdx.x);
        EpiBf16S E{(bf16_t*)(p.ws + WS_P), NP, nullptr, 0};
        pg8::gemm_phase<EpiBf16S, pg8::StaticOrder>(lds, g, S, E, nullptr, tid_);
    } else if (k == 1) {
        for (int u = ATTN_IN_SCAN + blockIdx.x; u < 3072; u += gridDim.x) { int t2 = tid_; asm volatile("" : "+v"(t2)); attn_unit(p, l, u, lds, t2); }
        for (int t = blockIdx.x; t < 768; t += gridDim.x) { int t2 = tid_; asm volatile("" : "+v"(t2)); rwkv_prep_tile(p, l, t, lds, t2); }
        { const int per = (int)gridDim.x >> 3; if ((int)blockIdx.x < per * 8) { const int first = (int)blockIdx.x >> 3; lru_run(p, l, (int)blockIdx.x & 7, first, per, (768 - first + per - 1) / per, 0, lds, tid_); } }
    } else if (k == 2) {
        for (int vb = blockIdx.x; vb < 256; vb += gridDim.x) {
#ifndef PROBE2
#define PROBE2 0
#endif
            if (vb < 192) { const int n = vb < 128 ? 1 : 4, b0 = vb < 128 ? vb : 128 + 4 * (vb - 128); for (int i = 0; i < n * (PROBE2 == 1 ? 2 : 1); ++i) rwkv_scan_task(p, l, b0 + (i % n), lds, tid_); }
            else { const int j = vb - 192; for (int rep = 0; rep < (PROBE2 == 2 ? 2 : 1); ++rep) lru_run(p, l, j & 7, j >> 3, 8, 96, 1, lds, tid_);
                for (int u = j; u < ATTN_IN_SCAN; u += 64) { int t2 = tid_; asm volatile("" : "+v"(t2)); attn_unit(p, l, u, lds, t2); } }
        }
    } else if (k == 3) { rwkv_final(p, l, tid_);
    } else if (k == 4) {
        pg8::Gemm g{mixbuf_of(p), (const bf16_t*)(p.ws + WS_WOUT), T, D, D}; pg8::StaticOrder S; S.init(T, D, (int)gridDim.x, (int)blockIdx.x);
        EpiBf16S E{(bf16_t*)(p.ws + WS_F), D, nullptr, 0};
        pg8::gemm_phase<EpiBf16S, pg8::StaticOrder>(lds, g, S, E, nullptr, tid_);
    } else if (k == 5) { rowpass_post(p, (const bf16_t*)(p.ws + WS_F), p.in[3] + l * D, 2, RS1, RS2, 0, tid_);
    } else if (k < 6 + 2 * FCH) {
        const int th = (k - 6) >> 1; const size_t rb = (size_t)th * FROWS;
        if (((k - 6) & 1) == 0) {
            pg8::Gemm g{XB + rb * D, (const bf16_t*)(p.ws + WS_WUP), FROWS, DFF, D}; pg8::StaticOrder S; S.init(FROWS, DFF, (int)gridDim.x, (int)blockIdx.x);
            EpiBf16S E{(bf16_t*)(p.ws + WS_U), DFF, nullptr, 1};
            pg8::gemm_phase<EpiBf16S, pg8::StaticOrder>(lds, g, S, E, nullptr, tid_);
        } else {
            pg8::Gemm g{(const bf16_t*)(p.ws + WS_U), (const bf16_t*)(p.ws + WS_WDN), FROWS, D, DFF}; pg8::StaticOrder S; S.init(FROWS, D, (int)gridDim.x, (int)blockIdx.x);
            EpiBf16S E{(bf16_t*)(p.ws + WS_F) + rb * D, D, nullptr, 0};
            pg8::gemm_phase<EpiBf16S, pg8::StaticOrder>(lds, g, S, E, nullptr, tid_);
        }
    } else {
        rowpass_post(p, (const bf16_t*)(p.ws + WS_F), p.in[5] + l * D, 2, RS2, RS1, l == 0 ? 0 : 2, tid_);
        if (l == 0) wprep_phase(p, 1, lds, tid_);
    }
}

__global__ void __launch_bounds__(512, 2) hymba_mega(Params p) {
    extern __shared__ __attribute__((aligned(16))) unsigned char smem[];
    LAS unsigned char* lds = (LAS unsigned char*)smem;
    volatile LAS unsigned* bst = (volatile LAS unsigned*)(lds + 131072);
    unsigned* bar = (unsigned*)(p.ws + WS_BAR);
    const bool coop = p.ph_hi - p.ph_lo > 1;
    if (coop) {
        if (threadIdx.x < 2) bst[threadIdx.x] = 0u;
        if (blockIdx.x == 0) for (int i = threadIdx.x; i < XCD_BAR_WORDS; i += 512) bar[i] = 0u;
        __syncthreads();
    }
    XcdBarrier xb; xb.bar = bar; xb.x = 0; xb.st = bst;
    bool posted = false;
    for (int ph = p.ph_lo; ph < p.ph_hi; ++ph) {
        int nrep = 1;
#if PROBE_MASK
        if ((ph > 0 && ((PROBE_MASK >> ((ph - 1) % PER)) & 1)) || (ph == 0 && ((PROBE_MASK >> 30) & 1))) nrep = 2;
#endif
        for (int rep = 0; rep < nrep; ++rep) {
            int tid_ = (int)__builtin_amdgcn_workitem_id_x(); asm volatile("" : "+v"(tid_));
            run_phase(p, ph, lds, tid_);
            if (ph + 1 < p.ph_hi || rep + 1 < nrep) {
                if (!posted) { cg::this_grid().sync(); xb = xcd_barrier_post(bar, bst, tid_ == 0); posted = true; }
                else xcd_barrier(xb, tid_ == 0);
            }
        }
    }
}

#ifndef PROBE_MASK
#define PROBE_MASK 0
#endif
#ifndef N_LAUNCH_PER_PHASE
#define N_LAUNCH_PER_PHASE 1
#endif
extern "C" void kernel_launch(void* const* d_in, const int* in_sizes, int n_in, void* d_out, int out_size, void* d_ws, size_t ws_size, hipStream_t stream) {
    static int grid = 0;
    if (grid == 0) {
        if (n_in != 30 || ws_size < WS_END) { fprintf(stderr, "kernel_launch: unexpected n_in %d / ws_size %zu\n", n_in, ws_size); grid = -1; return; }
        int dev = 0, cus = 0, per_cu = 0;
        hipGetDevice(&dev); hipDeviceGetAttribute(&cus, hipDeviceAttributeMultiprocessorCount, dev);
        if (hipFuncSetAttribute((const void*)hymba_mega, hipFuncAttributeMaxDynamicSharedMemorySize, LDS_BYTES) != hipSuccess) { fprintf(stderr, "kernel_launch: hipFuncSetAttribute failed\n"); grid = -1; return; }
        if (hipOccupancyMaxActiveBlocksPerMultiprocessor(&per_cu, (const void*)hymba_mega, 512, LDS_BYTES) != hipSuccess || per_cu < 1) { fprintf(stderr, "kernel_launch: occupancy query says %d\n", per_cu); per_cu = 1; }
        (void)hipGetLastError();
        grid = cus * (per_cu > 1 ? 1 : per_cu);
    }
    if (grid < 0) return;
    Params p{};
    for (int i = 0; i < 30; ++i) p.in[i] = (const float*)d_in[i];
    p.out = (float*)d_out; p.ws = (unsigned char*)d_ws;
#if N_LAUNCH_PER_PHASE
    for (int ph = 0; ph < N_PHASES; ++ph) { p.ph_lo = ph; p.ph_hi = ph + 1; hipLaunchKernelGGL(hymba_mega, dim3(grid), dim3(512), LDS_BYTES, stream, p); }
#else
    p.ph_lo = 0; p.ph_hi = N_PHASES;
    void* args[] = {&p};
    hipError_t e = hipLaunchCooperativeKernel((const void*)hymba_mega, dim3(grid), dim3(512), args, LDS_BYTES, stream);
    if (e != hipSuccess) fprintf(stderr, "kernel_launch: cooperative launch failed: %s (grid %d)\n", hipGetErrorString(e), grid);
#endif
}
```

```cpp
#include <hip/hip_runtime.h>
#include <hip/hip_cooperative_groups.h>
#include <cstdio>
namespace cg = cooperative_groups;

#define LAS __attribute__((address_space(3)))
typedef float f32x2 __attribute__((ext_vector_type(2)));
typedef unsigned u32x2 __attribute__((ext_vector_type(2)));
typedef _Float16 f16x4 __attribute__((ext_vector_type(4)));
typedef _Float16 f16x8 __attribute__((ext_vector_type(8)));
#define N_LAUNCH_PER_PHASE 0
#define PROBE_MASK 0
#define PROBE2 0
#define NCH 6
namespace pg8 {
#define PG8_LAS __attribute__((address_space(3)))
typedef unsigned short bf16_t;
typedef short bf16x8 __attribute__((ext_vector_type(8)));
typedef float f32x4 __attribute__((ext_vector_type(4)));
typedef unsigned u32x4 __attribute__((ext_vector_type(4)));
constexpr int BM = 256, BK = 64, HALF = 128, HTB = HALF * BK * 2  , STAGE_BYTES = 8 * HTB, NXCD = 8, WGM = 8;

__host__ __device__ __forceinline__ int lds_byte(int r, int c) { const int st = (r >> 4) * 2 + (c >> 5), rr = r & 15, cc = c & 31, ob = rr * 64 + cc * 2; return st * 1024 + (ob ^ (((ob >> 9) & 1) << 5)); }
__host__ __device__ __forceinline__ void stage_rc(int b, int& R, int& C) { const int st = b / 1024, sb = b % 1024, swz = sb ^ (((sb >> 9) & 1) << 5); R = (st >> 1) * 16 + swz / 64; C = (st & 1) * 32 + (swz % 64) / 2; }
__host__ __device__ __forceinline__ int perm32(int rho) { const int n = rho >> 4, i = rho & 15; return 8 * (i >> 2) + 4 * n + (i & 3); }

struct Unit { int pm, pn; };
struct Gemm { const bf16_t* A; const bf16_t* Bt; int M, N, K; };

struct StaticOrder {
    int nM, nN, nwg, G, c;
    __host__ __device__ void init(int M, int N, int G_, int c_) { nM = M / BM; nN = N / BM; nwg = nM * nN; G = G_; c = c_; }
    __host__ __device__ bool next(int i, Unit& u) const {
        const long L = (long)i * G + c; if (L >= nwg) return false;
        int wgid = (int)L; { const int q = nwg / NXCD, r = nwg % NXCD, xcd = wgid % NXCD, off = wgid / NXCD; wgid = (xcd < r ? xcd * (q + 1) : r * (q + 1) + (xcd - r) * q) + off; }
        const int nig = WGM * nN, gid = wgid / nig, fm = gid * WGM, gsz = (nM - fm) < WGM ? (nM - fm) : WGM;
        u.pm = fm + ((wgid % nig) % gsz); u.pn = (wgid % nig) / gsz; return true;
    }
    __device__ __forceinline__ void a_ready(const Unit&) const {}
    __device__ __forceinline__ void done(const Unit&) const {}
};
__device__ __forceinline__ unsigned cvt_pk_bf16(float lo, float hi) { unsigned r; asm volatile("v_cvt_pk_bf16_f32 %0, %1, %2" : "=v"(r) : "v"(lo), "v"(hi)); return r; }
template <class Epi, class Sched, bool STAMP = false>
__device__ __forceinline__ void gemm_phase(PG8_LAS unsigned char* lds, const Gemm g, const Sched& S, const Epi& E, unsigned long long* stamps, const int tid_) {
    const int tid = tid_, wid = __builtin_amdgcn_readfirstlane(tid >> 6), lane = tid & 63, wr = wid >> 2, wc = wid & 3, fr = lane & 15, fq = lane >> 4;
    const int K = g.K, nt = K / BK;
    int ts_lo = 0, ts_hi = 0, nts = 0; const unsigned long long rt_entry = STAMP ? (unsigned long long)wall_clock64() : 0ull;
#define PG8_STAMP() do { if (STAMP && wid == 0 && nts < 64) { const unsigned long long _c = (unsigned long long)clock64(); \
        ts_lo = (lane == nts) ? (int)(unsigned)_c : ts_lo; ts_hi = (lane == nts) ? (int)(unsigned)(_c >> 32) : ts_hi; ++nts; } } while (0)
    PG8_STAMP();
    unsigned voffA[2], voffB[2];
#pragma unroll
    for (int i = 0; i < 2; ++i) { int R, C; stage_rc(tid * 16 + i * 8192, R, C); const int Rb = Epi::PERM ? ((R & ~31) + perm32(R & 31)) : R;
        voffA[i] = (unsigned)(R * K + C) * 2u; voffB[i] = (unsigned)(Rb * K + C) * 2u; }
    const size_t kstep = (size_t)(BK * 2);
    const size_t hstep = (size_t)HALF * K * 2;
    const size_t tstep = 2 * hstep;
    const unsigned ldsw = (unsigned)wid * 1024u;
    const int aoff = lds_byte(wr * 64 + fr, fq * 8), boff = lds_byte(wc * 32 + fr, fq * 8);
#define PG8_SA(b, h) (((b) * 2 + (h)) * HTB)
#define PG8_SB(b, h) ((4 + (b) * 2 + (h)) * HTB)
#define PG8_STAGE(bufoff, gbase, voff) do { _Pragma("unroll") for (int _i = 0; _i < 2; ++_i) \
        __builtin_amdgcn_global_load_lds((const unsigned*)((const char*)(gbase) + (voff)[_i]), (PG8_LAS unsigned*)(lds + (bufoff) + ldsw + _i * 8192), 16, 0, 0); } while (0)
#define PG8_LDA(dst, b, h) do { _Pragma("unroll") for (int m = 0; m < 4; ++m) _Pragma("unroll") for (int k = 0; k < 2; ++k) dst[m][k] = *(const PG8_LAS bf16x8*)(lds + PG8_SA(b, h) + aoff + m * 2048 + k * 1024); } while (0)
#define PG8_LDB(dst, b, h) do { _Pragma("unroll") for (int n = 0; n < 2; ++n) _Pragma("unroll") for (int k = 0; k < 2; ++k) dst[n][k] = *(const PG8_LAS bf16x8*)(lds + PG8_SB(b, h) + boff + n * 2048 + k * 1024); } while (0)
#define PG8_MMA(ai, bj, At, Bt) do { __builtin_amdgcn_s_setprio(1); _Pragma("unroll") for (int m = 0; m < 4; ++m) _Pragma("unroll") for (int n = 0; n < 2; ++n) _Pragma("unroll") for (int k = 0; k < 2; ++k) \
        acc[ai][bj][m][n] = __builtin_amdgcn_mfma_f32_16x16x32_bf16(Bt[n][k], At[m][k], acc[ai][bj][m][n], 0, 0, 0); __builtin_amdgcn_s_setprio(0); } while (0)
#define PG8_WAIT_V(n) asm volatile("s_waitcnt vmcnt(" #n ")" ::: "memory")
#define PG8_WAIT_L(n) asm volatile("s_waitcnt lgkmcnt(" #n ")" ::: "memory")
#define PG8_BAR __builtin_amdgcn_s_barrier()
#define PG8_SCHED __builtin_amdgcn_sched_barrier(0)
    Unit cur, nxt; int ui = 0;
    if (!S.next(0, cur)) return;
    f32x4 acc[2][2][4][2];
#pragma unroll
    for (int a = 0; a < 2; ++a)
#pragma unroll
        for (int b = 0; b < 2; ++b)
#pragma unroll
            for (int m = 0; m < 4; ++m)
#pragma unroll
                for (int n = 0; n < 2; ++n) acc[a][b][m][n] = (f32x4){0.f, 0.f, 0.f, 0.f};
    bf16x8 At[4][2], B0[2][2], B1[2][2];
    const char* cA = (const char*)g.A + (size_t)cur.pm * tstep; const char* cB = (const char*)g.Bt + (size_t)cur.pn * tstep;
    S.a_ready(cur);
    PG8_STAGE(PG8_SB(0, 0), cB, voffB); PG8_STAGE(PG8_SA(0, 0), cA, voffA); PG8_STAGE(PG8_SB(0, 1), cB + hstep, voffB); PG8_STAGE(PG8_SA(0, 1), cA + hstep, voffA);
    if (wr == 1) PG8_BAR;
    PG8_WAIT_V(4); PG8_BAR;
    PG8_STAGE(PG8_SB(1, 0), cB + kstep, voffB); PG8_STAGE(PG8_SA(1, 0), cA + kstep, voffA); PG8_STAGE(PG8_SB(1, 1), cB + hstep + kstep, voffB);
    PG8_WAIT_V(6); PG8_BAR;
    PG8_STAMP();
    for (;;) {
        const bool has_next = S.next(ui + 1, nxt);
        const char* nA = has_next ? (const char*)g.A + (size_t)nxt.pm * tstep : cA; const char* nB = has_next ? (const char*)g.Bt + (size_t)nxt.pn * tstep : cB;
        for (int t = 0; t < nt; t += 2) {
            const bool last = (t == nt - 2);
            const char* a1 = cA + (size_t)(t + 1) * kstep;
            const char* a2 = last ? nA : cA + (size_t)(t + 2) * kstep; const char* b2 = last ? nB : cB + (size_t)(t + 2) * kstep;
            const char* a3 = a2 + kstep; const char* b3 = b2 + kstep;
            if (last && has_next) S.a_ready(nxt);
            PG8_LDB(B0, 0, 0); PG8_SCHED; PG8_LDA(At, 0, 0); PG8_STAGE(PG8_SA(1, 1), a1 + hstep, voffA);
            PG8_WAIT_L(8); PG8_BAR; PG8_WAIT_L(0); PG8_MMA(0, 0, At, B0); PG8_BAR; PG8_SCHED;
            PG8_LDB(B1, 0, 1); PG8_STAGE(PG8_SB(0, 0), b2, voffB);
            PG8_BAR; PG8_WAIT_L(0); PG8_MMA(0, 1, At, B1); PG8_BAR;
            PG8_LDA(At, 0, 1); PG8_STAGE(PG8_SA(0, 0), a2, voffA);
            PG8_BAR; PG8_WAIT_L(0); PG8_MMA(1, 0, At, B0); PG8_BAR; PG8_SCHED;
            PG8_STAGE(PG8_SB(0, 1), b2 + hstep, voffB);
            PG8_WAIT_V(6); PG8_BAR; PG8_MMA(1, 1, At, B1); PG8_BAR;
            PG8_LDB(B0, 1, 0); PG8_SCHED; PG8_LDA(At, 1, 0); PG8_STAGE(PG8_SA(0, 1), a2 + hstep, voffA);
            PG8_WAIT_L(8); PG8_BAR; PG8_WAIT_L(0); PG8_MMA(0, 0, At, B0); PG8_BAR; PG8_SCHED;
            PG8_LDB(B1, 1, 1); PG8_STAGE(PG8_SB(1, 0), b3, voffB);
            PG8_BAR; PG8_WAIT_L(0); PG8_MMA(0, 1, At, B1); PG8_BAR;
            PG8_LDA(At, 1, 1); PG8_STAGE(PG8_SA(1, 0), a3, voffA);
            PG8_BAR; PG8_WAIT_L(0); PG8_MMA(1, 0, At, B0); PG8_BAR; PG8_SCHED;
            PG8_STAGE(PG8_SB(1, 1), b3 + hstep, voffB);
            PG8_WAIT_V(6); PG8_BAR; PG8_MMA(1, 1, At, B1); PG8_BAR;
        }
        PG8_STAMP();
        if constexpr (!Epi::AFTER_DRAIN) { E(acc, cur, wr, wc, fr, fq); S.done(cur); }
        PG8_STAMP();
        if (!has_next) break;
#pragma unroll
        for (int a = 0; a < 2; ++a)
#pragma unroll
            for (int b = 0; b < 2; ++b)
#pragma unroll
                for (int m = 0; m < 4; ++m)
#pragma unroll
                    for (int n = 0; n < 2; ++n) acc[a][b][m][n] = (f32x4){0.f, 0.f, 0.f, 0.f};
        cur = nxt; cA = nA; cB = nB; ++ui;
    }
    PG8_WAIT_V(0);
    if (wr == 0) PG8_BAR;
    PG8_BAR;
    if constexpr (Epi::AFTER_DRAIN) { E.fused(acc, cur, wr, wc, fr, fq, lds, wid, lane); S.done(cur); }
    PG8_STAMP();
    if (STAMP && wid == 0) { stamps[lane] = lane < nts ? (((unsigned long long)(unsigned)ts_hi << 32) | (unsigned)ts_lo) : 0ull;
        if (lane == 62) stamps[62] = rt_entry; if (lane == 63) stamps[63] = (unsigned long long)wall_clock64(); }
#undef PG8_STAMP
#undef PG8_SA
#undef PG8_SB
#undef PG8_STAGE
#undef PG8_LDA
#undef PG8_LDB
#undef PG8_MMA
#undef PG8_WAIT_V
#undef PG8_WAIT_L
#undef PG8_BAR
#undef PG8_SCHED
}
}
#define XB_TMO      128
#define XB_XCNT(j)  (256  + 64 * (j))
#define XB_XSUB(j)  (1280 + 64 * (j))
#define XB_XGEN(j)  (2304 + 64 * (j))
#define XB_TOP      3328
#define XB_TOPGEN   3392
#define XCD_BAR_WORDS 3456
#define XB_SPIN_CAP (1u << 18)

__device__ __forceinline__ unsigned xb_ld(unsigned* p)              { return __hip_atomic_load(p, __ATOMIC_RELAXED, __HIP_MEMORY_SCOPE_AGENT); }
__device__ __forceinline__ unsigned xb_add(unsigned* p, unsigned v) { return __hip_atomic_fetch_add(p, v, __ATOMIC_RELAXED, __HIP_MEMORY_SCOPE_AGENT); }
__device__ __forceinline__ unsigned xb_xcc_id() { return (unsigned)__builtin_amdgcn_s_getreg((3 << 11) | 20) & 0xFu; }
#define XB_SPIN(cond, bar) do { unsigned _sp = 0; while (cond) { __builtin_amdgcn_s_sleep(1); \
    if ((++_sp & 255u) == 0u) { if (xb_ld(&(bar)[XB_TMO])) break; if (_sp > XB_SPIN_CAP) { atomicAdd(&(bar)[XB_TMO], 1u); break; } } } } while (0)

struct XcdBarrier {
    unsigned* bar; unsigned x;
    volatile LAS unsigned* st;
};

__device__ __forceinline__ XcdBarrier xcd_barrier_post(unsigned* bar, volatile LAS unsigned* st, const bool tid0_) {
    XcdBarrier b; b.bar = bar; b.x = xb_xcc_id(); b.st = st;
    if (tid0_) (void)xb_add(&bar[XB_XCNT(b.x)], 1u);
    return b;
}
__device__ __forceinline__ void xcd_barrier_complete(unsigned* bar, unsigned x, unsigned& nloc, unsigned& nx) {
    const unsigned G = gridDim.x * gridDim.y * gridDim.z;
    unsigned sum, cnt, mine, sp = 0u;
    for (;;) {
        sum = 0u; cnt = 0u; mine = 0u;
#pragma unroll
        for (unsigned j = 0; j < 16; ++j) { const unsigned c = xb_ld(&bar[XB_XCNT(j)]); sum += c; cnt += (c > 0u) ? 1u : 0u; mine = (j == x) ? c : mine; }
        if (sum == G) break;
        __builtin_amdgcn_s_sleep(1);
        if ((++sp & 255u) == 0u) { if (xb_ld(&bar[XB_TMO])) break; if (sp > XB_SPIN_CAP) { atomicAdd(&bar[XB_TMO], 1u); break; } }
    }
    nloc = mine > 0u ? mine : 1u; nx = cnt > 0u ? cnt : 1u;
}

__device__ __forceinline__ void xcd_barrier(const XcdBarrier& b, const bool tid0_) {
    asm volatile("s_waitcnt vmcnt(0)" ::: "memory");
    __syncthreads();
    if (tid0_) {
        unsigned* bar = b.bar;
        __builtin_amdgcn_s_waitcnt(0);
        unsigned nloc = b.st[0], nx = b.st[1];
        if (nloc == 0u) { xcd_barrier_complete(bar, b.x, nloc, nx); b.st[0] = nloc; b.st[1] = nx; }
        const unsigned old = xb_add(&bar[XB_XSUB(b.x)], 1u);
        const unsigned gen = old / nloc;
        if (old + 1u == (gen + 1u) * nloc) {
            __builtin_amdgcn_fence(__ATOMIC_RELEASE, "agent");
            asm volatile("s_waitcnt vmcnt(0)" ::: "memory");
            const unsigned og = xb_add(&bar[XB_TOP], 1u);
            const unsigned tg = og / nx;
            if (og + 1u == (tg + 1u) * nx) xb_add(&bar[XB_TOPGEN], 1u);
            else XB_SPIN(xb_ld(&bar[XB_TOPGEN]) == tg, bar);
            __builtin_amdgcn_fence(__ATOMIC_ACQUIRE, "agent");
            xb_add(&bar[XB_XGEN(b.x)], 1u);
            asm volatile("s_waitcnt vmcnt(0)" ::: "memory");
        } else {
            XB_SPIN(xb_ld(&bar[XB_XGEN(b.x)]) == gen, bar);
            __builtin_amdgcn_fence(__ATOMIC_ACQUIRE, "agent");
            asm volatile("s_waitcnt vmcnt(0)" ::: "memory");
        }
    }
    __syncthreads();
}

using pg8::bf16_t; using pg8::bf16x8; using pg8::f32x4; using pg8::u32x4;

constexpr int T = 49152, D = 2048, NP = 4608, DFF = 8192;
constexpr int P_K = 1024, P_V = 1280, P_LX = 1536, P_LG = 2048, P_RW = 2560;
constexpr size_t MiB = (size_t)1 << 20;
constexpr size_t WS_WIN = 0, WS_WOUT = WS_WIN + (size_t)NP * D * 2, WS_WUP = WS_WOUT + (size_t)D * D * 2, WS_WDN = WS_WUP + (size_t)DFF * D * 2;
constexpr size_t WS_SMALL = 90 * MiB, WS_LB = WS_SMALL, WS_W2T = WS_SMALL + 262144, WS_A2T = WS_SMALL + 393216, WS_G2T = WS_SMALL + 524288,
                 WS_RS1 = WS_SMALL + 1048576, WS_RS2 = WS_SMALL + 1310720, WS_BAR = WS_SMALL + 1572864;
constexpr size_t WS_XB = 92 * MiB, WS_P = 284 * MiB, WS_PREP = 716 * MiB, WS_YFB = 908 * MiB, WS_AGG = 1004 * MiB, WS_END = 1012 * MiB;
constexpr size_t WS_F = WS_P, WS_U = 476 * MiB;
constexpr int LDS_BYTES = 131072 + 16;

struct Params { const float* in[30]; float* out; unsigned char* ws; int ph_lo, ph_hi; };

#define DI __device__ __forceinline__
DI pg8::bf16_t* mixbuf_of(const Params& p) { return (pg8::bf16_t*)p.out + (size_t)T * D; }
DI unsigned pk_bf16(float lo, float hi) { unsigned r; asm("v_cvt_pk_bf16_f32 %0, %1, %2" : "=v"(r) : "v"(lo), "v"(hi)); return r; }
DI float bf_lo(unsigned w) { return __uint_as_float(w << 16); }
DI float bf_hi(unsigned w) { return __uint_as_float(w & 0xffff0000u); }
DI float bf_at(const u32x4& v, int j) { const unsigned w = v[j >> 1]; return (j & 1) ? bf_hi(w) : bf_lo(w); }
DI float sigm(float x) { return __builtin_amdgcn_rcpf(1.0f + __builtin_amdgcn_exp2f(-1.4426950408889634f * x)); }
DI float tanh_fast(float x) { return 1.0f - 2.0f * __builtin_amdgcn_rcpf(1.0f + __builtin_amdgcn_exp2f(2.8853900817779268f * x)); }
DI float exp_fast(float x) { return __builtin_amdgcn_exp2f(1.4426950408889634f * x); }
DI void seq_of(int row, int& s0, int& len) { if (row < 16384) { s0 = row & ~2047; len = 2048; } else { s0 = 16384 + ((row - 16384) & ~8191); len = 8192; } }
DI f32x4 mfma16(bf16x8 a, bf16x8 b, f32x4 c) { return __builtin_amdgcn_mfma_f32_16x16x32_bf16(a, b, c, 0, 0, 0); }

struct EpiBf16S {
    static constexpr bool PERM = true, AFTER_DRAIN = false;
    bf16_t* O; int ldc; const float* rs; int act;
    __device__ __forceinline__ void operator()(const f32x4 (&acc)[2][2][4][2], const pg8::Unit& u, int wr, int wc, int fr, int fq) const {
        const int row0 = u.pm * 256 + wr * 64 + fr, col0 = u.pn * 256 + wc * 32 + 8 * fq;
#pragma unroll
        for (int ai = 0; ai < 2; ++ai)
#pragma unroll
            for (int m = 0; m < 4; ++m) { const int row = row0 + ai * 128 + m * 16; const float s = rs ? rs[row] : 1.0f; bf16_t* rowp = O + (size_t)row * ldc + col0;
#pragma unroll
                for (int bj = 0; bj < 2; ++bj) { f32x4 v0 = acc[ai][bj][m][0] * s, v1 = acc[ai][bj][m][1] * s;
                    if (act) {
#pragma unroll
                        for (int j = 0; j < 4; ++j) { const float a = fmaxf(v0[j], 0.f), b = fmaxf(v1[j], 0.f); v0[j] = a * a; v1[j] = b * b; } }
                    u32x4 w; w.x = pk_bf16(v0[0], v0[1]); w.y = pk_bf16(v0[2], v0[3]); w.z = pk_bf16(v1[0], v1[1]); w.w = pk_bf16(v1[2], v1[3]);
                    *(u32x4*)(rowp + bj * 128) = w; } }
    }
};
struct EpiF32S {
    static constexpr bool PERM = false, AFTER_DRAIN = false;
    float* C; int ldc;
    __device__ __forceinline__ void operator()(const f32x4 (&acc)[2][2][4][2], const pg8::Unit& u, int wr, int wc, int fr, int fq) const {
        const int row0 = u.pm * 256 + wr * 64 + fr, col0 = u.pn * 256 + wc * 32 + 4 * fq;
#pragma unroll
        for (int ai = 0; ai < 2; ++ai)
#pragma unroll
            for (int m = 0; m < 4; ++m) { float* rowp = C + (size_t)(row0 + ai * 128 + m * 16) * ldc + col0;
#pragma unroll
                for (int bj = 0; bj < 2; ++bj)
#pragma unroll
                    for (int n = 0; n < 2; ++n) *(f32x4*)(rowp + bj * 128 + n * 16) = acc[ai][bj][m][n]; }
    }
};

struct WTile { const float* W; bf16_t* Wt; const float* gain; int ldw, k0, srcn0, ldt, dstn0; };
DI WTile wtile_of(int id, const float* w_in, const float* w_out, const float* w_up, const float* w_dn, const float* g_mix, const float* g_ffn, unsigned char* ws) {
    WTile t;
    if (id < 2304) { const int kt = id & 31, nt = id >> 5, dn = nt * 64; t = WTile{w_in, (bf16_t*)(ws + WS_WIN), g_mix, 4480, kt * 64, dn < 1536 ? dn + 2944 : (dn < 4480 ? dn - 1536 : -1), D, dn}; }
    else if (id < 3328) { const int j = id - 2304, kt = j & 31, nt = j >> 5; t = WTile{w_out, (bf16_t*)(ws + WS_WOUT), nullptr, D, kt * 64, nt * 64, D, nt * 64}; }
    else if (id < 7424) { const int j = id - 3328, kt = j & 31, nt = j >> 5; t = WTile{w_up, (bf16_t*)(ws + WS_WUP), g_ffn, DFF, kt * 64, nt * 64, D, nt * 64}; }
    else { const int j = id - 7424, kt = j & 127, nt = j >> 7; t = WTile{w_dn, (bf16_t*)(ws + WS_WDN), nullptr, D, kt * 64, nt * 64, DFF, nt * 64}; }
    return t; }
DI void wtile_load(const WTile& t, int tid, float4 (&v)[2]) {
#pragma unroll
    for (int it = 0; it < 2; ++it) { const int kk = (tid >> 4) + 32 * it, n4 = (tid & 15) * 4; v[it] = make_float4(0.f, 0.f, 0.f, 0.f);
        if (t.srcn0 >= 0) { v[it] = *(const float4*)(t.W + (size_t)(t.k0 + kk) * t.ldw + t.srcn0 + n4); if (t.gain) { const float g = t.gain[t.k0 + kk]; v[it].x *= g; v[it].y *= g; v[it].z *= g; v[it].w *= g; } } } }
__device__ void wprep_phase(const Params& p, int l, LAS unsigned char* lds, const int tid_) {
    LAS float* tile = (LAS float*)lds; const int tid = tid_;
    const float* w_in = p.in[6] + (size_t)l * D * 4480; const float* w_out = p.in[7] + (size_t)l * D * D;
    const float* w_up = p.in[28] + (size_t)l * D * DFF; const float* w_dn = p.in[29] + (size_t)l * DFF * D;
    const float* g_mix = p.in[2] + l * D; const float* g_ffn = p.in[4] + l * D;
    float4 v[2], vn[2];
    int id = blockIdx.x;
    WTile t = wtile_of(id < 11520 ? id : 0, w_in, w_out, w_up, w_dn, g_mix, g_ffn, p.ws);
    if (id < 11520) wtile_load(t, tid, v);
    for (; id < 11520; id += gridDim.x) {
        const int idn = id + gridDim.x;
        const WTile tn = wtile_of(idn < 11520 ? idn : 0, w_in, w_out, w_up, w_dn, g_mix, g_ffn, p.ws);
        if (idn < 11520) wtile_load(tn, tid, vn);
#pragma unroll
        for (int it = 0; it < 2; ++it) { const int kk = (tid >> 4) + 32 * it, n4 = (tid & 15) * 4;
            tile[kk * 65 + n4 + 0] = v[it].x; tile[kk * 65 + n4 + 1] = v[it].y; tile[kk * 65 + n4 + 2] = v[it].z; tile[kk * 65 + n4 + 3] = v[it].w; }
        __syncthreads();
        { const int nn = tid >> 3, kc = tid & 7; float e[8];
#pragma unroll
          for (int j = 0; j < 8; ++j) e[j] = tile[(8 * kc + j) * 65 + nn];
          u32x4 w; w.x = pk_bf16(e[0], e[1]); w.y = pk_bf16(e[2], e[3]); w.z = pk_bf16(e[4], e[5]); w.w = pk_bf16(e[6], e[7]);
          *(u32x4*)(t.Wt + (size_t)(t.dstn0 + nn) * t.ldt + t.k0 + 8 * kc) = w; }
        __syncthreads();
        t = tn; v[0] = vn[0]; v[1] = vn[1];
    }
    const int gt = blockIdx.x * 512 + tid_, gs = gridDim.x * 512;
    bf16_t* LB = (bf16_t*)(p.ws + WS_LB); bf16_t* W2T = (bf16_t*)(p.ws + WS_W2T); bf16_t* A2T = (bf16_t*)(p.ws + WS_A2T); bf16_t* G2T = (bf16_t*)(p.ws + WS_G2T);
    const float* wa = p.in[10] + (size_t)l * 65536; const float* wx = p.in[12] + (size_t)l * 65536;
    for (int e = gt; e < 131072; e += gs) { const int i = e & 63, c = (e >> 6) & 63, gate = (e >> 12) & 1, d = (e >> 13) & 1, n = e >> 14;
        const float v = (gate ? wx : wa)[((d * 8 + n) * 64 + i) * 64 + c]; LB[e] = (bf16_t)(pk_bf16(v, 0.f) & 0xffffu); }
    const float* w2 = p.in[17] + (size_t)l * 65536; const float* a2 = p.in[19] + (size_t)l * 65536; const float* g2 = p.in[20] + (size_t)l * 65536;
    for (int e = gt; e < 65536; e += gs) { const int rk = e & 63, c = (e >> 6) & 511, d = e >> 15;
        W2T[e] = (bf16_t)(pk_bf16(w2[(d * 64 + rk) * 512 + c], 0.f) & 0xffffu); A2T[e] = (bf16_t)(pk_bf16(a2[(d * 64 + rk) * 512 + c], 0.f) & 0xffffu); }
    for (int e = gt; e < 65536; e += gs) { const int rk = e & 127, c = e >> 7; G2T[e] = (bf16_t)(pk_bf16(g2[rk * 512 + c], 0.f) & 0xffffu); }
}

DI float wave_sum(float v) {
#pragma unroll
    for (int o = 32; o >= 1; o >>= 1) v += __shfl_xor(v, o);
    return v; }
__device__ void rowpass0(const Params& p, const int tid_) {
    const int lane = tid_ & 63, gw = blockIdx.x * 8 + (tid_ >> 6), nw = gridDim.x * 8;
    bf16_t* XB = (bf16_t*)(p.ws + WS_XB); float* RS1 = (float*)(p.ws + WS_RS1);
    for (int row = gw; row < T; row += nw) {
        const float* src = row < 16384 ? p.in[0] + (size_t)row * D : p.in[1] + (size_t)(row - 16384) * D;
        float ss = 0.f; float4 v[8];
#pragma unroll
        for (int i = 0; i < 8; ++i) { v[i] = ((const float4*)src)[lane + 64 * i]; ss += v[i].x * v[i].x + v[i].y * v[i].y + v[i].z * v[i].z + v[i].w * v[i].w; }
        ss = wave_sum(ss);
        const float rs = rsqrtf(ss * (1.0f / 2048.0f) + 1e-6f);
#pragma unroll
        for (int i = 0; i < 8; ++i) { u32x2 w; w.x = pk_bf16(v[i].x * rs, v[i].y * rs); w.y = pk_bf16(v[i].z * rs, v[i].w * rs); *(u32x2*)(XB + (size_t)row * D + 4 * (lane + 64 * i)) = w; }
        if (lane == 0) RS1[row] = rs;
    }
}
__device__ void rowpass_post(const Params& p, const bf16_t* Y, const float* gpost, int xmode, const float* RSin, float* RS, int outmode, const int tid_) {
    const int lane = tid_ & 63, gw = blockIdx.x * 8 + (tid_ >> 6), nw = gridDim.x * 8;
    bf16_t* XB = (bf16_t*)(p.ws + WS_XB); bf16_t* XS = (bf16_t*)p.out;
    float g[4][8];
#pragma unroll
    for (int i = 0; i < 4; ++i)
#pragma unroll
        for (int j = 0; j < 8; ++j) g[i][j] = gpost[8 * (lane + 64 * i) + j];
    for (int row = gw; row < T; row += nw) {
        float y[4][8], x[4][8]; float ss = 0.f;
#pragma unroll
        for (int i = 0; i < 4; ++i) { const size_t off = (size_t)row * D + 8 * (lane + 64 * i);
            const u32x4 yv = *(const u32x4*)(Y + off);
#pragma unroll
            for (int j = 0; j < 8; ++j) { y[i][j] = bf_at(yv, j); ss += y[i][j] * y[i][j]; }
            if (xmode == 0) { const float* xs = row < 16384 ? p.in[0] + off : p.in[1] + (off - (size_t)16384 * D);
                const float4 a = *(const float4*)xs, b = *(const float4*)(xs + 4);
                x[i][0] = a.x; x[i][1] = a.y; x[i][2] = a.z; x[i][3] = a.w; x[i][4] = b.x; x[i][5] = b.y; x[i][6] = b.z; x[i][7] = b.w; }
            else { const u32x4 xv = *(const u32x4*)((xmode == 1 ? XS : XB) + off); const float us = xmode == 2 ? 1.0f / RSin[row] : 1.0f;
#pragma unroll
                for (int j = 0; j < 8; ++j) x[i][j] = bf_at(xv, j) * us; } }
        ss = wave_sum(ss);
        const float ry = rsqrtf(ss * (1.0f / 2048.0f) + 1e-6f);
        float s2 = 0.f;
#pragma unroll
        for (int i = 0; i < 4; ++i)
#pragma unroll
            for (int j = 0; j < 8; ++j) { x[i][j] += y[i][j] * ry * g[i][j]; s2 += x[i][j] * x[i][j]; }
        s2 = wave_sum(s2);
        const float rsn = rsqrtf(s2 * (1.0f / 2048.0f) + 1e-6f);
#pragma unroll
        for (int i = 0; i < 4; ++i) { const size_t off = (size_t)row * D + 8 * (lane + 64 * i);
            if (outmode == 2) { *(float4*)(p.out + off) = make_float4(x[i][0], x[i][1], x[i][2], x[i][3]); *(float4*)(p.out + off + 4) = make_float4(x[i][4], x[i][5], x[i][6], x[i][7]); }
            else { u32x4 w; w.x = pk_bf16(x[i][0] * rsn, x[i][1] * rsn); w.y = pk_bf16(x[i][2] * rsn, x[i][3] * rsn); w.z = pk_bf16(x[i][4] * rsn, x[i][5] * rsn); w.w = pk_bf16(x[i][6] * rsn, x[i][7] * rsn);
                *(u32x4*)(XB + off) = w;
                if (outmode == 1) { u32x4 u; u.x = pk_bf16(x[i][0], x[i][1]); u.y = pk_bf16(x[i][2], x[i][3]); u.z = pk_bf16(x[i][4], x[i][5]); u.w = pk_bf16(x[i][6], x[i][7]); *(u32x4*)(XS + off) = u; } } }
        if (outmode != 2 && lane == 0) RS[row] = rsn;
    }
}

__device__ void attn_unit(const Params& p, int l, int unit, LAS unsigned char* lds, const int tid_) {
    const int tid = tid_, lane = tid & 63, w = tid >> 6, r = lane & 15, q = lane >> 4;
    constexpr int NH = 1; const int qb = unit >> 3, hq0 = unit & 7, kvh = hq0 >> 2;
    const int g0 = qb * 128; int s0, len; seq_of(g0, s0, len);
    const bf16_t* P = (const bf16_t*)(p.ws + WS_P); bf16_t* MB = mixbuf_of(p);
    LAS bf16_t* Ks = (LAS bf16_t*)lds;
    LAS bf16_t* Vt = (LAS bf16_t*)(lds + 34816);
    LAS float* btab = (LAS float*)(lds + 69632);
    const int ql = 16 * w + r;
    __syncthreads();
    {
        const int rel = tid - 256, n = rel < 0 ? -rel : rel;
        const int bkt = (rel > 0 ? 16 : 0) + (n < 8 ? n : n < 12 ? 8 : n < 16 ? 9 : n < 23 ? 10 : n < 32 ? 11 : n < 46 ? 12 : n < 64 ? 13 : n < 91 ? 14 : 15);
#pragma unroll
        for (int hh = 0; hh < NH; ++hh) { const float v = n <= 128 ? p.in[27][bkt * 8 + hq0 + hh] : -1e30f;
#pragma unroll
            for (int c = 0; c < 4; ++c) btab[(hh * 4 + c) * 520 + tid + c] = v; } }
    bf16x8 qf[NH][4];
#pragma unroll
    for (int hh = 0; hh < NH; ++hh)
#pragma unroll
        for (int ks = 0; ks < 4; ++ks) qf[hh][ks] = *(const bf16x8*)(P + (size_t)(g0 + ql) * NP + (hq0 + hh) * 128 + 32 * ks + 8 * q);
    float m[NH], lsum[NH]; f32x4 o[NH][8];
#pragma unroll
    for (int hh = 0; hh < NH; ++hh) { m[hh] = p.in[26][l * 8 + hq0 + hh]; lsum[hh] = q == 0 ? 1.0f : 0.0f;
#pragma unroll
        for (int dt = 0; dt < 8; ++dt) o[hh][dt] = (f32x4){0.f, 0.f, 0.f, 0.f}; }
    const float scale = 0.08838834764831845f;
#pragma unroll 1
    for (int kbi = 0; kbi < 3; ++kbi) {
        const int gk0 = g0 + (kbi - 1) * 128;
        if (gk0 < s0 || gk0 >= s0 + len) continue;
        __syncthreads();
#pragma unroll
        for (int i = 0; i < 4; ++i) { const int id = tid + 512 * i, row = id >> 4, ch = id & 15;
            const u32x4 v = *(const u32x4*)(P + (size_t)(gk0 + row) * NP + P_K + kvh * 128 + 8 * ch); *(LAS u32x4*)(Ks + row * 136 + 8 * ch) = v; }
#pragma unroll
        for (int i = 0; i < 2; ++i) { const int id = tid + 512 * i, kp = id & 63, dc = id >> 6, k0 = 2 * kp, kin = k0 & 31;
            const int pos = (k0 & ~31) + (kin < 16 ? 8 * (kin >> 2) + (kin & 3) : 8 * ((kin - 16) >> 2) + 4 + (kin & 3));
            const u32x4 va = *(const u32x4*)(P + (size_t)(gk0 + k0) * NP + P_V + kvh * 128 + 8 * dc), vb = *(const u32x4*)(P + (size_t)(gk0 + k0 + 1) * NP + P_V + kvh * 128 + 8 * dc);
#pragma unroll
            for (int j = 0; j < 4; ++j) { *(LAS unsigned*)(Vt + (8 * dc + 2 * j) * 136 + pos) = (va[j] & 0xffffu) | (vb[j] << 16);
                                          *(LAS unsigned*)(Vt + (8 * dc + 2 * j + 1) * 136 + pos) = (va[j] >> 16) | (vb[j] & 0xffff0000u); } }
        __syncthreads();
        bf16x8 pf[NH][4];
        const int bidx = (kbi - 1) * 128 + 4 * q - ql + 256 + (ql & 3);
#pragma unroll
        for (int hh = 0; hh < NH; ++hh) {
            f32x4 s[8];
#pragma unroll
            for (int kt = 0; kt < 8; ++kt) { f32x4 acc = (f32x4){0.f, 0.f, 0.f, 0.f};
#pragma unroll
                for (int ks = 0; ks < 4; ++ks) { const bf16x8 a = *(const LAS bf16x8*)(Ks + (16 * kt + r) * 136 + 32 * ks + 8 * q); acc = mfma16(a, qf[hh][ks], acc); }
                s[kt] = acc; }
            const LAS float* bt = btab + (hh * 4 + (ql & 3)) * 520 + bidx;
            float mx = -1e30f;
#pragma unroll
            for (int kt = 0; kt < 8; ++kt) { const f32x4 bv = *(const LAS f32x4*)(bt + 16 * kt);
#pragma unroll
                for (int i = 0; i < 4; ++i) { const float v = s[kt][i] * scale + bv[i]; s[kt][i] = v; mx = fmaxf(mx, v); } }
            mx = fmaxf(mx, __shfl_xor(mx, 16)); mx = fmaxf(mx, __shfl_xor(mx, 32));
            const float mn = fmaxf(m[hh], mx), alpha = exp_fast(m[hh] - mn); m[hh] = mn;
            float ps = 0.f;
#pragma unroll
            for (int kt = 0; kt < 8; ++kt)
#pragma unroll
                for (int i = 0; i < 4; ++i) { const float pv = exp_fast(s[kt][i] - mn); s[kt][i] = pv; ps += pv; }
            lsum[hh] = lsum[hh] * alpha + ps;
#pragma unroll
            for (int dt = 0; dt < 8; ++dt) o[hh][dt] *= alpha;
#pragma unroll
            for (int kk = 0; kk < 4; ++kk) { u32x4 pw; pw.x = pk_bf16(s[2 * kk][0], s[2 * kk][1]); pw.y = pk_bf16(s[2 * kk][2], s[2 * kk][3]);
                pw.z = pk_bf16(s[2 * kk + 1][0], s[2 * kk + 1][1]); pw.w = pk_bf16(s[2 * kk + 1][2], s[2 * kk + 1][3]); pf[hh][kk] = __builtin_bit_cast(bf16x8, pw); }
            asm volatile("" ::: "memory");
        }
#pragma unroll
        for (int kk = 0; kk < 4; ++kk)
#pragma unroll
            for (int dt = 0; dt < 8; ++dt) { const bf16x8 vf = *(const LAS bf16x8*)(Vt + (16 * dt + r) * 136 + 32 * kk + 8 * q);
                o[0][dt] = mfma16(vf, pf[0][kk], o[0][dt]); }
    }
#pragma unroll
    for (int hh = 0; hh < NH; ++hh) {
        float lt = lsum[hh]; lt += __shfl_xor(lt, 16); lt += __shfl_xor(lt, 32);
        const float inv = 1.0f / lt;
        bf16_t* dst = MB + (size_t)(g0 + ql) * D + 1024 + (hq0 + hh) * 128 + 4 * q;
#pragma unroll
        for (int dt = 0; dt < 8; ++dt) { u32x2 wv; wv.x = pk_bf16(o[hh][dt][0] * inv, o[hh][dt][1] * inv); wv.y = pk_bf16(o[hh][dt][2] * inv, o[hh][dt][3] * inv); *(u32x2*)(dst + 16 * dt) = wv; }
    }
}

__device__ void rwkv_prep_tile(const Params& p, int l, int tile, LAS unsigned char* lds, const int tid_) {
    const int tid = tid_, lane = tid & 63, w = tid >> 6, r = lane & 15, q = lane >> 4;
    const int t0 = tile * 64; int s0, len; seq_of(t0, s0, len);
    LAS bf16_t* raw = (LAS bf16_t*)lds;
    LAS bf16_t* A = (LAS bf16_t*)(lds + 50688);
    const bf16_t* P = (const bf16_t*)(p.ws + WS_P); bf16_t* MB = mixbuf_of(p); _Float16* PREP = (_Float16*)(p.ws + WS_PREP);
    const bf16_t* W2T = (const bf16_t*)(p.ws + WS_W2T); const bf16_t* A2T = (const bf16_t*)(p.ws + WS_A2T); const bf16_t* G2T = (const bf16_t*)(p.ws + WS_G2T);
    const float* mu = p.in[15] + l * 1920 + 1536; const float* w0 = p.in[16] + l * 1024; const float* a0 = p.in[18] + l * 1024;
    __syncthreads();
    for (int id = tid; id < 66 * 48; id += 512) { const int row = id / 48, ch = id % 48, gr = t0 - 1 + row; u32x4 v = (u32x4){0u, 0u, 0u, 0u};
        if (gr >= s0 && gr < s0 + len) v = *(const u32x4*)(P + (size_t)gr * NP + P_RW + 1536 + 8 * ch);
        *(LAS u32x4*)(raw + row * 384 + 8 * ch) = v; }
    __syncthreads();
    for (int id = tid; id < 64 * 48; id += 512) { const int tok = id / 48, ch = id % 48, col = 8 * ch;
        const u32x4 a = *(const LAS u32x4*)(raw + tok * 384 + col), b = *(const LAS u32x4*)(raw + (tok + 1) * 384 + col), c = *(const LAS u32x4*)(raw + (tok + 2) * 384 + col);
        float o[8];
#pragma unroll
        for (int j = 0; j < 8; ++j) { const float zm = bf_at(a, j), z = bf_at(b, j), zp = bf_at(c, j); float zz = z + (0.5f * (zm + zp) - z) * mu[col + j];
            if (col < 128) zz = tanh_fast(zz); else if (col >= 256) zz = sigm(zz); o[j] = zz; }
        u32x4 wv; wv.x = pk_bf16(o[0], o[1]); wv.y = pk_bf16(o[2], o[3]); wv.z = pk_bf16(o[4], o[5]); wv.w = pk_bf16(o[6], o[7]);
        *(LAS u32x4*)(A + tok * 392 + col) = wv; }
    __syncthreads();
#pragma unroll 1
    for (int og = 0; og < 5; ++og) {
        const int nks = og < 4 ? 2 : 4, acol0 = og < 4 ? 64 * og : 256, ldb = og < 4 ? 64 : 128;
        const bf16_t* Bt = og < 2 ? W2T + og * 32768 : (og < 4 ? A2T + (og - 2) * 32768 : G2T);
        f32x4 acc[4][4];
#pragma unroll
        for (int mt = 0; mt < 4; ++mt)
#pragma unroll
            for (int nt = 0; nt < 4; ++nt) acc[mt][nt] = (f32x4){0.f, 0.f, 0.f, 0.f};
#pragma unroll 1
        for (int ks = 0; ks < nks; ++ks) {
            bf16x8 bfr[4];
#pragma unroll
            for (int nt = 0; nt < 4; ++nt) bfr[nt] = *(const bf16x8*)(Bt + (size_t)(64 * w + 16 * nt + r) * ldb + 32 * ks + 8 * q);
#pragma unroll
            for (int mt = 0; mt < 4; ++mt) { const bf16x8 a = *(const LAS bf16x8*)(A + (16 * mt + r) * 392 + acol0 + 32 * ks + 8 * q);
#pragma unroll
                for (int nt = 0; nt < 4; ++nt) acc[mt][nt] = mfma16(bfr[nt], a, acc[mt][nt]); }
        }
        {
            _Float16* pb = PREP + (size_t)(t0 + r) * 2048 + og * 512 + 64 * w + 4 * q; bf16_t* mb = MB + (size_t)(t0 + r) * D + 512 + 64 * w + 4 * q;
            const float* bsrc = og < 2 ? w0 + og * 512 : a0 + (og - 2) * 512;
#pragma unroll
            for (int nt = 0; nt < 4; ++nt) { f32x4 bias = (f32x4){0.f, 0.f, 0.f, 0.f}; if (og < 4) bias = *(const f32x4*)(bsrc + 64 * w + 16 * nt + 4 * q);
#pragma unroll
                for (int mt = 0; mt < 4; ++mt) { const f32x4 x = acc[mt][nt] + bias;
                    if (og < 4) { f16x4 hv;
#pragma unroll
                        for (int i = 0; i < 4; ++i) { const float sg = sigm(x[i]); hv[i] = (_Float16)(og < 2 ? exp_fast(-0.606531f * sg) : sg); }
                        *(f16x4*)(pb + (size_t)mt * 16 * 2048 + 16 * nt) = hv; }
                    else { u32x2 wv; wv.x = pk_bf16(x[0], x[1]); wv.y = pk_bf16(x[2], x[3]); *(u32x2*)(mb + (size_t)mt * 16 * D + 16 * nt) = wv; }
                    asm volatile("" ::: "memory"); } }
        }
    }
}

DI float fma_s(float a, float b, float c) { float d; asm("v_fma_f32 %0, %1, %2, %3" : "=v"(d) : "v"(a), "v"(b), "v"(c)); return d; }
DI float mul_s(float a, float b) { float d; asm("v_mul_f32 %0, %1, %2" : "=v"(d) : "v"(a), "v"(b)); return d; }
template <int CTRL> DI float dpp_xadd(float v) { return v + __int_as_float(__builtin_amdgcn_update_dpp(0, __float_as_int(v), CTRL, 0xF, 0xF, true)); }
DI float sum16(float v) { v = dpp_xadd<0xB1>(v); v = dpp_xadd<0x4E>(v); v = dpp_xadd<0x141>(v); v = dpp_xadd<0x140>(v); return v; }
DI float sum8(float v) { v = dpp_xadd<0xB1>(v); v = dpp_xadd<0x4E>(v); v = dpp_xadd<0x141>(v); return v; }
__device__ void rwkv_scan_task(const Params& p, int l, int htask, LAS unsigned char* lds, const int tid_) {
    const int tid = tid_;
    const int task = htask >> 1, rhalf = htask & 1;
    int seq, hd; if (task < 64) { seq = 8 + (task >> 4); hd = task & 15; } else { const int j = task - 64; seq = j >> 4; hd = j & 15; }
    const int h = hd >> 1, d = hd & 1;
    const int s0 = seq < 8 ? seq * 2048 : 16384 + (seq - 8) * 8192, len = seq < 8 ? 2048 : 8192, ntiles = len / 32;
    LAS float* ldsf = (LAS float*)lds;
    const bf16_t* P = (const bf16_t*)(p.ws + WS_P); const _Float16* PREP = (const _Float16*)(p.ws + WS_PREP); bf16_t* YFB = (bf16_t*)(p.ws + WS_YFB);
    __syncthreads();
    if (tid >= 256) {
        const int pt = tid - 256, ptok = pt >> 3, cq = pt & 7, c0 = 64 * h + 8 * cq;
        const float* mu = p.in[15] + l * 1920;
        float mu_c[3][8], kk_c[8], ka_c[8];
#pragma unroll
        for (int j = 0; j < 8; ++j) { mu_c[0][j] = mu[c0 + j]; mu_c[1][j] = mu[512 + c0 + j]; mu_c[2][j] = mu[1024 + c0 + j]; kk_c[j] = p.in[21][l * 512 + c0 + j]; ka_c[j] = p.in[22][(l * 2 + d) * 512 + c0 + j]; }
        u32x4 raw[3][3], rw_w, rw_a;
        const u32x4 zero4 = (u32x4){0u, 0u, 0u, 0u};
#define RW_TT(ti) (d ? len - 32 * ((ti) + 1) + (31 - ptok) : 32 * (ti) + ptok)
#define RW_LOAD(ti) do { const int tt_ = RW_TT(ti); const size_t gr_ = (size_t)(s0 + tt_); \
            _Pragma("unroll") for (int X = 0; X < 3; ++X) { const bf16_t* b_ = P + gr_ * NP + P_RW + 512 * X + c0; raw[X][1] = *(const u32x4*)b_; \
                raw[X][0] = tt_ > 0 ? *(const u32x4*)(b_ - NP) : zero4; raw[X][2] = tt_ < len - 1 ? *(const u32x4*)(b_ + NP) : zero4; } \
            rw_w = *(const u32x4*)(PREP + gr_ * 2048 + d * 512 + c0); rw_a = *(const u32x4*)(PREP + gr_ * 2048 + (2 + d) * 512 + c0); } while (0)
#define RW_CONVERT(bufi) do { LAS float* ob_ = ldsf + (bufi) * 11264; float z_[3][8]; \
            _Pragma("unroll") for (int X = 0; X < 3; ++X) _Pragma("unroll") for (int j = 0; j < 8; ++j) { const float zc_ = bf_at(raw[X][1], j); z_[X][j] = zc_ + (0.5f * (bf_at(raw[X][0], j) + bf_at(raw[X][2], j)) - zc_) * mu_c[X][j]; } \
            const f16x8 wh_ = __builtin_bit_cast(f16x8, rw_w), ah_ = __builtin_bit_cast(f16x8, rw_a); float kkn_[8], ss_ = 0.f; \
            _Pragma("unroll") for (int j = 0; j < 8; ++j) { kkn_[j] = z_[1][j] * kk_c[j]; ss_ += kkn_[j] * kkn_[j]; } \
            ss_ = sum8(ss_); const float inv_ = rsqrtf(fmaxf(ss_, 1e-24f)); \
            _Pragma("unroll") for (int hh = 0; hh < 2; ++hh) { f32x4 vK, vW, vB, vKh, vR, vV; \
                _Pragma("unroll") for (int j = 0; j < 4; ++j) { const int jj = 4 * hh + j; const float av = (float)ah_[jj]; vK[j] = kkn_[jj] * inv_; vW[j] = (float)wh_[jj]; vB[j] = vK[j] * av; \
                    vKh[j] = z_[1][jj] * (1.0f + (av - 1.0f) * ka_c[jj]); vR[j] = z_[0][jj]; vV[j] = z_[2][jj]; } \
                const int o_ = ptok * 64 + 8 * cq + 4 * hh; \
                *(LAS f32x4*)(ob_ + o_) = vK; *(LAS f32x4*)(ob_ + 2048 + o_) = vW; *(LAS f32x4*)(ob_ + 4096 + o_) = vB; *(LAS f32x4*)(ob_ + 6144 + o_) = vKh; *(LAS f32x4*)(ob_ + 8192 + o_) = vR; \
                if ((cq >> 2) == rhalf) *(LAS f32x4*)(ob_ + 10240 + ptok * 32 + 8 * (cq & 3) + 4 * hh) = vV; } } while (0)
#define RW_STOREY(ti) do { const int tt_ = RW_TT(ti); const f32x4 yv_ = *(const LAS f32x4*)(ldsf + 22528 + ((ti) & 1) * 1024 + ptok * 32 + 4 * cq); \
            u32x2 wv_; wv_.x = pk_bf16(yv_[0], yv_[1]); wv_.y = pk_bf16(yv_[2], yv_[3]); \
            *(u32x2*)(YFB + ((size_t)d * T + (size_t)(s0 + tt_)) * 512 + 64 * h + 32 * rhalf + 4 * cq) = wv_; } while (0)
        RW_LOAD(0); RW_CONVERT(0); RW_LOAD(1);
        __syncthreads();
        for (int ti = 0; ti < ntiles; ++ti) {
            if (ti + 1 < ntiles) { RW_CONVERT((ti + 1) & 1); if (ti + 2 < ntiles) RW_LOAD(ti + 2); }
            if (ti > 0) RW_STOREY(ti - 1);
            __syncthreads();
        }
        RW_STOREY(ntiles - 1);
#undef RW_LOAD
#undef RW_CONVERT
#undef RW_STOREY
#undef RW_TT
    } else {
        const int rv = tid >> 3, rg = tid & 7;
        __builtin_amdgcn_s_setprio(3);
        f32x2 st[4];
#pragma unroll
        for (int i = 0; i < 4; ++i) st[i] = (f32x2){0.f, 0.f};
        __syncthreads();
        for (int ti = 0; ti < ntiles; ++ti) {
            const LAS float* ob = ldsf + (ti & 1) * 11264 + 8 * rg; const LAS float* ov = ldsf + (ti & 1) * 11264 + 10240 + rv; LAS float* yb = ldsf + 22528 + (ti & 1) * 1024 + rv;
#define RW_FETCH(dst, dv, s) do { _Pragma("unroll") for (int a_ = 0; a_ < 5; ++a_) { dst[2 * a_] = *(const LAS f32x4*)(ob + a_ * 2048 + (s) * 64); dst[2 * a_ + 1] = *(const LAS f32x4*)(ob + a_ * 2048 + (s) * 64 + 4); } dv = ov[(s) * 32]; } while (0)
            f32x4 cur[10], nxt[10]; float cv, nv;
            RW_FETCH(cur, cv, 0);
#pragma unroll 1
            for (int s8 = 0; s8 < 32; s8 += 8) {
                float yk = 0.f;
#pragma unroll
                for (int j = 0; j < 8; ++j) { const int s = s8 + j;
                    { const int sn = s + 1 < 32 ? s + 1 : 31; RW_FETCH(nxt, nv, sn); }
                    const f32x2 vv2 = (f32x2){cv, cv};
                    const f32x2 t0 = st[0] * (f32x2){cur[2][0], cur[2][1]} + vv2 * (f32x2){cur[6][0], cur[6][1]}, t1 = st[1] * (f32x2){cur[2][2], cur[2][3]} + vv2 * (f32x2){cur[6][2], cur[6][3]};
                    const f32x2 t2 = st[2] * (f32x2){cur[3][0], cur[3][1]} + vv2 * (f32x2){cur[7][0], cur[7][1]}, t3 = st[3] * (f32x2){cur[3][2], cur[3][3]} + vv2 * (f32x2){cur[7][2], cur[7][3]};
                    const f32x2 sa2 = ((st[0] * (f32x2){cur[0][0], cur[0][1]} + st[1] * (f32x2){cur[0][2], cur[0][3]}) + st[2] * (f32x2){cur[1][0], cur[1][1]}) + st[3] * (f32x2){cur[1][2], cur[1][3]};
                    const float sa = sum8(sa2[0] + sa2[1]);
                    const f32x2 nsa = (f32x2){-sa, -sa};
                    st[0] = nsa * (f32x2){cur[4][0], cur[4][1]} + t0; st[1] = nsa * (f32x2){cur[4][2], cur[4][3]} + t1;
                    st[2] = nsa * (f32x2){cur[5][0], cur[5][1]} + t2; st[3] = nsa * (f32x2){cur[5][2], cur[5][3]} + t3;
                    const f32x2 y2 = ((st[0] * (f32x2){cur[8][0], cur[8][1]} + st[1] * (f32x2){cur[8][2], cur[8][3]}) + st[2] * (f32x2){cur[9][0], cur[9][1]}) + st[3] * (f32x2){cur[9][2], cur[9][3]};
                    const float y = sum8(y2[0] + y2[1]);
                    yk = (rg == j) ? y : yk;
#pragma unroll
                    for (int a_ = 0; a_ < 10; ++a_) cur[a_] = nxt[a_];
                    cv = nv; }
                yb[(s8 + rg) * 32] = yk;
            }
#undef RW_FETCH
            __syncthreads();
        }
        __builtin_amdgcn_s_setprio(0);
    }
}

__device__ void rwkv_final(const Params& p, int l, const int tid_) {
    const int lane = tid_ & 63, gw = blockIdx.x * 8 + (tid_ >> 6), nw = gridDim.x * 8, c0 = 8 * lane, h = lane >> 3;
    const bf16_t* P = (const bf16_t*)(p.ws + WS_P); const _Float16* PREP = (const _Float16*)(p.ws + WS_PREP); const bf16_t* YFB = (const bf16_t*)(p.ws + WS_YFB); bf16_t* MB = mixbuf_of(p);
    const float* mu = p.in[15] + l * 1920;
    float mu_c[3][8], ka0[8], ka1[8], rk[8], gnw[8], gnb[8];
#pragma unroll
    for (int j = 0; j < 8; ++j) { mu_c[0][j] = mu[c0 + j]; mu_c[1][j] = mu[512 + c0 + j]; mu_c[2][j] = mu[1024 + c0 + j];
        ka0[j] = p.in[22][(l * 2 + 0) * 512 + c0 + j]; ka1[j] = p.in[22][(l * 2 + 1) * 512 + c0 + j]; rk[j] = p.in[23][l * 512 + h * 64 + (c0 & 63) + j];
        gnw[j] = p.in[24][l * 512 + c0 + j]; gnb[j] = p.in[25][l * 512 + c0 + j]; }
    for (int row = gw; row < T; row += nw) {
        int s0, len; seq_of(row, s0, len); const bool hm = row > s0, hp = row < s0 + len - 1;
        const u32x4 yf = *(const u32x4*)(YFB + (size_t)row * 512 + c0), yb = *(const u32x4*)(YFB + ((size_t)T + row) * 512 + c0);
        float y[8], sum = 0.f;
#pragma unroll
        for (int j = 0; j < 8; ++j) { y[j] = bf_at(yf, j) + bf_at(yb, j); sum += y[j]; }
        sum += __shfl_xor(sum, 1); sum += __shfl_xor(sum, 2); sum += __shfl_xor(sum, 4);
        const float mean = sum * (1.0f / 64.0f); float var = 0.f;
#pragma unroll
        for (int j = 0; j < 8; ++j) { const float dd = y[j] - mean; var += dd * dd; }
        var += __shfl_xor(var, 1); var += __shfl_xor(var, 2); var += __shfl_xor(var, 4);
        const float rstd = rsqrtf(var * (1.0f / 64.0f) + 64e-5f);
        float z[3][8];
        const u32x4 zero4 = (u32x4){0u, 0u, 0u, 0u};
#pragma unroll
        for (int X = 0; X < 3; ++X) { const bf16_t* b = P + (size_t)row * NP + P_RW + 512 * X + c0;
            const u32x4 zc = *(const u32x4*)b, zm = hm ? *(const u32x4*)(b - NP) : zero4, zp = hp ? *(const u32x4*)(b + NP) : zero4;
#pragma unroll
            for (int j = 0; j < 8; ++j) { const float c = bf_at(zc, j); z[X][j] = c + (0.5f * (bf_at(zm, j) + bf_at(zp, j)) - c) * mu_c[X][j]; } }
        const f16x8 a0 = *(const f16x8*)(PREP + (size_t)row * 2048 + 1024 + c0), a1 = *(const f16x8*)(PREP + (size_t)row * 2048 + 1536 + c0);
        float bs = 0.f;
#pragma unroll
        for (int j = 0; j < 8; ++j) { const float k0 = z[1][j] * (1.0f + ((float)a0[j] - 1.0f) * ka0[j]), k1 = z[1][j] * (1.0f + ((float)a1[j] - 1.0f) * ka1[j]); bs += z[0][j] * (k0 + k1) * rk[j]; }
        bs += __shfl_xor(bs, 1); bs += __shfl_xor(bs, 2); bs += __shfl_xor(bs, 4);
        const u32x4 gv = *(const u32x4*)(MB + (size_t)row * D + 512 + c0);
        float o[8];
#pragma unroll
        for (int j = 0; j < 8; ++j) o[j] = ((y[j] - mean) * rstd * gnw[j] + gnb[j] + bs * z[2][j]) * bf_at(gv, j);
        u32x4 wv; wv.x = pk_bf16(o[0], o[1]); wv.y = pk_bf16(o[2], o[3]); wv.z = pk_bf16(o[4], o[5]); wv.w = pk_bf16(o[6], o[7]);
        *(u32x4*)(MB + (size_t)row * D + 512 + c0) = wv;
    }
}

DI float gelu_tanh(float x) { const float u = 0.7978845608028654f * (x + 0.044715f * x * x * x); return 0.5f * x * (1.0f + tanh_fast(u)); }
__device__ void lru_run(const Params& p, int l, int n, int tile_first, int tile_stride, int tile_count, int mode, LAS unsigned char* lds, const int tid_) {
    const int tid = tid_, lane = tid & 63, w = tid >> 6, r = lane & 15, q = lane >> 4;
    LAS float* xcf = (LAS float*)lds;
    LAS bf16_t* Ab = (LAS bf16_t*)(lds + 16384);
    LAS float* aL = (LAS float*)(lds + 25600);
    LAS float* uL = (LAS float*)(lds + 58368);
    LAS float* agg = (LAS float*)(lds + 91136);
    LAS float* carry = (LAS float*)(lds + 95232);
    const bf16_t* P = (const bf16_t*)(p.ws + WS_P); bf16_t* MB = mixbuf_of(p); const bf16_t* LB = (const bf16_t*)(p.ws + WS_LB);
    f32x2* AGG = (f32x2*)(p.ws + WS_AGG);
    const int tok = tid >> 3, cg8 = tid & 7, ch0 = 64 * n + 8 * cg8;
    LAS float* cwl = (LAS float*)(lds + 95744);
    __syncthreads();
    if (tid < 320) { const int k = tid >> 6, c = tid & 63; cwl[tid] = k < 4 ? p.in[8][(l * 4 + k) * 512 + 64 * n + c] : p.in[9][l * 512 + 64 * n + c]; }
    const int gd = w >> 2, ct = w & 3, chl = 16 * ct + r, gc = 64 * n + chl;
    bf16x8 br[2], bi[2];
#pragma unroll
    for (int ks = 0; ks < 2; ++ks) { br[ks] = *(const bf16x8*)(LB + (size_t)(n * 256 + (gd * 2 + 0) * 64 + chl) * 64 + 32 * ks + 8 * q);
                                     bi[ks] = *(const bf16x8*)(LB + (size_t)(n * 256 + (gd * 2 + 1) * 64 + chl) * 64 + 32 * ks + 8 * q); }
    const float ba_c = p.in[11][(l * 2 + gd) * 512 + gc], bx_c = p.in[13][(l * 2 + gd) * 512 + gc];
    float sp_c; { const float lam = p.in[14][(l * 2 + gd) * 512 + gc]; const float e = exp_fast(-lam); sp_c = e < 0.1f ? e * (1.0f - e * (0.5f - e * (0.33333334f - e * (0.25f - e * 0.2f)))) : 0.6931471805599453f * __builtin_amdgcn_logf(1.0f + e); }
    const int sd = tid >> 8, sc = (tid >> 6) & 3, scn = tid & 63;
    const u32x4 zero4 = (u32x4){0u, 0u, 0u, 0u};
    u32x4 xr[4];
#define LRU_LOADX(gt_) do { const int t0g_ = (gt_) * 64; int s0_, len_; seq_of(t0g_, s0_, len_); \
        _Pragma("unroll") for (int k = 0; k < 4; ++k) { const int gr_ = t0g_ + tok - 2 + k; xr[k] = (gr_ >= s0_ && gr_ < s0_ + len_) ? *(const u32x4*)(P + (size_t)gr_ * NP + P_LX + ch0) : zero4; } } while (0)
    if (tile_count > 0) LRU_LOADX(tile_first);
    for (int it = 0; it < tile_count; ++it) {
        int tl_ = tid_; asm volatile("" : "+v"(tl_));
        const int tid = tl_, lane = tid & 63, w = tid >> 6, r = lane & 15, q = lane >> 4, tok = tid >> 3, cg8 = tid & 7, ch0 = 64 * n + 8 * cg8;
        const int gd = w >> 2, ct = w & 3, chl = 16 * ct + r, sd = tid >> 8, sc = (tid >> 6) & 3, scn = tid & 63;
        const int gt = tile_first + it * tile_stride, t0g = gt * 64; int s0, len; seq_of(t0g, s0, len);
        const int ti = (t0g - s0) >> 6, N = len >> 6;
        u32x4 gv = zero4;
        if (mode) gv = *(const u32x4*)(P + (size_t)(t0g + tok) * NP + P_LG + ch0);
        __syncthreads();
        {   float acc[8];
            { const f32x4 c0_ = *(const LAS f32x4*)(cwl + 256 + 8 * cg8), c1_ = *(const LAS f32x4*)(cwl + 256 + 8 * cg8 + 4);
#pragma unroll
              for (int j = 0; j < 4; ++j) { acc[j] = c0_[j]; acc[4 + j] = c1_[j]; } }
#pragma unroll
            for (int k = 0; k < 4; ++k) { const f32x4 c0_ = *(const LAS f32x4*)(cwl + 64 * k + 8 * cg8), c1_ = *(const LAS f32x4*)(cwl + 64 * k + 8 * cg8 + 4);
#pragma unroll
                for (int j = 0; j < 4; ++j) { acc[j] += c0_[j] * bf_at(xr[k], j); acc[4 + j] += c1_[j] * bf_at(xr[k], 4 + j); } }
            *(LAS f32x4*)(xcf + tok * 64 + 8 * cg8) = (f32x4){acc[0], acc[1], acc[2], acc[3]};
            *(LAS f32x4*)(xcf + tok * 64 + 8 * cg8 + 4) = (f32x4){acc[4], acc[5], acc[6], acc[7]};
            u32x4 wv; wv.x = pk_bf16(acc[0], acc[1]); wv.y = pk_bf16(acc[2], acc[3]); wv.z = pk_bf16(acc[4], acc[5]); wv.w = pk_bf16(acc[6], acc[7]);
            *(LAS u32x4*)(Ab + tok * 72 + 8 * cg8) = wv; }
        if (it + 1 < tile_count) LRU_LOADX(gt + tile_stride);
        float pA = 1.f, pH = 0.f;
        if (mode) { const int cnt = sd == 0 ? ti : N - 1 - ti, lo = (cnt * sc) >> 2, hi = (cnt * (sc + 1)) >> 2;
            const f32x2* ab = AGG + ((size_t)(gt - ti) * 8 + n) * 128 + sd * 64 + scn;
            f32x2 e[32];
#pragma unroll
            for (int u = 0; u < 32; ++u) { const int j = lo + u, tj = sd == 0 ? j : N - 1 - j; e[u] = j < hi ? ab[(size_t)tj * 1024] : (f32x2){1.f, 0.f}; }
#pragma unroll
            for (int u = 0; u < 32; ++u) { pH = e[u][0] * pH + e[u][1]; pA *= e[u][0]; } }
        __syncthreads();
        {   f32x4 accr[4], acci[4];
#pragma unroll
            for (int mt = 0; mt < 4; ++mt) { accr[mt] = (f32x4){0.f, 0.f, 0.f, 0.f}; acci[mt] = (f32x4){0.f, 0.f, 0.f, 0.f};
#pragma unroll
                for (int ks = 0; ks < 2; ++ks) { const bf16x8 a = *(const LAS bf16x8*)(Ab + (16 * mt + r) * 72 + 32 * ks + 8 * q);
                    accr[mt] = mfma16(a, br[ks], accr[mt]); acci[mt] = mfma16(a, bi[ks], acci[mt]); } }
            const int t0 = t0g - s0;
#pragma unroll
            for (int mt = 0; mt < 4; ++mt)
#pragma unroll
                for (int i = 0; i < 4; ++i) { const int tk = 16 * mt + 4 * q + i, tt = t0 + tk;
                    const float rg_ = sigm(accr[mt][i] + ba_c), ig_ = sigm(acci[mt][i] + bx_c);
                    const float la = -8.0f * rg_ * sp_c, a = exp_fast(la), e2 = 2.0f * la;
                    const float om = e2 > -0.05f ? -e2 * (1.0f + e2 * (0.5f + e2 * (0.16666667f + e2 * 0.041666668f))) : 1.0f - exp_fast(e2);
                    float mult = sqrtf(om); if (gd == 0 ? tt == 0 : tt == len - 1) mult = 1.0f;
                    const float u = mult * ig_ * xcf[tk * 64 + chl];
                    aL[(gd * 64 + tk) * 64 + chl] = a; uL[(gd * 64 + tk) * 64 + chl] = u; }
        }
        if (mode) { agg[((sd * 64 + scn) * 4 + sc) * 2 + 0] = pA; agg[((sd * 64 + scn) * 4 + sc) * 2 + 1] = pH; }
        __syncthreads();
        {
            float hh = 0.f;
            if (mode) {
#pragma unroll
                for (int s2 = 0; s2 < 4; ++s2) hh = agg[((sd * 64 + scn) * 4 + s2) * 2 + 0] * hh + agg[((sd * 64 + scn) * 4 + s2) * 2 + 1]; }
            float A = 1.f, H = 0.f;
#pragma unroll
            for (int j = 0; j < 16; ++j) { const int tk = sd == 0 ? 16 * sc + j : 63 - 16 * sc - j; const float a_ = aL[(sd * 64 + tk) * 64 + scn], u_ = uL[(sd * 64 + tk) * 64 + scn]; H = a_ * H + u_; A *= a_; }
            __syncthreads();
            agg[((sd * 64 + scn) * 4 + sc) * 2 + 0] = A; agg[((sd * 64 + scn) * 4 + sc) * 2 + 1] = H;
            __syncthreads();
            if (mode == 0) { if (sc == 0) { float tA = 1.f, tH = 0.f;
#pragma unroll
                    for (int s2 = 0; s2 < 4; ++s2) { const float a_ = agg[((sd * 64 + scn) * 4 + s2) * 2 + 0], h_ = agg[((sd * 64 + scn) * 4 + s2) * 2 + 1]; tH = a_ * tH + h_; tA *= a_; }
                    AGG[((size_t)gt * 8 + n) * 128 + sd * 64 + scn] = (f32x2){tA, tH}; } }
            else {
                for (int s2 = 0; s2 < sc; ++s2) hh = agg[((sd * 64 + scn) * 4 + s2) * 2 + 0] * hh + agg[((sd * 64 + scn) * 4 + s2) * 2 + 1];
#pragma unroll
                for (int j = 0; j < 16; ++j) { const int tk = sd == 0 ? 16 * sc + j : 63 - 16 * sc - j; hh = aL[(sd * 64 + tk) * 64 + scn] * hh + uL[(sd * 64 + tk) * 64 + scn]; uL[(sd * 64 + tk) * 64 + scn] = hh; }
            }
        }
        if (mode) {
            __syncthreads();
            const f32x4 f0 = *(const LAS f32x4*)(uL + tok * 64 + 8 * cg8), f1 = *(const LAS f32x4*)(uL + tok * 64 + 8 * cg8 + 4);
            const f32x4 b0 = *(const LAS f32x4*)(uL + (64 + tok) * 64 + 8 * cg8), b1 = *(const LAS f32x4*)(uL + (64 + tok) * 64 + 8 * cg8 + 4);
            float hv[8] = {f0[0] + b0[0], f0[1] + b0[1], f0[2] + b0[2], f0[3] + b0[3], f1[0] + b1[0], f1[1] + b1[1], f1[2] + b1[2], f1[3] + b1[3]};
#pragma unroll
            for (int j = 0; j < 8; ++j) hv[j] *= gelu_tanh(bf_at(gv, j));
            u32x4 wv; wv.x = pk_bf16(hv[0], hv[1]); wv.y = pk_bf16(hv[2], hv[3]); wv.z = pk_bf16(hv[4], hv[5]); wv.w = pk_bf16(hv[6], hv[7]);
            *(u32x4*)(MB + (size_t)(t0g + tok) * D + ch0) = wv;
        }
    }
#undef LRU_LOADX
}

#ifndef NCH
#define NCH 2
#endif
constexpr int FCH = NCH, FROWS = T / FCH, PER = 7 + 2 * FCH, N_PHASES = 1 + 2 * PER, ATTN_IN_SCAN = 768, ATTN_UNITS = 3072;
__device__ void run_phase(const Params& p, int ph, LAS unsigned char* lds, const int tid_) {
    bf16_t* XB = (bf16_t*)(p.ws + WS_XB); float* RS1 = (float*)(p.ws + WS_RS1); float* RS2 = (float*)(p.ws + WS_RS2);
    if (ph == 0) { wprep_phase(p, 0, lds, tid_); rowpass0(p, tid_); return; }
    const int l = (ph - 1) / PER, k = (ph - 1) % PER;
    if (k == 0) {
        pg8::Gemm g{XB, (const bf16_t*)(p.ws + WS_WIN), T, NP, D}; pg8::StaticOrder S; S.init(T, NP, (int)gridDim.x, (int)blockIdx.x);
        EpiBf16S E{(bf16_t*)(p.ws + WS_P), NP, nullptr, 0};
        pg8::gemm_phase<EpiBf16S, pg8::StaticOrder>(lds, g, S, E, nullptr, tid_);
    } else if (k == 1) {
        for (int u = ATTN_IN_SCAN + blockIdx.x; u < ATTN_UNITS; u += gridDim.x) { int t2 = tid_; asm volatile("" : "+v"(t2)); attn_unit(p, l, u, lds, t2); }
        for (int t = blockIdx.x; t < 768; t += gridDim.x) { int t2 = tid_; asm volatile("" : "+v"(t2)); rwkv_prep_tile(p, l, t, lds, t2); }
        { const int per = (int)gridDim.x >> 3; if ((int)blockIdx.x < per * 8) { const int first = (int)blockIdx.x >> 3; lru_run(p, l, (int)blockIdx.x & 7, first, per, (768 - first + per - 1) / per, 0, lds, tid_); } }
    } else if (k == 2) {
        for (int vb = blockIdx.x; vb < 256; vb += gridDim.x) {
#ifndef PROBE2
#define PROBE2 0
#endif
            if (vb < 192) { const int n = vb < 128 ? 1 : 4, b0 = vb < 128 ? vb : 128 + 4 * (vb - 128); for (int i = 0; i < n * (PROBE2 == 1 ? 2 : 1); ++i) rwkv_scan_task(p, l, b0 + (i % n), lds, tid_); }
            else { const int j = vb - 192; for (int rep = 0; rep < (PROBE2 == 2 ? 2 : 1); ++rep) lru_run(p, l, j & 7, j >> 3, 8, 96, 1, lds, tid_);
                for (int u = j; u < ATTN_IN_SCAN; u += 64) { int t2 = tid_; asm volatile("" : "+v"(t2)); attn_unit(p, l, u, lds, t2); } }
        }
    } else if (k == 3) { rwkv_final(p, l, tid_);
    } else if (k == 4) {
        pg8::Gemm g{mixbuf_of(p), (const bf16_t*)(p.ws + WS_WOUT), T, D, D}; pg8::StaticOrder S; S.init(T, D, (int)gridDim.x, (int)blockIdx.x);
        EpiBf16S E{(bf16_t*)(p.ws + WS_F), D, nullptr, 0};
        pg8::gemm_phase<EpiBf16S, pg8::StaticOrder>(lds, g, S, E, nullptr, tid_);
    } else if (k == 5) { rowpass_post(p, (const bf16_t*)(p.ws + WS_F), p.in[3] + l * D, 2, RS1, RS2, 0, tid_);
    } else if (k < 6 + 2 * FCH) {
        const int th = (k - 6) >> 1; const size_t rb = (size_t)th * FROWS;
        if (((k - 6) & 1) == 0) {
            pg8::Gemm g{XB + rb * D, (const bf16_t*)(p.ws + WS_WUP), FROWS, DFF, D}; pg8::StaticOrder S; S.init(FROWS, DFF, (int)gridDim.x, (int)blockIdx.x);
            EpiBf16S E{(bf16_t*)(p.ws + WS_U), DFF, nullptr, 1};
            pg8::gemm_phase<EpiBf16S, pg8::StaticOrder>(lds, g, S, E, nullptr, tid_);
        } else {
            pg8::Gemm g{(const bf16_t*)(p.ws + WS_U), (const bf16_t*)(p.ws + WS_WDN), FROWS, D, DFF}; pg8::StaticOrder S; S.init(FROWS, D, (int)gridDim.x, (int)blockIdx.x);
            EpiBf16S E{(bf16_t*)(p.ws + WS_F) + rb * D, D, nullptr, 0};
            pg8::gemm_phase<EpiBf16S, pg8::StaticOrder>(lds, g, S, E, nullptr, tid_);
        }
    } else {
        rowpass_post(p, (const bf16_t*)(p.ws + WS_F), p.in[5] + l * D, 2, RS2, RS1, l == 0 ? 0 : 2, tid_);
        if (l == 0) wprep_phase(p, 1, lds, tid_);
    }
}

__global__ void __launch_bounds__(512, 2) hymba_mega(Params p) {
    extern __shared__ __attribute__((aligned(16))) unsigned char smem[];
    LAS unsigned char* lds = (LAS unsigned char*)smem;
    volatile LAS unsigned* bst = (volatile LAS unsigned*)(lds + 131072);
    unsigned* bar = (unsigned*)(p.ws + WS_BAR);
    const bool coop = p.ph_hi - p.ph_lo > 1;
    if (coop) {
        if (threadIdx.x < 2) bst[threadIdx.x] = 0u;
        if (blockIdx.x == 0) for (int i = threadIdx.x; i < XCD_BAR_WORDS; i += 512) bar[i] = 0u;
        __syncthreads();
    }
    XcdBarrier xb; xb.bar = bar; xb.x = 0; xb.st = bst;
    bool posted = false;
    for (int ph = p.ph_lo; ph < p.ph_hi; ++ph) {
        int nrep = 1;
#if PROBE_MASK
        if ((ph > 0 && ((PROBE_MASK >> ((ph - 1) % PER)) & 1)) || (ph == 0 && ((PROBE_MASK >> 30) & 1))) nrep = 2;
#endif
        for (int rep = 0; rep < nrep; ++rep) {
            int tid_ = (int)__builtin_amdgcn_workitem_id_x(); asm volatile("" : "+v"(tid_));
            run_phase(p, ph, lds, tid_);
            if (ph + 1 < p.ph_hi || rep + 1 < nrep) {
                if (!posted) { cg::this_grid().sync(); xb = xcd_barrier_post(bar, bst, tid_ == 0); posted = true; }
                else xcd_barrier(xb, tid_ == 0);
            }
        }
    }
}

#ifndef PROBE_MASK
#define PROBE_MASK 0
#endif
#ifndef N_LAUNCH_PER_PHASE
#define N_LAUNCH_PER_PHASE 1
#endif
extern "C" void kernel_launch(void* const* d_in, const int* in_sizes, int n_in, void* d_out, int out_size, void* d_ws, size_t ws_size, hipStream_t stream) {
    static int grid = 0;
    if (grid == 0) {
        if (n_in != 30 || ws_size < WS_END) { fprintf(stderr, "kernel_launch: unexpected n_in %d / ws_size %zu\n", n_in, ws_size); grid = -1; return; }
        int dev = 0, cus = 0, per_cu = 0;
        hipGetDevice(&dev); hipDeviceGetAttribute(&cus, hipDeviceAttributeMultiprocessorCount, dev);
        if (hipFuncSetAttribute((const void*)hymba_mega, hipFuncAttributeMaxDynamicSharedMemorySize, LDS_BYTES) != hipSuccess) { fprintf(stderr, "kernel_launch: hipFuncSetAttribute failed\n"); grid = -1; return; }
        if (hipOccupancyMaxActiveBlocksPerMultiprocessor(&per_cu, (const void*)hymba_mega, 512, LDS_BYTES) != hipSuccess || per_cu < 1) { fprintf(stderr, "kernel_launch: occupancy query says %d\n", per_cu); per_cu = 1; }
        (void)hipGetLastError();
        grid = cus * (per_cu > 1 ? 1 : per_cu);
    }
    if (grid < 0) return;
    Params p{};
    for (int i = 0; i < 30; ++i) p.in[i] = (const float*)d_in[i];
    p.out = (float*)d_out; p.ws = (unsigned char*)d_ws;
#if N_LAUNCH_PER_PHASE
    for (int ph = 0; ph < N_PHASES; ++ph) { p.ph_lo = ph; p.ph_hi = ph + 1; hipLaunchKernelGGL(hymba_mega, dim3(grid), dim3(512), LDS_BYTES, stream, p); }
#else
    p.ph_lo = 0; p.ph_hi = N_PHASES;
    void* args[] = {&p};
    hipError_t e = hipLaunchCooperativeKernel((const void*)hymba_mega, dim3(grid), dim3(512), args, LDS_BYTES, stream);
    if (e != hipSuccess) fprintf(stderr, "kernel_launch: cooperative launch failed: %s (grid %d)\n", hipGetErrorString(e), grid);
#endif
}
```

```cpp
#include <hip/hip_runtime.h>
#include <hip/hip_cooperative_groups.h>
#include <cstdio>
namespace cg = cooperative_groups;

#define LAS __attribute__((address_space(3)))
typedef float f32x2 __attribute__((ext_vector_type(2)));
typedef unsigned u32x2 __attribute__((ext_vector_type(2)));
typedef _Float16 f16x4 __attribute__((ext_vector_type(4)));
typedef _Float16 f16x8 __attribute__((ext_vector_type(8)));
#define N_LAUNCH_PER_PHASE 0
#define PROBE_MASK 0
#define PROBE2 0
#define NCH 6
namespace pg8 {
#define PG8_LAS __attribute__((address_space(3)))
typedef unsigned short bf16_t;
typedef short bf16x8 __attribute__((ext_vector_type(8)));
typedef float f32x4 __attribute__((ext_vector_type(4)));
typedef unsigned u32x4 __attribute__((ext_vector_type(4)));
constexpr int BM = 256, BK = 64, HALF = 128, HTB = HALF * BK * 2  , STAGE_BYTES = 8 * HTB, NXCD = 8, WGM = 8;

__host__ __device__ __forceinline__ int lds_byte(int r, int c) { const int st = (r >> 4) * 2 + (c >> 5), rr = r & 15, cc = c & 31, ob = rr * 64 + cc * 2; return st * 1024 + (ob ^ (((ob >> 9) & 1) << 5)); }
__host__ __device__ __forceinline__ void stage_rc(int b, int& R, int& C) { const int st = b / 1024, sb = b % 1024, swz = sb ^ (((sb >> 9) & 1) << 5); R = (st >> 1) * 16 + swz / 64; C = (st & 1) * 32 + (swz % 64) / 2; }
__host__ __device__ __forceinline__ int perm32(int rho) { const int n = rho >> 4, i = rho & 15; return 8 * (i >> 2) + 4 * n + (i & 3); }

struct Unit { int pm, pn; };
struct Gemm { const bf16_t* A; const bf16_t* Bt; int M, N, K; };

struct StaticOrder {
    int nM, nN, nwg, G, c;
    __host__ __device__ void init(int M, int N, int G_, int c_) { nM = M / BM; nN = N / BM; nwg = nM * nN; G = G_; c = c_; }
    __host__ __device__ bool next(int i, Unit& u) const {
        const long L = (long)i * G + c; if (L >= nwg) return false;
        int wgid = (int)L; { const int q = nwg / NXCD, r = nwg % NXCD, xcd = wgid % NXCD, off = wgid / NXCD; wgid = (xcd < r ? xcd * (q + 1) : r * (q + 1) + (xcd - r) * q) + off; }
        const int nig = WGM * nN, gid = wgid / nig, fm = gid * WGM, gsz = (nM - fm) < WGM ? (nM - fm) : WGM;
        u.pm = fm + ((wgid % nig) % gsz); u.pn = (wgid % nig) / gsz; return true;
    }
    __device__ __forceinline__ void a_ready(const Unit&) const {}
    __device__ __forceinline__ void done(const Unit&) const {}
};
__device__ __forceinline__ unsigned cvt_pk_bf16(float lo, float hi) { unsigned r; asm volatile("v_cvt_pk_bf16_f32 %0, %1, %2" : "=v"(r) : "v"(lo), "v"(hi)); return r; }
template <class Epi, class Sched, bool STAMP = false>
__device__ __forceinline__ void gemm_phase(PG8_LAS unsigned char* lds, const Gemm g, const Sched& S, const Epi& E, unsigned long long* stamps, const int tid_) {
    const int tid = tid_, wid = __builtin_amdgcn_readfirstlane(tid >> 6), lane = tid & 63, wr = wid >> 2, wc = wid & 3, fr = lane & 15, fq = lane >> 4;
    const int K = g.K, nt = K / BK;
    int ts_lo = 0, ts_hi = 0, nts = 0; const unsigned long long rt_entry = STAMP ? (unsigned long long)wall_clock64() : 0ull;
#define PG8_STAMP() do { if (STAMP && wid == 0 && nts < 64) { const unsigned long long _c = (unsigned long long)clock64(); \
        ts_lo = (lane == nts) ? (int)(unsigned)_c : ts_lo; ts_hi = (lane == nts) ? (int)(unsigned)(_c >> 32) : ts_hi; ++nts; } } while (0)
    PG8_STAMP();
    unsigned voffA[2], voffB[2];
#pragma unroll
    for (int i = 0; i < 2; ++i) { int R, C; stage_rc(tid * 16 + i * 8192, R, C); const int Rb = Epi::PERM ? ((R & ~31) + perm32(R & 31)) : R;
        voffA[i] = (unsigned)(R * K + C) * 2u; voffB[i] = (unsigned)(Rb * K + C) * 2u; }
    const size_t kstep = (size_t)(BK * 2);
    const size_t hstep = (size_t)HALF * K * 2;
    const size_t tstep = 2 * hstep;
    const unsigned ldsw = (unsigned)wid * 1024u;
    const int aoff = lds_byte(wr * 64 + fr, fq * 8), boff = lds_byte(wc * 32 + fr, fq * 8);
#define PG8_SA(b, h) (((b) * 2 + (h)) * HTB)
#define PG8_SB(b, h) ((4 + (b) * 2 + (h)) * HTB)
#define PG8_STAGE(bufoff, gbase, voff) do { _Pragma("unroll") for (int _i = 0; _i < 2; ++_i) \
        __builtin_amdgcn_global_load_lds((const unsigned*)((const char*)(gbase) + (voff)[_i]), (PG8_LAS unsigned*)(lds + (bufoff) + ldsw + _i * 8192), 16, 0, 0); } while (0)
#define PG8_LDA(dst, b, h) do { _Pragma("unroll") for (int m = 0; m < 4; ++m) _Pragma("unroll") for (int k = 0; k < 2; ++k) dst[m][k] = *(const PG8_LAS bf16x8*)(lds + PG8_SA(b, h) + aoff + m * 2048 + k * 1024); } while (0)
#define PG8_LDB(dst, b, h) do { _Pragma("unroll") for (int n = 0; n < 2; ++n) _Pragma("unroll") for (int k = 0; k < 2; ++k) dst[n][k] = *(const PG8_LAS bf16x8*)(lds + PG8_SB(b, h) + boff + n * 2048 + k * 1024); } while (0)
#define PG8_MMA(ai, bj, At, Bt) do { __builtin_amdgcn_s_setprio(1); _Pragma("unroll") for (int m = 0; m < 4; ++m) _Pragma("unroll") for (int n = 0; n < 2; ++n) _Pragma("unroll") for (int k = 0; k < 2; ++k) \
        acc[ai][bj][m][n] = __builtin_amdgcn_mfma_f32_16x16x32_bf16(Bt[n][k], At[m][k], acc[ai][bj][m][n], 0, 0, 0); __builtin_amdgcn_s_setprio(0); } while (0)
#define PG8_WAIT_V(n) asm volatile("s_waitcnt vmcnt(" #n ")" ::: "memory")
#define PG8_WAIT_L(n) asm volatile("s_waitcnt lgkmcnt(" #n ")" ::: "memory")
#define PG8_BAR __builtin_amdgcn_s_barrier()
#define PG8_SCHED __builtin_amdgcn_sched_barrier(0)
    Unit cur, nxt; int ui = 0;
    if (!S.next(0, cur)) return;
    f32x4 acc[2][2][4][2];
#pragma unroll
    for (int a = 0; a < 2; ++a)
#pragma unroll
        for (int b = 0; b < 2; ++b)
#pragma unroll
            for (int m = 0; m < 4; ++m)
#pragma unroll
                for (int n = 0; n < 2; ++n) acc[a][b][m][n] = (f32x4){0.f, 0.f, 0.f, 0.f};
    bf16x8 At[4][2], B0[2][2], B1[2][2];
    const char* cA = (const char*)g.A + (size_t)cur.pm * tstep; const char* cB = (const char*)g.Bt + (size_t)cur.pn * tstep;
    S.a_ready(cur);
    PG8_STAGE(PG8_SB(0, 0), cB, voffB); PG8_STAGE(PG8_SA(0, 0), cA, voffA); PG8_STAGE(PG8_SB(0, 1), cB + hstep, voffB); PG8_STAGE(PG8_SA(0, 1), cA + hstep, voffA);
    if (wr == 1) PG8_BAR;
    PG8_WAIT_V(4); PG8_BAR;
    PG8_STAGE(PG8_SB(1, 0), cB + kstep, voffB); PG8_STAGE(PG8_SA(1, 0), cA + kstep, voffA); PG8_STAGE(PG8_SB(1, 1), cB + hstep + kstep, voffB);
    PG8_WAIT_V(6); PG8_BAR;
    PG8_STAMP();
    for (;;) {
        const bool has_next = S.next(ui + 1, nxt);
        const char* nA = has_next ? (const char*)g.A + (size_t)nxt.pm * tstep : cA; const char* nB = has_next ? (const char*)g.Bt + (size_t)nxt.pn * tstep : cB;
        for (int t = 0; t < nt; t += 2) {
            const bool last = (t == nt - 2);
            const char* a1 = cA + (size_t)(t + 1) * kstep;
            const char* a2 = last ? nA : cA + (size_t)(t + 2) * kstep; const char* b2 = last ? nB : cB + (size_t)(t + 2) * kstep;
            const char* a3 = a2 + kstep; const char* b3 = b2 + kstep;
            if (last && has_next) S.a_ready(nxt);
            PG8_LDB(B0, 0, 0); PG8_SCHED; PG8_LDA(At, 0, 0); PG8_STAGE(PG8_SA(1, 1), a1 + hstep, voffA);
            PG8_WAIT_L(8); PG8_BAR; PG8_WAIT_L(0); PG8_MMA(0, 0, At, B0); PG8_BAR; PG8_SCHED;
            PG8_LDB(B1, 0, 1); PG8_STAGE(PG8_SB(0, 0), b2, voffB);
            PG8_BAR; PG8_WAIT_L(0); PG8_MMA(0, 1, At, B1); PG8_BAR;
            PG8_LDA(At, 0, 1); PG8_STAGE(PG8_SA(0, 0), a2, voffA);
            PG8_BAR; PG8_WAIT_L(0); PG8_MMA(1, 0, At, B0); PG8_BAR; PG8_SCHED;
            PG8_STAGE(PG8_SB(0, 1), b2 + hstep, voffB);
            PG8_WAIT_V(6); PG8_BAR; PG8_MMA(1, 1, At, B1); PG8_BAR;
            PG8_LDB(B0, 1, 0); PG8_SCHED; PG8_LDA(At, 1, 0); PG8_STAGE(PG8_SA(0, 1), a2 + hstep, voffA);
            PG8_WAIT_L(8); PG8_BAR; PG8_WAIT_L(0); PG8_MMA(0, 0, At, B0); PG8_BAR; PG8_SCHED;
            PG8_LDB(B1, 1, 1); PG8_STAGE(PG8_SB(1, 0), b3, voffB);
            PG8_BAR; PG8_WAIT_L(0); PG8_MMA(0, 1, At, B1); PG8_BAR;
            PG8_LDA(At, 1, 1); PG8_STAGE(PG8_SA(1, 0), a3, voffA);
            PG8_BAR; PG8_WAIT_L(0); PG8_MMA(1, 0, At, B0); PG8_BAR; PG8_SCHED;
            PG8_STAGE(PG8_SB(1, 1), b3 + hstep, voffB);
            PG8_WAIT_V(6); PG8_BAR; PG8_MMA(1, 1, At, B1); PG8_BAR;
        }
        PG8_STAMP();
        if constexpr (!Epi::AFTER_DRAIN) { E(acc, cur, wr, wc, fr, fq); S.done(cur); }
        PG8_STAMP();
        if (!has_next) break;
#pragma unroll
        for (int a = 0; a < 2; ++a)
#pragma unroll
            for (int b = 0; b < 2; ++b)
#pragma unroll
                for (int m = 0; m < 4; ++m)
#pragma unroll
                    for (int n = 0; n < 2; ++n) acc[a][b][m][n] = (f32x4){0.f, 0.f, 0.f, 0.f};
        cur = nxt; cA = nA; cB = nB; ++ui;
    }
    PG8_WAIT_V(0);
    if (wr == 0) PG8_BAR;
    PG8_BAR;
    if constexpr (Epi::AFTER_DRAIN) { E.fused(acc, cur, wr, wc, fr, fq, lds, wid, lane); S.done(cur); }
    PG8_STAMP();
    if (STAMP && wid == 0) { stamps[lane] = lane < nts ? (((unsigned long long)(unsigned)ts_hi << 32) | (unsigned)ts_lo) : 0ull;
        if (lane == 62) stamps[62] = rt_entry; if (lane == 63) stamps[63] = (unsigned long long)wall_clock64(); }
#undef PG8_STAMP
#undef PG8_SA
#undef PG8_SB
#undef PG8_STAGE
#undef PG8_LDA
#undef PG8_LDB
#undef PG8_MMA
#undef PG8_WAIT_V
#undef PG8_WAIT_L
#undef PG8_BAR
#undef PG8_SCHED
}
}
#define XB_TMO      128
#define XB_XCNT(j)  (256  + 64 * (j))
#define XB_XSUB(j)  (1280 + 64 * (j))
#define XB_XGEN(j)  (2304 + 64 * (j))
#define XB_TOP      3328
#define XB_TOPGEN   3392
#define XCD_BAR_WORDS 3456
#define XB_SPIN_CAP (1u << 18)

__device__ __forceinline__ unsigned xb_ld(unsigned* p)              { return __hip_atomic_load(p, __ATOMIC_RELAXED, __HIP_MEMORY_SCOPE_AGENT); }
__device__ __forceinline__ unsigned xb_add(unsigned* p, unsigned v) { return __hip_atomic_fetch_add(p, v, __ATOMIC_RELAXED, __HIP_MEMORY_SCOPE_AGENT); }
__device__ __forceinline__ unsigned xb_xcc_id() { return (unsigned)__builtin_amdgcn_s_getreg((3 << 11) | 20) & 0xFu; }
#define XB_SPIN(cond, bar) do { unsigned _sp = 0; while (cond) { __builtin_amdgcn_s_sleep(1); \
    if ((++_sp & 255u) == 0u) { if (xb_ld(&(bar)[XB_TMO])) break; if (_sp > XB_SPIN_CAP) { atomicAdd(&(bar)[XB_TMO], 1u); break; } } } } while (0)

struct XcdBarrier {
    unsigned* bar; unsigned x;
    volatile LAS unsigned* st;
};

__device__ __forceinline__ XcdBarrier xcd_barrier_post(unsigned* bar, volatile LAS unsigned* st, const bool tid0_) {
    XcdBarrier b; b.bar = bar; b.x = xb_xcc_id(); b.st = st;
    if (tid0_) (void)xb_add(&bar[XB_XCNT(b.x)], 1u);
    return b;
}
__device__ __forceinline__ void xcd_barrier_complete(unsigned* bar, unsigned x, unsigned& nloc, unsigned& nx) {
    const unsigned G = gridDim.x * gridDim.y * gridDim.z;
    unsigned sum, cnt, mine, sp = 0u;
    for (;;) {
        sum = 0u; cnt = 0u; mine = 0u;
#pragma unroll
        for (unsigned j = 0; j < 16; ++j) { const unsigned c = xb_ld(&bar[XB_XCNT(j)]); sum += c; cnt += (c > 0u) ? 1u : 0u; mine = (j == x) ? c : mine; }
        if (sum == G) break;
        __builtin_amdgcn_s_sleep(1);
        if ((++sp & 255u) == 0u) { if (xb_ld(&bar[XB_TMO])) break; if (sp > XB_SPIN_CAP) { atomicAdd(&bar[XB_TMO], 1u); break; } }
    }
    nloc = mine > 0u ? mine : 1u; nx = cnt > 0u ? cnt : 1u;
}

__device__ __forceinline__ void xcd_barrier(const XcdBarrier& b, const bool tid0_) {
    asm volatile("s_waitcnt vmcnt(0)" ::: "memory");
    __syncthreads();
    if (tid0_) {
        unsigned* bar = b.bar;
        __builtin_amdgcn_s_waitcnt(0);
        unsigned nloc = b.st[0], nx = b.st[1];
        if (nloc == 0u) { xcd_barrier_complete(bar, b.x, nloc, nx); b.st[0] = nloc; b.st[1] = nx; }
        const unsigned old = xb_add(&bar[XB_XSUB(b.x)], 1u);
        const unsigned gen = old / nloc;
        if (old + 1u == (gen + 1u) * nloc) {
            __builtin_amdgcn_fence(__ATOMIC_RELEASE, "agent");
            asm volatile("s_waitcnt vmcnt(0)" ::: "memory");
            const unsigned og = xb_add(&bar[XB_TOP], 1u);
            const unsigned tg = og / nx;
            if (og + 1u == (tg + 1u) * nx) xb_add(&bar[XB_TOPGEN], 1u);
            else XB_SPIN(xb_ld(&bar[XB_TOPGEN]) == tg, bar);
            __builtin_amdgcn_fence(__ATOMIC_ACQUIRE, "agent");
            xb_add(&bar[XB_XGEN(b.x)], 1u);
            asm volatile("s_waitcnt vmcnt(0)" ::: "memory");
        } else {
            XB_SPIN(xb_ld(&bar[XB_XGEN(b.x)]) == gen, bar);
            __builtin_amdgcn_fence(__ATOMIC_ACQUIRE, "agent");
            asm volatile("s_waitcnt vmcnt(0)" ::: "memory");
        }
    }
    __syncthreads();
}

using pg8::bf16_t; using pg8::bf16x8; using pg8::f32x4; using pg8::u32x4;

constexpr int T = 49152, D = 2048, NP = 4608, DFF = 8192;
constexpr int P_K = 1024, P_V = 1280, P_LX = 1536, P_LG = 2048, P_RW = 2560;
constexpr size_t MiB = (size_t)1 << 20;
constexpr size_t WS_WIN = 0, WS_WOUT = WS_WIN + (size_t)NP * D * 2, WS_WUP = WS_WOUT + (size_t)D * D * 2, WS_WDN = WS_WUP + (size_t)DFF * D * 2;
constexpr size_t WS_SMALL = 90 * MiB, WS_LB = WS_SMALL, WS_W2T = WS_SMALL + 262144, WS_A2T = WS_SMALL + 393216, WS_G2T = WS_SMALL + 524288,
                 WS_RS1 = WS_SMALL + 1048576, WS_RS2 = WS_SMALL + 1310720, WS_BAR = WS_SMALL + 1572864;
constexpr size_t WS_XB = 92 * MiB, WS_P = 284 * MiB, WS_PREP = 716 * MiB, WS_YFB = 908 * MiB, WS_AGG = 1004 * MiB, WS_END = 1012 * MiB;
constexpr size_t WS_F = WS_P, WS_U = 476 * MiB;
constexpr int LDS_BYTES = 131072 + 16;

struct Params { const float* in[30]; float* out; unsigned char* ws; int ph_lo, ph_hi; };

#define DI __device__ __forceinline__
DI pg8::bf16_t* mixbuf_of(const Params& p) { return (pg8::bf16_t*)p.out + (size_t)T * D; }
DI unsigned pk_bf16(float lo, float hi) { unsigned r; asm("v_cvt_pk_bf16_f32 %0, %1, %2" : "=v"(r) : "v"(lo), "v"(hi)); return r; }
DI float bf_lo(unsigned w) { return __uint_as_float(w << 16); }
DI float bf_hi(unsigned w) { return __uint_as_float(w & 0xffff0000u); }
DI float bf_at(const u32x4& v, int j) { const unsigned w = v[j >> 1]; return (j & 1) ? bf_hi(w) : bf_lo(w); }
DI float sigm(float x) { return __builtin_amdgcn_rcpf(1.0f + __builtin_amdgcn_exp2f(-1.4426950408889634f * x)); }
DI float tanh_fast(float x) { return 1.0f - 2.0f * __builtin_amdgcn_rcpf(1.0f + __builtin_amdgcn_exp2f(2.8853900817779268f * x)); }
DI float exp_fast(float x) { return __builtin_amdgcn_exp2f(1.4426950408889634f * x); }
DI void seq_of(int row, int& s0, int& len) { if (row < 16384) { s0 = row & ~2047; len = 2048; } else { s0 = 16384 + ((row - 16384) & ~8191); len = 8192; } }
DI f32x4 mfma16(bf16x8 a, bf16x8 b, f32x4 c) { return __builtin_amdgcn_mfma_f32_16x16x32_bf16(a, b, c, 0, 0, 0); }

struct EpiBf16S {
    static constexpr bool PERM = true, AFTER_DRAIN = false;
    bf16_t* O; int ldc; const float* rs; int act;
    __device__ __forceinline__ void operator()(const f32x4 (&acc)[2][2][4][2], const pg8::Unit& u, int wr, int wc, int fr, int fq) const {
        const int row0 = u.pm * 256 + wr * 64 + fr, col0 = u.pn * 256 + wc * 32 + 8 * fq;
#pragma unroll
        for (int ai = 0; ai < 2; ++ai)
#pragma unroll
            for (int m = 0; m < 4; ++m) { const int row = row0 + ai * 128 + m * 16; const float s = rs ? rs[row] : 1.0f; bf16_t* rowp = O + (size_t)row * ldc + col0;
#pragma unroll
                for (int bj = 0; bj < 2; ++bj) { f32x4 v0 = acc[ai][bj][m][0] * s, v1 = acc[ai][bj][m][1] * s;
                    if (act) {
#pragma unroll
                        for (int j = 0; j < 4; ++j) { const float a = fmaxf(v0[j], 0.f), b = fmaxf(v1[j], 0.f); v0[j] = a * a; v1[j] = b * b; } }
                    u32x4 w; w.x = pk_bf16(v0[0], v0[1]); w.y = pk_bf16(v0[2], v0[3]); w.z = pk_bf16(v1[0], v1[1]); w.w = pk_bf16(v1[2], v1[3]);
                    *(u32x4*)(rowp + bj * 128) = w; } }
    }
};
struct EpiF32S {
    static constexpr bool PERM = false, AFTER_DRAIN = false;
    float* C; int ldc;
    __device__ __forceinline__ void operator()(const f32x4 (&acc)[2][2][4][2], const pg8::Unit& u, int wr, int wc, int fr, int fq) const {
        const int row0 = u.pm * 256 + wr * 64 + fr, col0 = u.pn * 256 + wc * 32 + 4 * fq;
#pragma unroll
        for (int ai = 0; ai < 2; ++ai)
#pragma unroll
            for (int m = 0; m < 4; ++m) { float* rowp = C + (size_t)(row0 + ai * 128 + m * 16) * ldc + col0;
#pragma unroll
                for (int bj = 0; bj < 2; ++bj)
#pragma unroll
                    for (int n = 0; n < 2; ++n) *(f32x4*)(rowp + bj * 128 + n * 16) = acc[ai][bj][m][n]; }
    }
};

struct WTile { const float* W; bf16_t* Wt; const float* gain; int ldw, k0, srcn0, ldt, dstn0; };
DI WTile wtile_of(int id, const float* w_in, const float* w_out, const float* w_up, const float* w_dn, const float* g_mix, const float* g_ffn, unsigned char* ws) {
    WTile t;
    if (id < 2304) { const int kt = id & 31, nt = id >> 5, dn = nt * 64; t = WTile{w_in, (bf16_t*)(ws + WS_WIN), g_mix, 4480, kt * 64, dn < 1536 ? dn + 2944 : (dn < 4480 ? dn - 1536 : -1), D, dn}; }
    else if (id < 3328) { const int j = id - 2304, kt = j & 31, nt = j >> 5; t = WTile{w_out, (bf16_t*)(ws + WS_WOUT), nullptr, D, kt * 64, nt * 64, D, nt * 64}; }
    else if (id < 7424) { const int j = id - 3328, kt = j & 31, nt = j >> 5; t = WTile{w_up, (bf16_t*)(ws + WS_WUP), g_ffn, DFF, kt * 64, nt * 64, D, nt * 64}; }
    else { const int j = id - 7424, kt = j & 127, nt = j >> 7; t = WTile{w_dn, (bf16_t*)(ws + WS_WDN), nullptr, D, kt * 64, nt * 64, DFF, nt * 64}; }
    return t; }
DI void wtile_load(const WTile& t, int tid, float4 (&v)[2]) {
#pragma unroll
    for (int it = 0; it < 2; ++it) { const int kk = (tid >> 4) + 32 * it, n4 = (tid & 15) * 4; v[it] = make_float4(0.f, 0.f, 0.f, 0.f);
        if (t.srcn0 >= 0) { v[it] = *(const float4*)(t.W + (size_t)(t.k0 + kk) * t.ldw + t.srcn0 + n4); if (t.gain) { const float g = t.gain[t.k0 + kk]; v[it].x *= g; v[it].y *= g; v[it].z *= g; v[it].w *= g; } } } }
__device__ void wprep_phase(const Params& p, int l, LAS unsigned char* lds, const int tid_) {
    LAS float* tile = (LAS float*)lds; const int tid = tid_;
    const float* w_in = p.in[6] + (size_t)l * D * 4480; const float* w_out = p.in[7] + (size_t)l * D * D;
    const float* w_up = p.in[28] + (size_t)l * D * DFF; const float* w_dn = p.in[29] + (size_t)l * DFF * D;
    const float* g_mix = p.in[2] + l * D; const float* g_ffn = p.in[4] + l * D;
    float4 v[2], vn[2];
    int id = blockIdx.x;
    WTile t = wtile_of(id < 11520 ? id : 0, w_in, w_out, w_up, w_dn, g_mix, g_ffn, p.ws);
    if (id < 11520) wtile_load(t, tid, v);
    for (; id < 11520; id += gridDim.x) {
        const int idn = id + gridDim.x;
        const WTile tn = wtile_of(idn < 11520 ? idn : 0, w_in, w_out, w_up, w_dn, g_mix, g_ffn, p.ws);
        if (idn < 11520) wtile_load(tn, tid, vn);
#pragma unroll
        for (int it = 0; it < 2; ++it) { const int kk = (tid >> 4) + 32 * it, n4 = (tid & 15) * 4;
            tile[kk * 65 + n4 + 0] = v[it].x; tile[kk * 65 + n4 + 1] = v[it].y; tile[kk * 65 + n4 + 2] = v[it].z; tile[kk * 65 + n4 + 3] = v[it].w; }
        __syncthreads();
        { const int nn = tid >> 3, kc = tid & 7; float e[8];
#pragma unroll
          for (int j = 0; j < 8; ++j) e[j] = tile[(8 * kc + j) * 65 + nn];
          u32x4 w; w.x = pk_bf16(e[0], e[1]); w.y = pk_bf16(e[2], e[3]); w.z = pk_bf16(e[4], e[5]); w.w = pk_bf16(e[6], e[7]);
          *(u32x4*)(t.Wt + (size_t)(t.dstn0 + nn) * t.ldt + t.k0 + 8 * kc) = w; }
        __syncthreads();
        t = tn; v[0] = vn[0]; v[1] = vn[1];
    }
    const int gt = blockIdx.x * 512 + tid_, gs = gridDim.x * 512;
    bf16_t* LB = (bf16_t*)(p.ws + WS_LB); bf16_t* W2T = (bf16_t*)(p.ws + WS_W2T); bf16_t* A2T = (bf16_t*)(p.ws + WS_A2T); bf16_t* G2T = (bf16_t*)(p.ws + WS_G2T);
    const float* wa = p.in[10] + (size_t)l * 65536; const float* wx = p.in[12] + (size_t)l * 65536;
    for (int e = gt; e < 131072; e += gs) { const int i = e & 63, c = (e >> 6) & 63, gate = (e >> 12) & 1, d = (e >> 13) & 1, n = e >> 14;
        const float v = (gate ? wx : wa)[((d * 8 + n) * 64 + i) * 64 + c]; LB[e] = (bf16_t)(pk_bf16(v, 0.f) & 0xffffu); }
    const float* w2 = p.in[17] + (size_t)l * 65536; const float* a2 = p.in[19] + (size_t)l * 65536; const float* g2 = p.in[20] + (size_t)l * 65536;
    for (int e = gt; e < 65536; e += gs) { const int rk = e & 63, c = (e >> 6) & 511, d = e >> 15;
        W2T[e] = (bf16_t)(pk_bf16(w2[(d * 64 + rk) * 512 + c], 0.f) & 0xffffu); A2T[e] = (bf16_t)(pk_bf16(a2[(d * 64 + rk) * 512 + c], 0.f) & 0xffffu); }
    for (int e = gt; e < 65536; e += gs) { const int rk = e & 127, c = e >> 7; G2T[e] = (bf16_t)(pk_bf16(g2[rk * 512 + c], 0.f) & 0xffffu); }
}

DI float wave_sum(float v) {
#pragma unroll
    for (int o = 32; o >= 1; o >>= 1) v += __shfl_xor(v, o);
    return v; }
__device__ void rowpass0(const Params& p, const int tid_) {
    const int lane = tid_ & 63, gw = blockIdx.x * 8 + (tid_ >> 6), nw = gridDim.x * 8;
    bf16_t* XB = (bf16_t*)(p.ws + WS_XB); float* RS1 = (float*)(p.ws + WS_RS1);
    for (int row = gw; row < T; row += nw) {
        const float* src = row < 16384 ? p.in[0] + (size_t)row * D : p.in[1] + (size_t)(row - 16384) * D;
        float ss = 0.f; float4 v[8];
#pragma unroll
        for (int i = 0; i < 8; ++i) { v[i] = ((const float4*)src)[lane + 64 * i]; ss += v[i].x * v[i].x + v[i].y * v[i].y + v[i].z * v[i].z + v[i].w * v[i].w; }
        ss = wave_sum(ss);
        const float rs = rsqrtf(ss * (1.0f / 2048.0f) + 1e-6f);
#pragma unroll
        for (int i = 0; i < 8; ++i) { u32x2 w; w.x = pk_bf16(v[i].x * rs, v[i].y * rs); w.y = pk_bf16(v[i].z * rs, v[i].w * rs); *(u32x2*)(XB + (size_t)row * D + 4 * (lane + 64 * i)) = w; }
        if (lane == 0) RS1[row] = rs;
    }
}
__device__ void rowpass_post(const Params& p, const bf16_t* Y, const float* gpost, int xmode, const float* RSin, float* RS, int outmode, const int tid_) {
    const int lane = tid_ & 63, gw = blockIdx.x * 8 + (tid_ >> 6), nw = gridDim.x * 8;
    bf16_t* XB = (bf16_t*)(p.ws + WS_XB); bf16_t* XS = (bf16_t*)p.out;
    float g[4][8];
#pragma unroll
    for (int i = 0; i < 4; ++i)
#pragma unroll
        for (int j = 0; j < 8; ++j) g[i][j] = gpost[8 * (lane + 64 * i) + j];
    for (int row = gw; row < T; row += nw) {
        float y[4][8], x[4][8]; float ss = 0.f;
#pragma unroll
        for (int i = 0; i < 4; ++i) { const size_t off = (size_t)row * D + 8 * (lane + 64 * i);
            const u32x4 yv = *(const u32x4*)(Y + off);
#pragma unroll
            for (int j = 0; j < 8; ++j) { y[i][j] = bf_at(yv, j); ss += y[i][j] * y[i][j]; }
            if (xmode == 0) { const float* xs = row < 16384 ? p.in[0] + off : p.in[1] + (off - (size_t)16384 * D);
                const float4 a = *(const float4*)xs, b = *(const float4*)(xs + 4);
                x[i][0] = a.x; x[i][1] = a.y; x[i][2] = a.z; x[i][3] = a.w; x[i][4] = b.x; x[i][5] = b.y; x[i][6] = b.z; x[i][7] = b.w; }
            else { const u32x4 xv = *(const u32x4*)((xmode == 1 ? XS : XB) + off); const float us = xmode == 2 ? 1.0f / RSin[row] : 1.0f;
#pragma unroll
                for (int j = 0; j < 8; ++j) x[i][j] = bf_at(xv, j) * us; } }
        ss = wave_sum(ss);
        const float ry = rsqrtf(ss * (1.0f / 2048.0f) + 1e-6f);
        float s2 = 0.f;
#pragma unroll
        for (int i = 0; i < 4; ++i)
#pragma unroll
            for (int j = 0; j < 8; ++j) { x[i][j] += y[i][j] * ry * g[i][j]; s2 += x[i][j] * x[i][j]; }
        s2 = wave_sum(s2);
        const float rsn = rsqrtf(s2 * (1.0f / 2048.0f) + 1e-6f);
#pragma unroll
        for (int i = 0; i < 4; ++i) { const size_t off = (size_t)row * D + 8 * (lane + 64 * i);
            if (outmode == 2) { *(float4*)(p.out + off) = make_float4(x[i][0], x[i][1], x[i][2], x[i][3]); *(float4*)(p.out + off + 4) = make_float4(x[i][4], x[i][5], x[i][6], x[i][7]); }
            else { u32x4 w; w.x = pk_bf16(x[i][0] * rsn, x[i][1] * rsn); w.y = pk_bf16(x[i][2] * rsn, x[i][3] * rsn); w.z = pk_bf16(x[i][4] * rsn, x[i][5] * rsn); w.w = pk_bf16(x[i][6] * rsn, x[i][7] * rsn);
                *(u32x4*)(XB + off) = w;
                if (outmode == 1) { u32x4 u; u.x = pk_bf16(x[i][0], x[i][1]); u.y = pk_bf16(x[i][2], x[i][3]); u.z = pk_bf16(x[i][4], x[i][5]); u.w = pk_bf16(x[i][6], x[i][7]); *(u32x4*)(XS + off) = u; } } }
        if (outmode != 2 && lane == 0) RS[row] = rsn;
    }
}

__device__ void attn_unit(const Params& p, int l, int unit, LAS unsigned char* lds, const int tid_) {
    const int tid = tid_, lane = tid & 63, w = tid >> 6, r = lane & 15, q = lane >> 4;
    constexpr int NH = 1; const int qb = unit >> 3, hq0 = unit & 7, kvh = hq0 >> 2;
    const int g0 = qb * 128; int s0, len; seq_of(g0, s0, len);
    const bf16_t* P = (const bf16_t*)(p.ws + WS_P); bf16_t* MB = mixbuf_of(p);
    LAS bf16_t* Ks = (LAS bf16_t*)lds;
    LAS bf16_t* Vt = (LAS bf16_t*)(lds + 34816);
    LAS float* btab = (LAS float*)(lds + 69632);
    const int ql = 16 * w + r;
    __syncthreads();
    {
        const int rel = tid - 256, n = rel < 0 ? -rel : rel;
        const int bkt = (rel > 0 ? 16 : 0) + (n < 8 ? n : n < 12 ? 8 : n < 16 ? 9 : n < 23 ? 10 : n < 32 ? 11 : n < 46 ? 12 : n < 64 ? 13 : n < 91 ? 14 : 15);
#pragma unroll
        for (int hh = 0; hh < NH; ++hh) { const float v = n <= 128 ? p.in[27][bkt * 8 + hq0 + hh] : -1e30f;
#pragma unroll
            for (int c = 0; c < 4; ++c) btab[(hh * 4 + c) * 520 + tid + c] = v; } }
    bf16x8 qf[NH][4];
#pragma unroll
    for (int hh = 0; hh < NH; ++hh)
#pragma unroll
        for (int ks = 0; ks < 4; ++ks) qf[hh][ks] = *(const bf16x8*)(P + (size_t)(g0 + ql) * NP + (hq0 + hh) * 128 + 32 * ks + 8 * q);
    float m[NH], lsum[NH]; f32x4 o[NH][8];
#pragma unroll
    for (int hh = 0; hh < NH; ++hh) { m[hh] = p.in[26][l * 8 + hq0 + hh]; lsum[hh] = q == 0 ? 1.0f : 0.0f;
#pragma unroll
        for (int dt = 0; dt < 8; ++dt) o[hh][dt] = (f32x4){0.f, 0.f, 0.f, 0.f}; }
    const float scale = 0.08838834764831845f;
    u32x4 kreg[4], vreg[4];
    const int kb_lo = (g0 - 128 >= s0) ? 0 : 1, kb_hi = (g0 + 128 < s0 + len) ? 2 : 1;
#define AT_FETCH(kbi_) do { const int gk_ = g0 + ((kbi_) - 1) * 128; \
        _Pragma("unroll") for (int i = 0; i < 4; ++i) { const int id = tid + 512 * i; kreg[i] = *(const u32x4*)(P + (size_t)(gk_ + (id >> 4)) * NP + P_K + kvh * 128 + 8 * (id & 15)); } \
        _Pragma("unroll") for (int i = 0; i < 2; ++i) { const int id = tid + 512 * i, k0_ = 2 * (id & 63), dc_ = id >> 6; \
            vreg[2 * i] = *(const u32x4*)(P + (size_t)(gk_ + k0_) * NP + P_V + kvh * 128 + 8 * dc_); vreg[2 * i + 1] = *(const u32x4*)(P + (size_t)(gk_ + k0_ + 1) * NP + P_V + kvh * 128 + 8 * dc_); } } while (0)
    AT_FETCH(kb_lo);
#pragma unroll 1
    for (int kbi = kb_lo; kbi <= kb_hi; ++kbi) {
        __syncthreads();
#pragma unroll
        for (int i = 0; i < 4; ++i) { const int id = tid + 512 * i; *(LAS u32x4*)(Ks + (id >> 4) * 136 + 8 * (id & 15)) = kreg[i]; }
#pragma unroll
        for (int i = 0; i < 2; ++i) { const int id = tid + 512 * i, kp = id & 63, dc = id >> 6, k0 = 2 * kp, kin = k0 & 31;
            const int pos = (k0 & ~31) + (kin < 16 ? 8 * (kin >> 2) + (kin & 3) : 8 * ((kin - 16) >> 2) + 4 + (kin & 3));
            const u32x4 va = vreg[2 * i], vb = vreg[2 * i + 1];
#pragma unroll
            for (int j = 0; j < 4; ++j) { *(LAS unsigned*)(Vt + (8 * dc + 2 * j) * 136 + pos) = (va[j] & 0xffffu) | (vb[j] << 16);
                                          *(LAS unsigned*)(Vt + (8 * dc + 2 * j + 1) * 136 + pos) = (va[j] >> 16) | (vb[j] & 0xffff0000u); } }
        __syncthreads();
        if (kbi < kb_hi) AT_FETCH(kbi + 1);
        bf16x8 pf[NH][4];
        const int bidx = (kbi - 1) * 128 + 4 * q - ql + 256 + (ql & 3);
#pragma unroll
        for (int hh = 0; hh < NH; ++hh) {
            f32x4 s[8];
#pragma unroll
            for (int kt = 0; kt < 8; ++kt) { f32x4 acc = (f32x4){0.f, 0.f, 0.f, 0.f};
#pragma unroll
                for (int ks = 0; ks < 4; ++ks) { const bf16x8 a = *(const LAS bf16x8*)(Ks + (16 * kt + r) * 136 + 32 * ks + 8 * q); acc = mfma16(a, qf[hh][ks], acc); }
                s[kt] = acc; }
            const LAS float* bt = btab + (hh * 4 + (ql & 3)) * 520 + bidx;
            float mx = -1e30f;
#pragma unroll
            for (int kt = 0; kt < 8; ++kt) { const f32x4 bv = *(const LAS f32x4*)(bt + 16 * kt);
#pragma unroll
                for (int i = 0; i < 4; ++i) { const float v = s[kt][i] * scale + bv[i]; s[kt][i] = v; mx = fmaxf(mx, v); } }
            mx = fmaxf(mx, __shfl_xor(mx, 16)); mx = fmaxf(mx, __shfl_xor(mx, 32));
            const float mn = fmaxf(m[hh], mx), alpha = exp_fast(m[hh] - mn); m[hh] = mn;
            float ps = 0.f;
#pragma unroll
            for (int kt = 0; kt < 8; ++kt)
#pragma unroll
                for (int i = 0; i < 4; ++i) { const float pv = exp_fast(s[kt][i] - mn); s[kt][i] = pv; ps += pv; }
            lsum[hh] = lsum[hh] * alpha + ps;
#pragma unroll
            for (int dt = 0; dt < 8; ++dt) o[hh][dt] *= alpha;
#pragma unroll
            for (int kk = 0; kk < 4; ++kk) { u32x4 pw; pw.x = pk_bf16(s[2 * kk][0], s[2 * kk][1]); pw.y = pk_bf16(s[2 * kk][2], s[2 * kk][3]);
                pw.z = pk_bf16(s[2 * kk + 1][0], s[2 * kk + 1][1]); pw.w = pk_bf16(s[2 * kk + 1][2], s[2 * kk + 1][3]); pf[hh][kk] = __builtin_bit_cast(bf16x8, pw); }
            asm volatile("" ::: "memory");
        }
#pragma unroll
        for (int kk = 0; kk < 4; ++kk)
#pragma unroll
            for (int dt = 0; dt < 8; ++dt) { const bf16x8 vf = *(const LAS bf16x8*)(Vt + (16 * dt + r) * 136 + 32 * kk + 8 * q);
                o[0][dt] = mfma16(vf, pf[0][kk], o[0][dt]); }
    }
#undef AT_FETCH
#pragma unroll
    for (int hh = 0; hh < NH; ++hh) {
        float lt = lsum[hh]; lt += __shfl_xor(lt, 16); lt += __shfl_xor(lt, 32);
        const float inv = 1.0f / lt;
        bf16_t* dst = MB + (size_t)(g0 + ql) * D + 1024 + (hq0 + hh) * 128 + 4 * q;
#pragma unroll
        for (int dt = 0; dt < 8; ++dt) { u32x2 wv; wv.x = pk_bf16(o[hh][dt][0] * inv, o[hh][dt][1] * inv); wv.y = pk_bf16(o[hh][dt][2] * inv, o[hh][dt][3] * inv); *(u32x2*)(dst + 16 * dt) = wv; }
    }
}

__device__ void rwkv_prep_tile(const Params& p, int l, int tile, LAS unsigned char* lds, const int tid_) {
    const int tid = tid_, lane = tid & 63, w = tid >> 6, r = lane & 15, q = lane >> 4;
    const int t0 = tile * 64; int s0, len; seq_of(t0, s0, len);
    LAS bf16_t* raw = (LAS bf16_t*)lds;
    LAS bf16_t* A = (LAS bf16_t*)(lds + 50688);
    const bf16_t* P = (const bf16_t*)(p.ws + WS_P); bf16_t* MB = mixbuf_of(p); _Float16* PREP = (_Float16*)(p.ws + WS_PREP);
    const bf16_t* W2T = (const bf16_t*)(p.ws + WS_W2T); const bf16_t* A2T = (const bf16_t*)(p.ws + WS_A2T); const bf16_t* G2T = (const bf16_t*)(p.ws + WS_G2T);
    const float* mu = p.in[15] + l * 1920 + 1536; const float* w0 = p.in[16] + l * 1024; const float* a0 = p.in[18] + l * 1024;
    __syncthreads();
    for (int id = tid; id < 66 * 48; id += 512) { const int row = id / 48, ch = id % 48, gr = t0 - 1 + row; u32x4 v = (u32x4){0u, 0u, 0u, 0u};
        if (gr >= s0 && gr < s0 + len) v = *(const u32x4*)(P + (size_t)gr * NP + P_RW + 1536 + 8 * ch);
        *(LAS u32x4*)(raw + row * 384 + 8 * ch) = v; }
    __syncthreads();
    for (int id = tid; id < 64 * 48; id += 512) { const int tok = id / 48, ch = id % 48, col = 8 * ch;
        const u32x4 a = *(const LAS u32x4*)(raw + tok * 384 + col), b = *(const LAS u32x4*)(raw + (tok + 1) * 384 + col), c = *(const LAS u32x4*)(raw + (tok + 2) * 384 + col);
        float o[8];
#pragma unroll
        for (int j = 0; j < 8; ++j) { const float zm = bf_at(a, j), z = bf_at(b, j), zp = bf_at(c, j); float zz = z + (0.5f * (zm + zp) - z) * mu[col + j];
            if (col < 128) zz = tanh_fast(zz); else if (col >= 256) zz = sigm(zz); o[j] = zz; }
        u32x4 wv; wv.x = pk_bf16(o[0], o[1]); wv.y = pk_bf16(o[2], o[3]); wv.z = pk_bf16(o[4], o[5]); wv.w = pk_bf16(o[6], o[7]);
        *(LAS u32x4*)(A + tok * 392 + col) = wv; }
    __syncthreads();
#pragma unroll 1
    for (int og = 0; og < 5; ++og) {
        const int nks = og < 4 ? 2 : 4, acol0 = og < 4 ? 64 * og : 256, ldb = og < 4 ? 64 : 128;
        const bf16_t* Bt = og < 2 ? W2T + og * 32768 : (og < 4 ? A2T + (og - 2) * 32768 : G2T);
        f32x4 acc[4][4];
#pragma unroll
        for (int mt = 0; mt < 4; ++mt)
#pragma unroll
            for (int nt = 0; nt < 4; ++nt) acc[mt][nt] = (f32x4){0.f, 0.f, 0.f, 0.f};
#pragma unroll 1
        for (int ks = 0; ks < nks; ++ks) {
            bf16x8 bfr[4];
#pragma unroll
            for (int nt = 0; nt < 4; ++nt) bfr[nt] = *(const bf16x8*)(Bt + (size_t)(64 * w + 16 * nt + r) * ldb + 32 * ks + 8 * q);
#pragma unroll
            for (int mt = 0; mt < 4; ++mt) { const bf16x8 a = *(const LAS bf16x8*)(A + (16 * mt + r) * 392 + acol0 + 32 * ks + 8 * q);
#pragma unroll
                for (int nt = 0; nt < 4; ++nt) acc[mt][nt] = mfma16(bfr[nt], a, acc[mt][nt]); }
        }
        {
            _Float16* pb = PREP + (size_t)(t0 + r) * 2048 + og * 512 + 64 * w + 4 * q; bf16_t* mb = MB + (size_t)(t0 + r) * D + 512 + 64 * w + 4 * q;
            const float* bsrc = og < 2 ? w0 + og * 512 : a0 + (og - 2) * 512;
#pragma unroll
            for (int nt = 0; nt < 4; ++nt) { f32x4 bias = (f32x4){0.f, 0.f, 0.f, 0.f}; if (og < 4) bias = *(const f32x4*)(bsrc + 64 * w + 16 * nt + 4 * q);
#pragma unroll
                for (int mt = 0; mt < 4; ++mt) { const f32x4 x = acc[mt][nt] + bias;
                    if (og < 4) { f16x4 hv;
#pragma unroll
                        for (int i = 0; i < 4; ++i) { const float sg = sigm(x[i]); hv[i] = (_Float16)(og < 2 ? exp_fast(-0.606531f * sg) : sg); }
                        *(f16x4*)(pb + (size_t)mt * 16 * 2048 + 16 * nt) = hv; }
                    else { u32x2 wv; wv.x = pk_bf16(x[0], x[1]); wv.y = pk_bf16(x[2], x[3]); *(u32x2*)(mb + (size_t)mt * 16 * D + 16 * nt) = wv; }
                    asm volatile("" ::: "memory"); } }
        }
    }
}

DI float fma_s(float a, float b, float c) { float d; asm("v_fma_f32 %0, %1, %2, %3" : "=v"(d) : "v"(a), "v"(b), "v"(c)); return d; }
DI float mul_s(float a, float b) { float d; asm("v_mul_f32 %0, %1, %2" : "=v"(d) : "v"(a), "v"(b)); return d; }
template <int CTRL> DI float dpp_xadd(float v) { return v + __int_as_float(__builtin_amdgcn_update_dpp(0, __float_as_int(v), CTRL, 0xF, 0xF, true)); }
DI float sum16(float v) { v = dpp_xadd<0xB1>(v); v = dpp_xadd<0x4E>(v); v = dpp_xadd<0x141>(v); v = dpp_xadd<0x140>(v); return v; }
DI float sum8(float v) { v = dpp_xadd<0xB1>(v); v = dpp_xadd<0x4E>(v); v = dpp_xadd<0x141>(v); return v; }
__device__ void rwkv_scan_task(const Params& p, int l, int htask, LAS unsigned char* lds, const int tid_) {
    const int tid = tid_;
    const int task = htask >> 1, rhalf = htask & 1;
    int seq, hd; if (task < 64) { seq = 8 + (task >> 4); hd = task & 15; } else { const int j = task - 64; seq = j >> 4; hd = j & 15; }
    const int h = hd >> 1, d = hd & 1;
    const int s0 = seq < 8 ? seq * 2048 : 16384 + (seq - 8) * 8192, len = seq < 8 ? 2048 : 8192, ntiles = len / 32;
    LAS float* ldsf = (LAS float*)lds;
    const bf16_t* P = (const bf16_t*)(p.ws + WS_P); const _Float16* PREP = (const _Float16*)(p.ws + WS_PREP); bf16_t* YFB = (bf16_t*)(p.ws + WS_YFB);
    __syncthreads();
    if (tid >= 256) {
        const int pt = tid - 256, ptok = pt >> 3, cq = pt & 7, c0 = 64 * h + 8 * cq;
        const float* mu = p.in[15] + l * 1920;
        float mu_c[3][8], kk_c[8], ka_c[8];
#pragma unroll
        for (int j = 0; j < 8; ++j) { mu_c[0][j] = mu[c0 + j]; mu_c[1][j] = mu[512 + c0 + j]; mu_c[2][j] = mu[1024 + c0 + j]; kk_c[j] = p.in[21][l * 512 + c0 + j]; ka_c[j] = p.in[22][(l * 2 + d) * 512 + c0 + j]; }
        u32x4 raw[3][3], rw_w, rw_a;
        const u32x4 zero4 = (u32x4){0u, 0u, 0u, 0u};
#define RW_TT(ti) (d ? len - 32 * ((ti) + 1) + (31 - ptok) : 32 * (ti) + ptok)
#define RW_LOAD(ti) do { const int tt_ = RW_TT(ti); const size_t gr_ = (size_t)(s0 + tt_); \
            _Pragma("unroll") for (int X = 0; X < 3; ++X) { const bf16_t* b_ = P + gr_ * NP + P_RW + 512 * X + c0; raw[X][1] = *(const u32x4*)b_; \
                raw[X][0] = tt_ > 0 ? *(const u32x4*)(b_ - NP) : zero4; raw[X][2] = tt_ < len - 1 ? *(const u32x4*)(b_ + NP) : zero4; } \
            rw_w = *(const u32x4*)(PREP + gr_ * 2048 + d * 512 + c0); rw_a = *(const u32x4*)(PREP + gr_ * 2048 + (2 + d) * 512 + c0); } while (0)
#define RW_CONVERT(bufi) do { LAS float* ob_ = ldsf + (bufi) * 11264; float z_[3][8]; \
            _Pragma("unroll") for (int X = 0; X < 3; ++X) _Pragma("unroll") for (int j = 0; j < 8; ++j) { const float zc_ = bf_at(raw[X][1], j); z_[X][j] = zc_ + (0.5f * (bf_at(raw[X][0], j) + bf_at(raw[X][2], j)) - zc_) * mu_c[X][j]; } \
            const f16x8 wh_ = __builtin_bit_cast(f16x8, rw_w), ah_ = __builtin_bit_cast(f16x8, rw_a); float kkn_[8], ss_ = 0.f; \
            _Pragma("unroll") for (int j = 0; j < 8; ++j) { kkn_[j] = z_[1][j] * kk_c[j]; ss_ += kkn_[j] * kkn_[j]; } \
            ss_ = sum8(ss_); const float inv_ = rsqrtf(fmaxf(ss_, 1e-24f)); \
            _Pragma("unroll") for (int hh = 0; hh < 2; ++hh) { f32x4 vK, vW, vB, vKh, vR, vV; \
                _Pragma("unroll") for (int j = 0; j < 4; ++j) { const int jj = 4 * hh + j; const float av = (float)ah_[jj]; vK[j] = kkn_[jj] * inv_; vW[j] = (float)wh_[jj]; vB[j] = vK[j] * av; \
                    vKh[j] = z_[1][jj] * (1.0f + (av - 1.0f) * ka_c[jj]); vR[j] = z_[0][jj]; vV[j] = z_[2][jj]; } \
                const int o_ = ptok * 64 + 8 * cq + 4 * hh; \
                *(LAS f32x4*)(ob_ + o_) = vK; *(LAS f32x4*)(ob_ + 2048 + o_) = vW; *(LAS f32x4*)(ob_ + 4096 + o_) = vB; *(LAS f32x4*)(ob_ + 6144 + o_) = vKh; *(LAS f32x4*)(ob_ + 8192 + o_) = vR; \
                if ((cq >> 2) == rhalf) *(LAS f32x4*)(ob_ + 10240 + ptok * 32 + 8 * (cq & 3) + 4 * hh) = vV; } } while (0)
#define RW_STOREY(ti) do { const int tt_ = RW_TT(ti); const f32x4 yv_ = *(const LAS f32x4*)(ldsf + 22528 + ((ti) & 1) * 1024 + ptok * 32 + 4 * cq); \
            u32x2 wv_; wv_.x = pk_bf16(yv_[0], yv_[1]); wv_.y = pk_bf16(yv_[2], yv_[3]); \
            *(u32x2*)(YFB + ((size_t)d * T + (size_t)(s0 + tt_)) * 512 + 64 * h + 32 * rhalf + 4 * cq) = wv_; } while (0)
        RW_LOAD(0); RW_CONVERT(0); RW_LOAD(1);
        __syncthreads();
        for (int ti = 0; ti < ntiles; ++ti) {
            if (ti + 1 < ntiles) { RW_CONVERT((ti + 1) & 1); if (ti + 2 < ntiles) RW_LOAD(ti + 2); }
            if (ti > 0) RW_STOREY(ti - 1);
            __syncthreads();
        }
        RW_STOREY(ntiles - 1);
#undef RW_LOAD
#undef RW_CONVERT
#undef RW_STOREY
#undef RW_TT
    } else {
        const int rv = tid >> 3, rg = tid & 7;
        __builtin_amdgcn_s_setprio(3);
        f32x2 st[4];
#pragma unroll
        for (int i = 0; i < 4; ++i) st[i] = (f32x2){0.f, 0.f};
        __syncthreads();
        for (int ti = 0; ti < ntiles; ++ti) {
            const LAS float* ob = ldsf + (ti & 1) * 11264 + 8 * rg; const LAS float* ov = ldsf + (ti & 1) * 11264 + 10240 + rv; LAS float* yb = ldsf + 22528 + (ti & 1) * 1024 + rv;
#define RW_FETCH(dst, dv, s) do { _Pragma("unroll") for (int a_ = 0; a_ < 5; ++a_) { dst[2 * a_] = *(const LAS f32x4*)(ob + a_ * 2048 + (s) * 64); dst[2 * a_ + 1] = *(const LAS f32x4*)(ob + a_ * 2048 + (s) * 64 + 4); } dv = ov[(s) * 32]; } while (0)
            f32x4 cur[10], nxt[10]; float cv, nv;
            RW_FETCH(cur, cv, 0);
#pragma unroll 1
            for (int s8 = 0; s8 < 32; s8 += 8) {
                float yk = 0.f;
#pragma unroll
                for (int j = 0; j < 8; ++j) { const int s = s8 + j;
                    { const int sn = s + 1 < 32 ? s + 1 : 31; RW_FETCH(nxt, nv, sn); }
                    const f32x2 vv2 = (f32x2){cv, cv};
                    const f32x2 t0 = st[0] * (f32x2){cur[2][0], cur[2][1]} + vv2 * (f32x2){cur[6][0], cur[6][1]}, t1 = st[1] * (f32x2){cur[2][2], cur[2][3]} + vv2 * (f32x2){cur[6][2], cur[6][3]};
                    const f32x2 t2 = st[2] * (f32x2){cur[3][0], cur[3][1]} + vv2 * (f32x2){cur[7][0], cur[7][1]}, t3 = st[3] * (f32x2){cur[3][2], cur[3][3]} + vv2 * (f32x2){cur[7][2], cur[7][3]};
                    const f32x2 sa2 = ((st[0] * (f32x2){cur[0][0], cur[0][1]} + st[1] * (f32x2){cur[0][2], cur[0][3]}) + st[2] * (f32x2){cur[1][0], cur[1][1]}) + st[3] * (f32x2){cur[1][2], cur[1][3]};
                    const float sa = sum8(sa2[0] + sa2[1]);
                    const f32x2 nsa = (f32x2){-sa, -sa};
                    st[0] = nsa * (f32x2){cur[4][0], cur[4][1]} + t0; st[1] = nsa * (f32x2){cur[4][2], cur[4][3]} + t1;
                    st[2] = nsa * (f32x2){cur[5][0], cur[5][1]} + t2; st[3] = nsa * (f32x2){cur[5][2], cur[5][3]} + t3;
                    const f32x2 y2 = ((st[0] * (f32x2){cur[8][0], cur[8][1]} + st[1] * (f32x2){cur[8][2], cur[8][3]}) + st[2] * (f32x2){cur[9][0], cur[9][1]}) + st[3] * (f32x2){cur[9][2], cur[9][3]};
                    const float y = sum8(y2[0] + y2[1]);
                    yk = (rg == j) ? y : yk;
#pragma unroll
                    for (int a_ = 0; a_ < 10; ++a_) cur[a_] = nxt[a_];
                    cv = nv; }
                yb[(s8 + rg) * 32] = yk;
            }
#undef RW_FETCH
            __syncthreads();
        }
        __builtin_amdgcn_s_setprio(0);
    }
}

__device__ void rwkv_final(const Params& p, int l, const int tid_) {
    const int lane = tid_ & 63, gw = blockIdx.x * 8 + (tid_ >> 6), nw = gridDim.x * 8, c0 = 8 * lane, h = lane >> 3;
    const bf16_t* P = (const bf16_t*)(p.ws + WS_P); const _Float16* PREP = (const _Float16*)(p.ws + WS_PREP); const bf16_t* YFB = (const bf16_t*)(p.ws + WS_YFB); bf16_t* MB = mixbuf_of(p);
    const float* mu = p.in[15] + l * 1920;
    float mu_c[3][8], ka0[8], ka1[8], rk[8], gnw[8], gnb[8];
#pragma unroll
    for (int j = 0; j < 8; ++j) { mu_c[0][j] = mu[c0 + j]; mu_c[1][j] = mu[512 + c0 + j]; mu_c[2][j] = mu[1024 + c0 + j];
        ka0[j] = p.in[22][(l * 2 + 0) * 512 + c0 + j]; ka1[j] = p.in[22][(l * 2 + 1) * 512 + c0 + j]; rk[j] = p.in[23][l * 512 + h * 64 + (c0 & 63) + j];
        gnw[j] = p.in[24][l * 512 + c0 + j]; gnb[j] = p.in[25][l * 512 + c0 + j]; }
    for (int row = gw; row < T; row += nw) {
        int s0, len; seq_of(row, s0, len); const bool hm = row > s0, hp = row < s0 + len - 1;
        const u32x4 yf = *(const u32x4*)(YFB + (size_t)row * 512 + c0), yb = *(const u32x4*)(YFB + ((size_t)T + row) * 512 + c0);
        float y[8], sum = 0.f;
#pragma unroll
        for (int j = 0; j < 8; ++j) { y[j] = bf_at(yf, j) + bf_at(yb, j); sum += y[j]; }
        sum += __shfl_xor(sum, 1); sum += __shfl_xor(sum, 2); sum += __shfl_xor(sum, 4);
        const float mean = sum * (1.0f / 64.0f); float var = 0.f;
#pragma unroll
        for (int j = 0; j < 8; ++j) { const float dd = y[j] - mean; var += dd * dd; }
        var += __shfl_xor(var, 1); var += __shfl_xor(var, 2); var += __shfl_xor(var, 4);
        const float rstd = rsqrtf(var * (1.0f / 64.0f) + 64e-5f);
        float z[3][8];
        const u32x4 zero4 = (u32x4){0u, 0u, 0u, 0u};
#pragma unroll
        for (int X = 0; X < 3; ++X) { const bf16_t* b = P + (size_t)row * NP + P_RW + 512 * X + c0;
            const u32x4 zc = *(const u32x4*)b, zm = hm ? *(const u32x4*)(b - NP) : zero4, zp = hp ? *(const u32x4*)(b + NP) : zero4;
#pragma unroll
            for (int j = 0; j < 8; ++j) { const float c = bf_at(zc, j); z[X][j] = c + (0.5f * (bf_at(zm, j) + bf_at(zp, j)) - c) * mu_c[X][j]; } }
        const f16x8 a0 = *(const f16x8*)(PREP + (size_t)row * 2048 + 1024 + c0), a1 = *(const f16x8*)(PREP + (size_t)row * 2048 + 1536 + c0);
        float bs = 0.f;
#pragma unroll
        for (int j = 0; j < 8; ++j) { const float k0 = z[1][j] * (1.0f + ((float)a0[j] - 1.0f) * ka0[j]), k1 = z[1][j] * (1.0f + ((float)a1[j] - 1.0f) * ka1[j]); bs += z[0][j] * (k0 + k1) * rk[j]; }
        bs += __shfl_xor(bs, 1); bs += __shfl_xor(bs, 2); bs += __shfl_xor(bs, 4);
        const u32x4 gv = *(const u32x4*)(MB + (size_t)row * D + 512 + c0);
        float o[8];
#pragma unroll
        for (int j = 0; j < 8; ++j) o[j] = ((y[j] - mean) * rstd * gnw[j] + gnb[j] + bs * z[2][j]) * bf_at(gv, j);
        u32x4 wv; wv.x = pk_bf16(o[0], o[1]); wv.y = pk_bf16(o[2], o[3]); wv.z = pk_bf16(o[4], o[5]); wv.w = pk_bf16(o[6], o[7]);
        *(u32x4*)(MB + (size_t)row * D + 512 + c0) = wv;
    }
}

DI float gelu_tanh(float x) { const float u = 0.7978845608028654f * (x + 0.044715f * x * x * x); return 0.5f * x * (1.0f + tanh_fast(u)); }
__device__ void lru_run(const Params& p, int l, int n, int tile_first, int tile_stride, int tile_count, int mode, LAS unsigned char* lds, const int tid_) {
    const int tid = tid_, lane = tid & 63, w = tid >> 6, r = lane & 15, q = lane >> 4;
    LAS float* xcf = (LAS float*)lds;
    LAS bf16_t* Ab = (LAS bf16_t*)(lds + 16384);
    LAS float* aL = (LAS float*)(lds + 25600);
    LAS float* uL = (LAS float*)(lds + 58368);
    LAS float* agg = (LAS float*)(lds + 91136);
    LAS float* carry = (LAS float*)(lds + 95232);
    const bf16_t* P = (const bf16_t*)(p.ws + WS_P); bf16_t* MB = mixbuf_of(p); const bf16_t* LB = (const bf16_t*)(p.ws + WS_LB);
    f32x2* AGG = (f32x2*)(p.ws + WS_AGG);
    const int tok = tid >> 3, cg8 = tid & 7, ch0 = 64 * n + 8 * cg8;
    LAS float* cwl = (LAS float*)(lds + 95744);
    __syncthreads();
    if (tid < 320) { const int k = tid >> 6, c = tid & 63; cwl[tid] = k < 4 ? p.in[8][(l * 4 + k) * 512 + 64 * n + c] : p.in[9][l * 512 + 64 * n + c]; }
    const int gd = w >> 2, ct = w & 3, chl = 16 * ct + r, gc = 64 * n + chl;
    bf16x8 br[2], bi[2];
#pragma unroll
    for (int ks = 0; ks < 2; ++ks) { br[ks] = *(const bf16x8*)(LB + (size_t)(n * 256 + (gd * 2 + 0) * 64 + chl) * 64 + 32 * ks + 8 * q);
                                     bi[ks] = *(const bf16x8*)(LB + (size_t)(n * 256 + (gd * 2 + 1) * 64 + chl) * 64 + 32 * ks + 8 * q); }
    const float ba_c = p.in[11][(l * 2 + gd) * 512 + gc], bx_c = p.in[13][(l * 2 + gd) * 512 + gc];
    float sp_c; { const float lam = p.in[14][(l * 2 + gd) * 512 + gc]; const float e = exp_fast(-lam); sp_c = e < 0.1f ? e * (1.0f - e * (0.5f - e * (0.33333334f - e * (0.25f - e * 0.2f)))) : 0.6931471805599453f * __builtin_amdgcn_logf(1.0f + e); }
    const int sd = tid >> 8, sc = (tid >> 6) & 3, scn = tid & 63;
    const u32x4 zero4 = (u32x4){0u, 0u, 0u, 0u};
    u32x4 xr[4];
#define LRU_LOADX(gt_) do { const int t0g_ = (gt_) * 64; int s0_, len_; seq_of(t0g_, s0_, len_); \
        _Pragma("unroll") for (int k = 0; k < 4; ++k) { const int gr_ = t0g_ + tok - 2 + k; xr[k] = (gr_ >= s0_ && gr_ < s0_ + len_) ? *(const u32x4*)(P + (size_t)gr_ * NP + P_LX + ch0) : zero4; } } while (0)
    if (tile_count > 0) LRU_LOADX(tile_first);
    for (int it = 0; it < tile_count; ++it) {
        int tl_ = tid_; asm volatile("" : "+v"(tl_));
        const int tid = tl_, lane = tid & 63, w = tid >> 6, r = lane & 15, q = lane >> 4, tok = tid >> 3, cg8 = tid & 7, ch0 = 64 * n + 8 * cg8;
        const int gd = w >> 2, ct = w & 3, chl = 16 * ct + r, sd = tid >> 8, sc = (tid >> 6) & 3, scn = tid & 63;
        const int gt = tile_first + it * tile_stride, t0g = gt * 64; int s0, len; seq_of(t0g, s0, len);
        const int ti = (t0g - s0) >> 6, N = len >> 6;
        u32x4 gv = zero4;
        if (mode) gv = *(const u32x4*)(P + (size_t)(t0g + tok) * NP + P_LG + ch0);
        __syncthreads();
        {   float acc[8];
            { const f32x4 c0_ = *(const LAS f32x4*)(cwl + 256 + 8 * cg8), c1_ = *(const LAS f32x4*)(cwl + 256 + 8 * cg8 + 4);
#pragma unroll
              for (int j = 0; j < 4; ++j) { acc[j] = c0_[j]; acc[4 + j] = c1_[j]; } }
#pragma unroll
            for (int k = 0; k < 4; ++k) { const f32x4 c0_ = *(const LAS f32x4*)(cwl + 64 * k + 8 * cg8), c1_ = *(const LAS f32x4*)(cwl + 64 * k + 8 * cg8 + 4);
#pragma unroll
                for (int j = 0; j < 4; ++j) { acc[j] += c0_[j] * bf_at(xr[k], j); acc[4 + j] += c1_[j] * bf_at(xr[k], 4 + j); } }
            *(LAS f32x4*)(xcf + tok * 64 + 8 * cg8) = (f32x4){acc[0], acc[1], acc[2], acc[3]};
            *(LAS f32x4*)(xcf + tok * 64 + 8 * cg8 + 4) = (f32x4){acc[4], acc[5], acc[6], acc[7]};
            u32x4 wv; wv.x = pk_bf16(acc[0], acc[1]); wv.y = pk_bf16(acc[2], acc[3]); wv.z = pk_bf16(acc[4], acc[5]); wv.w = pk_bf16(acc[6], acc[7]);
            *(LAS u32x4*)(Ab + tok * 72 + 8 * cg8) = wv; }
        if (it + 1 < tile_count) LRU_LOADX(gt + tile_stride);
        float pA = 1.f, pH = 0.f;
        if (mode) { const int cnt = sd == 0 ? ti : N - 1 - ti, lo = (cnt * sc) >> 2, hi = (cnt * (sc + 1)) >> 2;
            const f32x2* ab = AGG + ((size_t)(gt - ti) * 8 + n) * 128 + sd * 64 + scn;
            f32x2 e[32];
#pragma unroll
            for (int u = 0; u < 32; ++u) { const int j = lo + u, tj = sd == 0 ? j : N - 1 - j; e[u] = j < hi ? ab[(size_t)tj * 1024] : (f32x2){1.f, 0.f}; }
#pragma unroll
            for (int u = 0; u < 32; ++u) { pH = e[u][0] * pH + e[u][1]; pA *= e[u][0]; } }
        __syncthreads();
        {   f32x4 accr[4], acci[4];
#pragma unroll
            for (int mt = 0; mt < 4; ++mt) { accr[mt] = (f32x4){0.f, 0.f, 0.f, 0.f}; acci[mt] = (f32x4){0.f, 0.f, 0.f, 0.f};
#pragma unroll
                for (int ks = 0; ks < 2; ++ks) { const bf16x8 a = *(const LAS bf16x8*)(Ab + (16 * mt + r) * 72 + 32 * ks + 8 * q);
                    accr[mt] = mfma16(a, br[ks], accr[mt]); acci[mt] = mfma16(a, bi[ks], acci[mt]); } }
            const int t0 = t0g - s0;
#pragma unroll
            for (int mt = 0; mt < 4; ++mt)
#pragma unroll
                for (int i = 0; i < 4; ++i) { const int tk = 16 * mt + 4 * q + i, tt = t0 + tk;
                    const float rg_ = sigm(accr[mt][i] + ba_c), ig_ = sigm(acci[mt][i] + bx_c);
                    const float la = -8.0f * rg_ * sp_c, a = exp_fast(la), e2 = 2.0f * la;
                    const float om = e2 > -0.05f ? -e2 * (1.0f + e2 * (0.5f + e2 * (0.16666667f + e2 * 0.041666668f))) : 1.0f - exp_fast(e2);
                    float mult = sqrtf(om); if (gd == 0 ? tt == 0 : tt == len - 1) mult = 1.0f;
                    const float u = mult * ig_ * xcf[tk * 64 + chl];
                    aL[(gd * 64 + tk) * 64 + chl] = a; uL[(gd * 64 + tk) * 64 + chl] = u; }
        }
        if (mode) { agg[((sd * 64 + scn) * 4 + sc) * 2 + 0] = pA; agg[((sd * 64 + scn) * 4 + sc) * 2 + 1] = pH; }
        __syncthreads();
        {
            float hh = 0.f;
            if (mode) {
#pragma unroll
                for (int s2 = 0; s2 < 4; ++s2) hh = agg[((sd * 64 + scn) * 4 + s2) * 2 + 0] * hh + agg[((sd * 64 + scn) * 4 + s2) * 2 + 1]; }
            float A = 1.f, H = 0.f;
#pragma unroll
            for (int j = 0; j < 16; ++j) { const int tk = sd == 0 ? 16 * sc + j : 63 - 16 * sc - j; const float a_ = aL[(sd * 64 + tk) * 64 + scn], u_ = uL[(sd * 64 + tk) * 64 + scn]; H = a_ * H + u_; A *= a_; }
            __syncthreads();
            agg[((sd * 64 + scn) * 4 + sc) * 2 + 0] = A; agg[((sd * 64 + scn) * 4 + sc) * 2 + 1] = H;
            __syncthreads();
            if (mode == 0) { if (sc == 0) { float tA = 1.f, tH = 0.f;
#pragma unroll
                    for (int s2 = 0; s2 < 4; ++s2) { const float a_ = agg[((sd * 64 + scn) * 4 + s2) * 2 + 0], h_ = agg[((sd * 64 + scn) * 4 + s2) * 2 + 1]; tH = a_ * tH + h_; tA *= a_; }
                    AGG[((size_t)gt * 8 + n) * 128 + sd * 64 + scn] = (f32x2){tA, tH}; } }
            else {
                for (int s2 = 0; s2 < sc; ++s2) hh = agg[((sd * 64 + scn) * 4 + s2) * 2 + 0] * hh + agg[((sd * 64 + scn) * 4 + s2) * 2 + 1];
#pragma unroll
                for (int j = 0; j < 16; ++j) { const int tk = sd == 0 ? 16 * sc + j : 63 - 16 * sc - j; hh = aL[(sd * 64 + tk) * 64 + scn] * hh + uL[(sd * 64 + tk) * 64 + scn]; uL[(sd * 64 + tk) * 64 + scn] = hh; }
            }
        }
        if (mode) {
            __syncthreads();
            const f32x4 f0 = *(const LAS f32x4*)(uL + tok * 64 + 8 * cg8), f1 = *(const LAS f32x4*)(uL + tok * 64 + 8 * cg8 + 4);
            const f32x4 b0 = *(const LAS f32x4*)(uL + (64 + tok) * 64 + 8 * cg8), b1 = *(const LAS f32x4*)(uL + (64 + tok) * 64 + 8 * cg8 + 4);
            float hv[8] = {f0[0] + b0[0], f0[1] + b0[1], f0[2] + b0[2], f0[3] + b0[3], f1[0] + b1[0], f1[1] + b1[1], f1[2] + b1[2], f1[3] + b1[3]};
#pragma unroll
            for (int j = 0; j < 8; ++j) hv[j] *= gelu_tanh(bf_at(gv, j));
            u32x4 wv; wv.x = pk_bf16(hv[0], hv[1]); wv.y = pk_bf16(hv[2], hv[3]); wv.z = pk_bf16(hv[4], hv[5]); wv.w = pk_bf16(hv[6], hv[7]);
            *(u32x4*)(MB + (size_t)(t0g + tok) * D + ch0) = wv;
        }
    }
#undef LRU_LOADX
}

#ifndef NCH
#define NCH 2
#endif
constexpr int FCH = NCH, FROWS = T / FCH, PER = 7 + 2 * FCH, N_PHASES = 1 + 2 * PER, ATTN_IN_SCAN = 768, ATTN_UNITS = 3072;
__device__ void run_phase(const Params& p, int ph, LAS unsigned char* lds, const int tid_) {
    bf16_t* XB = (bf16_t*)(p.ws + WS_XB); float* RS1 = (float*)(p.ws + WS_RS1); float* RS2 = (float*)(p.ws + WS_RS2);
    if (ph == 0) { wprep_phase(p, 0, lds, tid_); rowpass0(p, tid_); return; }
    const int l = (ph - 1) / PER, k = (ph - 1) % PER;
    if (k == 0) {
        pg8::Gemm g{XB, (const bf16_t*)(p.ws + WS_WIN), T, NP, D}; pg8::StaticOrder S; S.init(T, NP, (int)gridDim.x, (int)blockIdx.x);
        EpiBf16S E{(bf16_t*)(p.ws + WS_P), NP, nullptr, 0};
        pg8::gemm_phase<EpiBf16S, pg8::StaticOrder>(lds, g, S, E, nullptr, tid_);
    } else if (k == 1) {
        for (int u = ATTN_IN_SCAN + blockIdx.x; u < ATTN_UNITS; u += gridDim.x) { int t2 = tid_; asm volatile("" : "+v"(t2)); attn_unit(p, l, u, lds, t2); }
        for (int t = blockIdx.x; t < 768; t += gridDim.x) { int t2 = tid_; asm volatile("" : "+v"(t2)); rwkv_prep_tile(p, l, t, lds, t2); }
        { const int per = (int)gridDim.x >> 3; if ((int)blockIdx.x < per * 8) { const int first = (int)blockIdx.x >> 3; lru_run(p, l, (int)blockIdx.x & 7, first, per, (768 - first + per - 1) / per, 0, lds, tid_); } }
    } else if (k == 2) {
        for (int vb = blockIdx.x; vb < 256; vb += gridDim.x) {
#ifndef PROBE2
#define PROBE2 0
#endif
            if (vb < 192) { const int n = vb < 128 ? 1 : 4, b0 = vb < 128 ? vb : 128 + 4 * (vb - 128); for (int i = 0; i < n * (PROBE2 == 1 ? 2 : 1); ++i) rwkv_scan_task(p, l, b0 + (i % n), lds, tid_); }
            else { const int j = vb - 192; for (int rep = 0; rep < (PROBE2 == 2 ? 2 : 1); ++rep) lru_run(p, l, j & 7, j >> 3, 8, 96, 1, lds, tid_);
                for (int u = j; u < ATTN_IN_SCAN; u += 64) { int t2 = tid_; asm volatile("" : "+v"(t2)); attn_unit(p, l, u, lds, t2); } }
        }
    } else if (k == 3) { rwkv_final(p, l, tid_);
    } else if (k == 4) {
        pg8::Gemm g{mixbuf_of(p), (const bf16_t*)(p.ws + WS_WOUT), T, D, D}; pg8::StaticOrder S; S.init(T, D, (int)gridDim.x, (int)blockIdx.x);
        EpiBf16S E{(bf16_t*)(p.ws + WS_F), D, nullptr, 0};
        pg8::gemm_phase<EpiBf16S, pg8::StaticOrder>(lds, g, S, E, nullptr, tid_);
    } else if (k == 5) { rowpass_post(p, (const bf16_t*)(p.ws + WS_F), p.in[3] + l * D, 2, RS1, RS2, 0, tid_);
    } else if (k < 6 + 2 * FCH) {
        const int th = (k - 6) >> 1; const size_t rb = (size_t)th * FROWS;
        if (((k - 6) & 1) == 0) {
            pg8::Gemm g{XB + rb * D, (const bf16_t*)(p.ws + WS_WUP), FROWS, DFF, D}; pg8::StaticOrder S; S.init(FROWS, DFF, (int)gridDim.x, (int)blockIdx.x);
            EpiBf16S E{(bf16_t*)(p.ws + WS_U), DFF, nullptr, 1};
            pg8::gemm_phase<EpiBf16S, pg8::StaticOrder>(lds, g, S, E, nullptr, tid_);
        } else {
            pg8::Gemm g{(const bf16_t*)(p.ws + WS_U), (const bf16_t*)(p.ws + WS_WDN), FROWS, D, DFF}; pg8::StaticOrder S; S.init(FROWS, D, (int)gridDim.x, (int)blockIdx.x);
            EpiBf16S E{(bf16_t*)(p.ws + WS_F) + rb * D, D, nullptr, 0};
            pg8::gemm_phase<EpiBf16S, pg8::StaticOrder>(lds, g, S, E, nullptr, tid_);
        }
    } else {
        rowpass_post(p, (const bf16_t*)(p.ws + WS_F), p.in[5] + l * D, 2, RS2, RS1, l == 0 ? 0 : 2, tid_);
        if (l == 0) wprep_phase(p, 1, lds, tid_);
    }
}

__global__ void __launch_bounds__(512, 2) hymba_mega(Params p) {
    extern __shared__ __attribute__((aligned(16))) unsigned char smem[];
    LAS unsigned char* lds = (LAS unsigned char*)smem;
    volatile LAS unsigned* bst = (volatile LAS unsigned*)(lds + 131072);
    unsigned* bar = (unsigned*)(p.ws + WS_BAR);
    const bool coop = p.ph_hi - p.ph_lo > 1;
    if (coop) {
        if (threadIdx.x < 2) bst[threadIdx.x] = 0u;
        if (blockIdx.x == 0) for (int i = threadIdx.x; i < XCD_BAR_WORDS; i += 512) bar[i] = 0u;
        __syncthreads();
    }
    XcdBarrier xb; xb.bar = bar; xb.x = 0; xb.st = bst;
    bool posted = false;
    for (int ph = p.ph_lo; ph < p.ph_hi; ++ph) {
        int nrep = 1;
#if PROBE_MASK
        if ((ph > 0 && ((PROBE_MASK >> ((ph - 1) % PER)) & 1)) || (ph == 0 && ((PROBE_MASK >> 30) & 1))) nrep = 2;
#endif
        for (int rep = 0; rep < nrep; ++rep) {
            int tid_ = (int)__builtin_amdgcn_workitem_id_x(); asm volatile("" : "+v"(tid_));
            run_phase(p, ph, lds, tid_);
            if (ph + 1 < p.ph_hi || rep + 1 < nrep) {
                if (!posted) { cg::this_grid().sync(); xb = xcd_barrier_post(bar, bst, tid_ == 0); posted = true; }
                else xcd_barrier(xb, tid_ == 0);
            }
        }
    }
}

#ifndef PROBE_MASK
#define PROBE_MASK 0
#endif
#ifndef N_LAUNCH_PER_PHASE
#define N_LAUNCH_PER_PHASE 1
#endif
extern "C" void kernel_launch(void* const* d_in, const int* in_sizes, int n_in, void* d_out, int out_size, void* d_ws, size_t ws_size, hipStream_t stream) {
    static int grid = 0;
    if (grid == 0) {
        if (n_in != 30 || ws_size < WS_END) { fprintf(stderr, "kernel_launch: unexpected n_in %d / ws_size %zu\n", n_in, ws_size); grid = -1; return; }
        int dev = 0, cus = 0, per_cu = 0;
        hipGetDevice(&dev); hipDeviceGetAttribute(&cus, hipDeviceAttributeMultiprocessorCount, dev);
        if (hipFuncSetAttribute((const void*)hymba_mega, hipFuncAttributeMaxDynamicSharedMemorySize, LDS_BYTES) != hipSuccess) { fprintf(stderr, "kernel_launch: hipFuncSetAttribute failed\n"); grid = -1; return; }
        if (hipOccupancyMaxActiveBlocksPerMultiprocessor(&per_cu, (const void*)hymba_mega, 512, LDS_BYTES) != hipSuccess || per_cu < 1) { fprintf(stderr, "kernel_launch: occupancy query says %d\n", per_cu); per_cu = 1; }
        (void)hipGetLastError();
        grid = cus * (per_cu > 1 ? 1 : per_cu);
    }
    if (grid < 0) return;
    Params p{};
    for (int i = 0; i < 30; ++i) p.in[i] = (const float*)d_in[i];
    p.out = (float*)d_out; p.ws = (unsigned char*)d_ws;
#if N_LAUNCH_PER_PHASE
    for (int ph = 0; ph < N_PHASES; ++ph) { p.ph_lo = ph; p.ph_hi = ph + 1; hipLaunchKernelGGL(hymba_mega, dim3(grid), dim3(512), LDS_BYTES, stream, p); }
#else
    p.ph_lo = 0; p.ph_hi = N_PHASES;
    void* args[] = {&p};
    hipError_t e = hipLaunchCooperativeKernel((const void*)hymba_mega, dim3(grid), dim3(512), args, LDS_BYTES, stream);
    if (e != hipSuccess) fprintf(stderr, "kernel_launch: cooperative launch failed: %s (grid %d)\n", hipGetErrorString(e), grid);
#endif
}
```
